# Optimizing an MI355X kernel written in HIP

```python
import math
import jax, jax.numpy as jnp
from jax import lax
import numpy as np

D_MODEL = 1024
BATCH = 8
SEQ = 4096
DEPTH = 4

HEAD_DIM = 64
ATTN_Q_HEADS = D_MODEL // (2 * HEAD_DIM)
ATTN_KV_HEADS = max(1, ATTN_Q_HEADS // 4)
RET_HEADS = D_MODEL // (2 * HEAD_DIM)
ATTN_WIDTH = ATTN_Q_HEADS * HEAD_DIM
KV_WIDTH = ATTN_KV_HEADS * HEAD_DIM
RET_WIDTH = RET_HEADS * HEAD_DIM
MIX_WIDTH = ATTN_WIDTH + RET_WIDTH
IN_SPLITS = (ATTN_WIDTH,
             ATTN_WIDTH + KV_WIDTH,
             ATTN_WIDTH + 2 * KV_WIDTH,
             ATTN_WIDTH + 2 * KV_WIDTH + RET_WIDTH,
             ATTN_WIDTH + 2 * KV_WIDTH + 2 * RET_WIDTH,
             ATTN_WIDTH + 2 * KV_WIDTH + 3 * RET_WIDTH)
IN_WIDTH = ATTN_WIDTH + 2 * KV_WIDTH + 4 * RET_WIDTH
WINDOW = 128
ATTN_BLOCK = 128
RET_CHUNK = 128
ROPE_THETA = 10000.0
RET_THETA = 10000.0
D_FF = ((8 * D_MODEL // 3 + 127) // 128) * 128
LN_EPS = 1e-5
GN_EPS = 1e-6
DEEPNORM_ALPHA = (2 * DEPTH) ** 0.25
DEEPNORM_BETA = (8 * DEPTH) ** -0.25

kernel_name = "hybrid_swa_sink_retention_macaron_deepnorm"


def layer_norm(x, g, b):
    xf = x.astype(jnp.float32)
    mu = jnp.mean(xf, axis=-1, keepdims=True)
    var = jnp.mean(jnp.square(xf - mu), axis=-1, keepdims=True)
    return ((xf - mu) * lax.rsqrt(var + LN_EPS)).astype(x.dtype) * g + b


def swiglu_ffn(x, w_gu, w_down):
    a, u = jnp.split(x @ w_gu, 2, axis=-1)
    return (jax.nn.silu(a) * u) @ w_down


def rope_tables(seq):
    pos = jnp.arange(seq, dtype=jnp.float32)
    inv_freq = ROPE_THETA ** (-jnp.arange(0, HEAD_DIM, 2, dtype=jnp.float32) / HEAD_DIM)
    ang = pos[:, None] * inv_freq[None, :]
    return jnp.cos(ang), jnp.sin(ang)


def retention_rotation_tables(seq):
    pos = jnp.arange(seq, dtype=jnp.float32)
    ang_freq = 1.0 / (RET_THETA ** jnp.linspace(0.0, 1.0, HEAD_DIM // 2, dtype=jnp.float32))
    ang = pos[:, None] * ang_freq[None, :]
    return jnp.cos(ang), jnp.sin(ang)


def apply_rope(x, cos, sin):
    c = cos[:, None, :].astype(x.dtype)
    s = sin[:, None, :].astype(x.dtype)
    x1, x2 = jnp.split(x, 2, axis=-1)
    return jnp.concatenate([x1 * c - x2 * s, x2 * c + x1 * s], axis=-1)


def apply_pair_rotation(x, cos, sin):
    c = cos[:, None, :].astype(x.dtype)
    s = sin[:, None, :].astype(x.dtype)
    xe = x[..., 0::2]
    xo = x[..., 1::2]
    return jnp.stack([xe * c - xo * s, xo * c + xe * s], axis=-1).reshape(x.shape)


def sliding_window_sink_attention(q, k, v, sinks):
    B, S, Hq, D = q.shape
    Hkv = k.shape[2]
    G = Hq // Hkv
    C = ATTN_BLOCK
    N = S // C
    qb = (q * (HEAD_DIM ** -0.5)).reshape(B, N, C, Hkv, G, D)

    def with_prev_block(t):
        tb = t.reshape(B, N, C, Hkv, D)
        prev = jnp.pad(tb, ((0, 0), (1, 0), (0, 0), (0, 0), (0, 0)))[:, :-1]
        return jnp.concatenate([prev, tb], axis=2)

    kk = with_prev_block(k)
    vv = with_prev_block(v)
    s = jnp.einsum('bnqhgd,bnkhd->bnhgqk', qb, kk).astype(jnp.float32)
    q_idx = jnp.arange(C)[:, None]
    k_rel = jnp.arange(2 * C)[None, :] - C
    rel = q_idx - k_rel
    band = (rel >= 0) & (rel < WINDOW)
    valid = (jnp.arange(N)[:, None] * C + k_rel) >= 0
    mask = band[None, :, :] & valid[:, None, :]
    s = jnp.where(mask[None, :, None, None, :, :], s, -jnp.inf)
    sink = sinks.astype(jnp.float32).reshape(Hkv, G)[None, None, :, :, None, None]
    m = jnp.maximum(jnp.max(s, axis=-1, keepdims=True), sink)
    p = jnp.exp(s - m)
    denom = jnp.sum(p, axis=-1, keepdims=True) + jnp.exp(sink - m)
    o = jnp.einsum('bnhgqk,bnkhd->bnqhgd', (p / denom).astype(v.dtype), vv)
    return o.reshape(B, S, Hq * D)


def multiscale_retention(q, k, v, gate):
    B, S, H, D = q.shape
    C = RET_CHUNK
    N = S // C
    log_gamma = jnp.log1p(-jnp.exp2(-5.0 - jnp.arange(H, dtype=jnp.float32)))
    idx = jnp.arange(C, dtype=jnp.float32)
    diff = idx[:, None] - idx[None, :]
    decay = jnp.where(diff[None] >= 0,
                      jnp.exp(jnp.maximum(diff, 0.0)[None] * log_gamma[:, None, None]), 0.0)
    w_k = jnp.exp((C - 1.0 - idx)[None, :] * log_gamma[:, None])
    w_q = jnp.exp((idx + 1.0)[None, :] * log_gamma[:, None])
    g_chunk = jnp.exp(C * log_gamma)
    qc = q.reshape(B, N, C, H, D)
    kc = k.reshape(B, N, C, H, D)
    vc = v.reshape(B, N, C, H, D)
    scores = jnp.einsum('bnihd,bnjhd->bnhij', qc, kc) * decay
    intra = jnp.einsum('bnhij,bnjhe->bnihe', scores, vc)
    kv = jnp.einsum('bnjhd,hj,bnjhe->bnhde', kc, w_k, vc)

    def step(state, kv_n):
        return state * g_chunk[None, :, None, None] + kv_n, state

    init = jnp.zeros((B, H, D, D), dtype=kv.dtype)
    _, states = lax.scan(step, init, jnp.moveaxis(kv, 1, 0))
    states = jnp.moveaxis(states, 0, 1)
    cross = jnp.einsum('bnihd,hi,bnhde->bnihe', qc, w_q, states)
    o = (intra + cross).reshape(B, S, H, D).astype(jnp.float32)
    mu = jnp.mean(o, axis=-1, keepdims=True)
    var = jnp.mean(jnp.square(o - mu), axis=-1, keepdims=True)
    o = ((o - mu) * lax.rsqrt(var + GN_EPS)).reshape(B, S, H * D).astype(gate.dtype)
    return jax.nn.silu(gate) * o


def hybrid_mixer(x, w_in, w_out, sinks, rope_cos, rope_sin, ret_cos, ret_sin):
    B, S, _ = x.shape
    h = x @ w_in
    qa, ka, va, qr, kr, vr, gr = jnp.split(h, IN_SPLITS, axis=-1)
    qa = apply_rope(qa.reshape(B, S, ATTN_Q_HEADS, HEAD_DIM), rope_cos, rope_sin)
    ka = apply_rope(ka.reshape(B, S, ATTN_KV_HEADS, HEAD_DIM), rope_cos, rope_sin)
    va = va.reshape(B, S, ATTN_KV_HEADS, HEAD_DIM)
    y_attn = sliding_window_sink_attention(qa, ka, va, sinks)
    qr = apply_pair_rotation(qr.reshape(B, S, RET_HEADS, HEAD_DIM), ret_cos, ret_sin)
    kr = apply_pair_rotation(kr.reshape(B, S, RET_HEADS, HEAD_DIM), ret_cos, ret_sin) * (HEAD_DIM ** -0.5)
    y_ret = multiscale_retention(qr, kr, vr.reshape(B, S, RET_HEADS, HEAD_DIM), gr)
    return jnp.concatenate([y_attn, y_ret], axis=-1) @ w_out


def setup_inputs(seed: int = 0) -> dict:
    key = jax.random.key(seed)
    ks = jax.random.split(key, 16)
    f32 = jnp.float32
    x = jax.random.normal(ks[0], (BATCH, SEQ, D_MODEL), f32)
    col_scale = jnp.concatenate([
        jnp.ones((ATTN_WIDTH + KV_WIDTH,), f32),
        jnp.full((KV_WIDTH,), DEEPNORM_BETA, f32),
        jnp.ones((2 * RET_WIDTH,), f32),
        jnp.full((RET_WIDTH,), DEEPNORM_BETA, f32),
        jnp.ones((RET_WIDTH,), f32)])
    w_in = jax.random.normal(ks[1], (DEPTH, D_MODEL, IN_WIDTH), f32) * (D_MODEL ** -0.5) * col_scale
    w_out = jax.random.normal(ks[2], (DEPTH, MIX_WIDTH, D_MODEL), f32) * (MIX_WIDTH ** -0.5) * DEEPNORM_BETA
    attn_sinks = 0.5 * jax.random.normal(ks[3], (DEPTH, ATTN_Q_HEADS), f32)
    ffn1_w_gu = jax.random.normal(ks[4], (DEPTH, D_MODEL, 2 * D_FF), f32) * (D_MODEL ** -0.5) * DEEPNORM_BETA
    ffn1_w_down = jax.random.normal(ks[5], (DEPTH, D_FF, D_MODEL), f32) * (D_FF ** -0.5) * DEEPNORM_BETA
    ffn2_w_gu = jax.random.normal(ks[6], (DEPTH, D_MODEL, 2 * D_FF), f32) * (D_MODEL ** -0.5) * DEEPNORM_BETA
    ffn2_w_down = jax.random.normal(ks[7], (DEPTH, D_FF, D_MODEL), f32) * (D_FF ** -0.5) * DEEPNORM_BETA
    ln1_g = 1.0 + 0.02 * jax.random.normal(ks[8], (DEPTH, D_MODEL), f32)
    ln1_b = 0.02 * jax.random.normal(ks[9], (DEPTH, D_MODEL), f32)
    ln2_g = 1.0 + 0.02 * jax.random.normal(ks[10], (DEPTH, D_MODEL), f32)
    ln2_b = 0.02 * jax.random.normal(ks[11], (DEPTH, D_MODEL), f32)
    ln3_g = 1.0 + 0.02 * jax.random.normal(ks[12], (DEPTH, D_MODEL), f32)
    ln3_b = 0.02 * jax.random.normal(ks[13], (DEPTH, D_MODEL), f32)
    return {"x": x, "w_in": w_in, "w_out": w_out, "attn_sinks": attn_sinks,
            "ffn1_w_gu": ffn1_w_gu, "ffn1_w_down": ffn1_w_down,
            "ffn2_w_gu": ffn2_w_gu, "ffn2_w_down": ffn2_w_down,
            "ln1_g": ln1_g, "ln1_b": ln1_b, "ln2_g": ln2_g, "ln2_b": ln2_b,
            "ln3_g": ln3_g, "ln3_b": ln3_b}


def reference(x, w_in, w_out, attn_sinks, ffn1_w_gu, ffn1_w_down, ffn2_w_gu, ffn2_w_down,
              ln1_g, ln1_b, ln2_g, ln2_b, ln3_g, ln3_b):
    S = x.shape[1]
    rope_cos, rope_sin = rope_tables(S)
    ret_cos, ret_sin = retention_rotation_tables(S)
    for l in range(DEPTH):
        x = layer_norm(DEEPNORM_ALPHA * x + 0.5 * swiglu_ffn(x, ffn1_w_gu[l], ffn1_w_down[l]),
                       ln1_g[l], ln1_b[l])
        x = layer_norm(DEEPNORM_ALPHA * x + hybrid_mixer(x, w_in[l], w_out[l], attn_sinks[l],
                                                         rope_cos, rope_sin, ret_cos, ret_sin),
                       ln2_g[l], ln2_b[l])
        x = layer_norm(DEEPNORM_ALPHA * x + 0.5 * swiglu_ffn(x, ffn2_w_gu[l], ffn2_w_down[l]),
                       ln3_g[l], ln3_b[l])
    return x
```

```cpp
#include <hip/hip_runtime.h>
#include <hip/hip_cooperative_groups.h>
#include <cstdio>
#include <cstdint>
namespace cg = cooperative_groups;
#ifndef MK_ONE_LAUNCH
#define MK_ONE_LAUNCH 1
#endif
namespace pg8 {
#define PG8_LAS __attribute__((address_space(3)))
typedef unsigned short bf16_t;
typedef short bf16x8 __attribute__((ext_vector_type(8)));
typedef float f32x4 __attribute__((ext_vector_type(4)));
typedef unsigned u32x4 __attribute__((ext_vector_type(4)));
constexpr int BM = 256, BK = 64, HALF = 128, HTB = HALF * BK * 2  , STAGE_BYTES = 8 * HTB, NXCD = 8, WGM = 8;

__host__ __device__ __forceinline__ int lds_byte(int r, int c) { const int st = (r >> 4) * 2 + (c >> 5), rr = r & 15, cc = c & 31, ob = rr * 64 + cc * 2; return st * 1024 + (ob ^ (((ob >> 9) & 1) << 5)); }
__host__ __device__ __forceinline__ void stage_rc(int b, int& R, int& C) { const int st = b / 1024, sb = b % 1024, swz = sb ^ (((sb >> 9) & 1) << 5); R = (st >> 1) * 16 + swz / 64; C = (st & 1) * 32 + (swz % 64) / 2; }
__host__ __device__ __forceinline__ int perm32(int rho) { const int n = rho >> 4, i = rho & 15; return 8 * (i >> 2) + 4 * n + (i & 3); }

struct Unit { int pm, pn; };
struct Gemm { const bf16_t* A; const bf16_t* Bt; int M, N, K; };

struct StaticOrder {
    int nM, nN, nwg, G, c;
    __host__ __device__ void init(int M, int N, int G_, int c_) { nM = M / BM; nN = N / BM; nwg = nM * nN; G = G_; c = c_; }
    __host__ __device__ bool next(int i, Unit& u) const {
        const long L = (long)i * G + c; if (L >= nwg) return false;
        int wgid = (int)L; { const int q = nwg / NXCD, r = nwg % NXCD, xcd = wgid % NXCD, off = wgid / NXCD; wgid = (xcd < r ? xcd * (q + 1) : r * (q + 1) + (xcd - r) * q) + off; }
        const int nig = WGM * nN, gid = wgid / nig, fm = gid * WGM, gsz = (nM - fm) < WGM ? (nM - fm) : WGM;
        u.pm = fm + ((wgid % nig) % gsz); u.pn = (wgid % nig) / gsz; return true;
    }
    __device__ __forceinline__ void a_ready(const Unit&) const {}
    __device__ __forceinline__ void done(const Unit&) const {}
};

__device__ __forceinline__ unsigned cvt_pk_bf16(float lo, float hi) { unsigned r; asm volatile("v_cvt_pk_bf16_f32 %0, %1, %2" : "=v"(r) : "v"(lo), "v"(hi)); return r; }
typedef float f32x2 __attribute__((ext_vector_type(2)));
__device__ __forceinline__ f32x2 gelu_pk(f32x2 v) {
    const f32x2 av = __builtin_elementwise_abs(v), d = av * 0.2316418882f + 1.0f;
    f32x2 t; t.x = __builtin_amdgcn_rcpf(d.x); t.y = __builtin_amdgcn_rcpf(d.y);
    f32x2 q = t * 0.5307027145f + (-0.7265760135f); q = q * t + 0.7107068705f; q = q * t + (-0.142248368f); q = q * t + 0.127414796f; q = q * t;
    const f32x2 s = (v * v) * (-0.72134752044f);
    f32x2 e; e.x = __builtin_amdgcn_exp2f(s.x); e.y = __builtin_amdgcn_exp2f(s.y);
    const f32x2 m = v * (q * e), r = v - m;
    f32x2 o; o.x = v.x < 0.f ? m.x : r.x; o.y = v.y < 0.f ? m.y : r.y; return o;
}

template <int ACT  > struct EpiBf16 {
    static constexpr bool PERM = true, AFTER_DRAIN = false; static_assert(ACT == 0 || ACT == 1, "EpiBf16: ACT is 0 (none) or 1 (gelu_pk)");
    bf16_t* O; int ldc; const float* bias; int split_cols; size_t split_stride; float scale0;
    __device__ __forceinline__ void operator()(const f32x4 (&acc)[2][2][4][2], const Unit& u, int wr, int wc, int fr, int fq) const {
        const int row0 = u.pm * BM + wr * 64 + fr; int colt = u.pn * BM; bf16_t* base = O;
        float sc = 1.f; if (split_cols) { const int t = colt / split_cols; base += (size_t)t * split_stride; colt -= t * split_cols; if (t == 0) sc = scale0; }
        const int col0 = colt + wc * 32 + 8 * fq, bcol0 = u.pn * BM + wc * 32 + 8 * fq;
        f32x4 bv[2][2];
#pragma unroll
        for (int bj = 0; bj < 2; ++bj)
#pragma unroll
            for (int n = 0; n < 2; ++n) bv[bj][n] = bias ? *(const f32x4*)(bias + bcol0 + bj * HALF + 4 * n) : (f32x4){0.f, 0.f, 0.f, 0.f};
#pragma unroll
        for (int ai = 0; ai < 2; ++ai)
#pragma unroll
            for (int m = 0; m < 4; ++m) { bf16_t* rowp = base + (size_t)(row0 + ai * HALF + m * 16) * ldc + col0;
#pragma unroll
                for (int bj = 0; bj < 2; ++bj) { f32x4 v0 = acc[ai][bj][m][0] + bv[bj][0], v1 = acc[ai][bj][m][1] + bv[bj][1];
                    if (ACT == 1) { f32x2 a = gelu_pk((f32x2){v0[0], v0[1]}), b = gelu_pk((f32x2){v0[2], v0[3]}), c = gelu_pk((f32x2){v1[0], v1[1]}), d = gelu_pk((f32x2){v1[2], v1[3]});
                        v0 = (f32x4){a.x, a.y, b.x, b.y}; v1 = (f32x4){c.x, c.y, d.x, d.y}; }
                    v0 = v0 * sc; v1 = v1 * sc; u32x4 w; w.x = cvt_pk_bf16(v0[0], v0[1]); w.y = cvt_pk_bf16(v0[2], v0[3]); w.z = cvt_pk_bf16(v1[0], v1[1]); w.w = cvt_pk_bf16(v1[2], v1[3]);
                    *(u32x4*)(rowp + bj * HALF) = w; } }
    }
};
template <class Epi, class Sched, bool ALIGN_EPI = false, bool SP2 = false>
__device__ __forceinline__ void gemm_phase(PG8_LAS unsigned char* lds, const Gemm g, const Sched& S, const Epi& E) {
    int tid_ = threadIdx.x; asm volatile("" : "+v"(tid_)); const int tid = tid_, wid = __builtin_amdgcn_readfirstlane(tid >> 6), lane = tid & 63, wr = wid >> 2, wc = wid & 3, fr = lane & 15, fq = lane >> 4;
    const int K = g.K, nt = K / BK;
    unsigned voffA[2], voffB[2];
#pragma unroll
    for (int i = 0; i < 2; ++i) { int R, C; stage_rc(tid * 16 + i * 8192, R, C); const int Rb = Epi::PERM ? ((R & ~31) + perm32(R & 31)) : R;
        voffA[i] = (unsigned)(R * K + C) * 2u; voffB[i] = (unsigned)(Rb * K + C) * 2u; }
    const size_t kstep = (size_t)(BK * 2);
    const size_t hstep = (size_t)HALF * K * 2;
    const size_t tstep = 2 * hstep;
    const unsigned ldsw = (unsigned)wid * 1024u;
    const int aoff = lds_byte(wr * 64 + fr, fq * 8), boff = lds_byte(wc * 32 + fr, fq * 8);
#define PG8_SA(b, h) (((b) * 2 + (h)) * HTB)
#define PG8_SB(b, h) ((4 + (b) * 2 + (h)) * HTB)
#define PG8_STAGE(bufoff, gbase, voff) do { _Pragma("unroll") for (int _i = 0; _i < 2; ++_i) \
        __builtin_amdgcn_global_load_lds((const unsigned*)((const char*)(gbase) + (voff)[_i]), (PG8_LAS unsigned*)(lds + (bufoff) + ldsw + _i * 8192), 16, 0, 0); } while (0)
#define PG8_LDA(dst, b, h) do { _Pragma("unroll") for (int m = 0; m < 4; ++m) _Pragma("unroll") for (int k = 0; k < 2; ++k) dst[m][k] = *(const PG8_LAS bf16x8*)(lds + PG8_SA(b, h) + aoff + m * 2048 + k * 1024); } while (0)
#define PG8_LDB(dst, b, h) do { _Pragma("unroll") for (int n = 0; n < 2; ++n) _Pragma("unroll") for (int k = 0; k < 2; ++k) dst[n][k] = *(const PG8_LAS bf16x8*)(lds + PG8_SB(b, h) + boff + n * 2048 + k * 1024); } while (0)
#define PG8_MMA(ai, bj, At, Bt) do { __builtin_amdgcn_s_setprio(1); _Pragma("unroll") for (int m = 0; m < 4; ++m) _Pragma("unroll") for (int n = 0; n < 2; ++n) _Pragma("unroll") for (int k = 0; k < 2; ++k) \
        acc[ai][bj][m][n] = __builtin_amdgcn_mfma_f32_16x16x32_bf16(Bt[n][k], At[m][k], acc[ai][bj][m][n], 0, 0, 0); __builtin_amdgcn_s_setprio(0); } while (0)
#define PG8_WAIT_V(n) asm volatile("s_waitcnt vmcnt(" #n ")" ::: "memory")
#define PG8_WAIT_L(n) asm volatile("s_waitcnt lgkmcnt(" #n ")" ::: "memory")
#define PG8_BAR __builtin_amdgcn_s_barrier()
#define PG8_SCHED __builtin_amdgcn_sched_barrier(0)
    Unit cur, nxt; int ui = 0;
    if (!S.next(0, cur)) return;
    f32x4 acc[2][2][4][2];
#pragma unroll
    for (int a = 0; a < 2; ++a)
#pragma unroll
        for (int b = 0; b < 2; ++b)
#pragma unroll
            for (int m = 0; m < 4; ++m)
#pragma unroll
                for (int n = 0; n < 2; ++n) acc[a][b][m][n] = (f32x4){0.f, 0.f, 0.f, 0.f};
    bf16x8 At[4][2], B0[2][2], B1[2][2];
    const char* cA = (const char*)g.A + (size_t)cur.pm * tstep; const char* cB = (const char*)g.Bt + (size_t)cur.pn * tstep;
    S.a_ready(cur);
    if constexpr (SP2) {
        PG8_STAGE(PG8_SB(0, 0), cB, voffB); PG8_STAGE(PG8_SB(0, 1), cB + hstep, voffB); PG8_STAGE(PG8_SA(0, 0), cA, voffA); PG8_STAGE(PG8_SA(0, 1), cA + hstep, voffA);
        if (wr == 1) PG8_BAR;
        PG8_WAIT_V(2); PG8_BAR;
        PG8_STAGE(PG8_SB(1, 0), cB + kstep, voffB); PG8_STAGE(PG8_SA(1, 0), cA + kstep, voffA); PG8_STAGE(PG8_SB(1, 1), cB + hstep + kstep, voffB);
        PG8_WAIT_V(6); PG8_BAR;
    } else {
        PG8_STAGE(PG8_SB(0, 0), cB, voffB); PG8_STAGE(PG8_SA(0, 0), cA, voffA); PG8_STAGE(PG8_SB(0, 1), cB + hstep, voffB); PG8_STAGE(PG8_SA(0, 1), cA + hstep, voffA);
        if (wr == 1) PG8_BAR;
        PG8_WAIT_V(4); PG8_BAR;
        PG8_STAGE(PG8_SB(1, 0), cB + kstep, voffB); PG8_STAGE(PG8_SA(1, 0), cA + kstep, voffA); PG8_STAGE(PG8_SB(1, 1), cB + hstep + kstep, voffB);
        PG8_WAIT_V(6); PG8_BAR;
    }
    for (;;) {
        const bool has_next = S.next(ui + 1, nxt);
        const char* nA = has_next ? (const char*)g.A + (size_t)nxt.pm * tstep : cA; const char* nB = has_next ? (const char*)g.Bt + (size_t)nxt.pn * tstep : cB;
        for (int t = 0; t < nt; t += 2) {
            const bool last = (t == nt - 2);
            const char* a1 = cA + (size_t)(t + 1) * kstep;
            const char* a2 = last ? nA : cA + (size_t)(t + 2) * kstep; const char* b2 = last ? nB : cB + (size_t)(t + 2) * kstep;
            const char* a3 = a2 + kstep; const char* b3 = b2 + kstep;
            if (last && has_next) S.a_ready(nxt);
            if constexpr (SP2) {
            PG8_LDB(B0, 0, 0); PG8_LDB(B1, 0, 1); PG8_SCHED; PG8_LDA(At, 0, 0); PG8_STAGE(PG8_SA(1, 1), a1 + hstep, voffA);
            PG8_WAIT_V(8); PG8_WAIT_L(0); PG8_BAR; PG8_MMA(0, 0, At, B0); PG8_MMA(0, 1, At, B1); PG8_BAR; PG8_SCHED;
            PG8_LDA(At, 0, 1); PG8_STAGE(PG8_SB(0, 0), b2, voffB); PG8_STAGE(PG8_SB(0, 1), b2 + hstep, voffB); PG8_STAGE(PG8_SA(0, 0), a2, voffA);
            PG8_WAIT_V(8); PG8_WAIT_L(0); PG8_BAR; PG8_MMA(1, 0, At, B0); PG8_MMA(1, 1, At, B1); PG8_BAR; PG8_SCHED;
            PG8_LDB(B0, 1, 0); PG8_LDB(B1, 1, 1); PG8_SCHED; PG8_LDA(At, 1, 0); PG8_STAGE(PG8_SA(0, 1), a2 + hstep, voffA);
            PG8_WAIT_V(8); PG8_WAIT_L(0); PG8_BAR; PG8_MMA(0, 0, At, B0); PG8_MMA(0, 1, At, B1); PG8_BAR; PG8_SCHED;
            PG8_LDA(At, 1, 1); PG8_STAGE(PG8_SB(1, 0), b3, voffB); PG8_STAGE(PG8_SB(1, 1), b3 + hstep, voffB); PG8_STAGE(PG8_SA(1, 0), a3, voffA);
            PG8_WAIT_V(8); PG8_WAIT_L(0); PG8_BAR; PG8_MMA(1, 0, At, B0); PG8_MMA(1, 1, At, B1); PG8_BAR; PG8_SCHED;
            } else {
            PG8_LDB(B0, 0, 0); PG8_SCHED; PG8_LDA(At, 0, 0); PG8_STAGE(PG8_SA(1, 1), a1 + hstep, voffA);
            PG8_WAIT_L(8); PG8_BAR; PG8_WAIT_L(0); PG8_MMA(0, 0, At, B0); PG8_BAR; PG8_SCHED;
            PG8_LDB(B1, 0, 1); PG8_STAGE(PG8_SB(0, 0), b2, voffB);
            PG8_BAR; PG8_WAIT_L(0); PG8_MMA(0, 1, At, B1); PG8_BAR;
            PG8_LDA(At, 0, 1); PG8_STAGE(PG8_SA(0, 0), a2, voffA);
            PG8_BAR; PG8_WAIT_L(0); PG8_MMA(1, 0, At, B0); PG8_BAR; PG8_SCHED;
            PG8_STAGE(PG8_SB(0, 1), b2 + hstep, voffB);
            PG8_WAIT_V(6); PG8_BAR; PG8_MMA(1, 1, At, B1); PG8_BAR;
            PG8_LDB(B0, 1, 0); PG8_SCHED; PG8_LDA(At, 1, 0); PG8_STAGE(PG8_SA(0, 1), a2 + hstep, voffA);
            PG8_WAIT_L(8); PG8_BAR; PG8_WAIT_L(0); PG8_MMA(0, 0, At, B0); PG8_BAR; PG8_SCHED;
            PG8_LDB(B1, 1, 1); PG8_STAGE(PG8_SB(1, 0), b3, voffB);
            PG8_BAR; PG8_WAIT_L(0); PG8_MMA(0, 1, At, B1); PG8_BAR;
            PG8_LDA(At, 1, 1); PG8_STAGE(PG8_SA(1, 0), a3, voffA);
            PG8_BAR; PG8_WAIT_L(0); PG8_MMA(1, 0, At, B0); PG8_BAR; PG8_SCHED;
            PG8_STAGE(PG8_SB(1, 1), b3 + hstep, voffB);
            PG8_WAIT_V(6); PG8_BAR; PG8_MMA(1, 1, At, B1); PG8_BAR;
            }
        }
        if constexpr (ALIGN_EPI) { if (wr == 0) PG8_BAR; }
        if constexpr (!Epi::AFTER_DRAIN) { E(acc, cur, wr, wc, fr, fq); S.done(cur); }
        if (!has_next) break;
#pragma unroll
        for (int a = 0; a < 2; ++a)
#pragma unroll
            for (int b = 0; b < 2; ++b)
#pragma unroll
                for (int m = 0; m < 4; ++m)
#pragma unroll
                    for (int n = 0; n < 2; ++n) acc[a][b][m][n] = (f32x4){0.f, 0.f, 0.f, 0.f};
        cur = nxt; cA = nA; cB = nB; ++ui;
        if constexpr (ALIGN_EPI) { if (wr == 1) PG8_BAR; }
    }
    PG8_WAIT_V(0);
    if constexpr (!ALIGN_EPI) { if (wr == 0) PG8_BAR; }
    PG8_BAR;
    if constexpr (Epi::AFTER_DRAIN) { E.fused(acc, cur, wr, wc, fr, fq, lds, wid, lane); S.done(cur); }
#undef PG8_SA
#undef PG8_SB
#undef PG8_STAGE
#undef PG8_LDA
#undef PG8_LDB
#undef PG8_MMA
#undef PG8_WAIT_V
#undef PG8_WAIT_L
#undef PG8_BAR
#undef PG8_SCHED
}
}

#define DI __device__ __forceinline__
#define LAS __attribute__((address_space(3)))
typedef unsigned short bf16;
typedef short bf16x8 __attribute__((ext_vector_type(8)));
typedef short s16x4 __attribute__((ext_vector_type(4)));
typedef float f32x4 __attribute__((ext_vector_type(4)));
typedef float f32x2 __attribute__((ext_vector_type(2)));
typedef float f32x16 __attribute__((ext_vector_type(16)));
typedef unsigned u32x4 __attribute__((ext_vector_type(4)));
typedef unsigned u32x2 __attribute__((ext_vector_type(2)));
typedef __bf16 bf16x2_t __attribute__((ext_vector_type(2)));
typedef LAS unsigned char lds_u8;

constexpr int NWAVES = 8, NTHREADS = 512;
constexpr int BATCH = 8, SEQ = 4096, D = 1024, DEPTH = 4, M = BATCH * SEQ;
constexpr int HD = 64, FF = 2816, INW = 2816, GUW = 2 * FF;
constexpr float ALPHA = 1.681792830507429f;
constexpr float LN_EPS = 1e-5f, GN_EPS = 1e-6f;
constexpr float LOG2E = 1.4426950408889634f;
constexpr float QSCALE = 0.125f * LOG2E;

constexpr size_t MiB = 1u << 20;
constexpr size_t WS_TAB = 1 * MiB;
constexpr size_t WS_WGU1 = 4 * MiB, WS_WD1 = 16 * MiB, WS_WGU2 = 22 * MiB, WS_WD2 = 34 * MiB, WS_WIN = 40 * MiB, WS_WOUT = 46 * MiB;
constexpr size_t WS_XB = 48 * MiB;
constexpr size_t WS_HB = 112 * MiB;
constexpr size_t WS_YM = 288 * MiB;
constexpr size_t WS_END = 352 * MiB;
constexpr int LDS_BYTES = 147456;

DI unsigned cvtpk(float lo, float hi) { f32x2 v = {lo, hi}; bf16x2_t b = __builtin_convertvector(v, bf16x2_t); return __builtin_bit_cast(unsigned, b); }
DI float bf2f(unsigned short b) { return __uint_as_float((unsigned)b << 16); }
DI float fast_exp2(float x) { return __builtin_amdgcn_exp2f(x); }
DI float fast_rcp(float x) { return __builtin_amdgcn_rcpf(x); }
DI float silu_f(float a) { return a * fast_rcp(1.0f + fast_exp2(-a * LOG2E)); }
DI float wave_sum(float v) {
#pragma unroll
    for (int o = 1; o < 64; o <<= 1) v += __shfl_xor(v, o);
    return v;
}
DI int opaque_tid() { int t = threadIdx.x; asm volatile("" : "+v"(t)); return t; }
DI int crow(int r, int hi) { return (r & 3) + 8 * (r >> 2) + 4 * hi; }
#define MFMA32(a, b, c) __builtin_amdgcn_mfma_f32_32x32x16_bf16((a), (b), (c), 0, 0, 0)

namespace pg8 {
struct EpiSwiGLU {
    static constexpr bool PERM = true, AFTER_DRAIN = false;
    bf16_t* H;
    __device__ __forceinline__ void operator()(const f32x4 (&acc)[2][2][4][2], const Unit& u, int wr, int wc, int fr, int fq) const {
        const int row0 = u.pm * BM + wr * 64 + fr, col0 = u.pn * 128 + wc * 32 + 8 * fq;
#pragma unroll
        for (int ai = 0; ai < 2; ++ai)
#pragma unroll
            for (int m = 0; m < 4; ++m) {
                bf16_t* rowp = H + (size_t)(row0 + ai * HALF + m * 16) * FF + col0;
                float h[8];
#pragma unroll
                for (int n = 0; n < 2; ++n)
#pragma unroll
                    for (int j = 0; j < 4; ++j) h[n * 4 + j] = silu_f(acc[ai][0][m][n][j]) * acc[ai][1][m][n][j];
                u32x4 w; w.x = cvtpk(h[0], h[1]); w.y = cvtpk(h[2], h[3]); w.z = cvtpk(h[4], h[5]); w.w = cvtpk(h[6], h[7]);
                *(u32x4*)rowp = w;
            }
    }
};
struct EpiResid {
    static constexpr bool PERM = false, AFTER_DRAIN = false;
    const float* X; float* Y; float s;
    __device__ __forceinline__ void operator()(const f32x4 (&acc)[2][2][4][2], const Unit& u, int wr, int wc, int fr, int fq) const {
        const int col0 = u.pn * BM + wc * 32 + 4 * fq;
#pragma unroll
        for (int ai = 0; ai < 2; ++ai)
#pragma unroll
            for (int m = 0; m < 4; ++m) {
                const size_t off = (size_t)(u.pm * BM + ai * HALF + wr * 64 + m * 16 + fr) * D + col0;
#pragma unroll
                for (int bj = 0; bj < 2; ++bj)
#pragma unroll
                    for (int n = 0; n < 2; ++n) {
                        const f32x4 xv = *(const f32x4*)(X + off + bj * HALF + n * 16);
                        *(f32x4*)(Y + off + bj * HALF + n * 16) = xv * ALPHA + acc[ai][bj][m][n] * s;
                    }
            }
    }
};
struct EpiInProj {
    static constexpr bool PERM = true, AFTER_DRAIN = false;
    bf16_t* O; const float* tab;
    __device__ __forceinline__ void operator()(const f32x4 (&acc)[2][2][4][2], const Unit& u, int wr, int wc, int fr, int fq) const {
        const int pn = u.pn;
        int mode;
        float sc = 1.f;
        if (pn < 2) { mode = 1; sc = QSCALE; } else if (pn == 2) { mode = (wc < 2) ? 1 : 0; } else if (pn < 5) { mode = 2; } else if (pn < 7) { mode = 2; sc = 0.125f; } else if (pn < 9) { mode = 0; } else { mode = 3; }
        const int row0 = u.pm * BM + wr * 64 + fr, col0 = pn * 256 + wc * 64 + 8 * fq;
        const float* rc = tab; const float* rs = tab + SEQ * 32; const float* tc = tab + 2 * SEQ * 32; const float* ts = tab + 3 * SEQ * 32;
#pragma unroll
        for (int ai = 0; ai < 2; ++ai)
#pragma unroll
            for (int m = 0; m < 4; ++m) {
                const int row = row0 + ai * HALF + m * 16, pos = row & (SEQ - 1);
                bf16_t* rowp = O + (size_t)row * INW + col0;
                float o[2][8];
                if (mode == 1) {
#pragma unroll
                    for (int n = 0; n < 2; ++n) {
                        const f32x4 c = *(const f32x4*)(rc + pos * 32 + 8 * fq + 4 * n), s = *(const f32x4*)(rs + pos * 32 + 8 * fq + 4 * n);
#pragma unroll
                        for (int j = 0; j < 4; ++j) { const float x1 = acc[ai][0][m][n][j], x2 = acc[ai][1][m][n][j];
                            o[0][n * 4 + j] = (x1 * c[j] - x2 * s[j]) * sc; o[1][n * 4 + j] = (x2 * c[j] + x1 * s[j]) * sc; }
                    }
                } else if (mode == 2) {
#pragma unroll
                    for (int bj = 0; bj < 2; ++bj)
#pragma unroll
                        for (int n = 0; n < 2; ++n) {
                            const f32x2 c = *(const f32x2*)(tc + pos * 32 + bj * 16 + 4 * fq + 2 * n), s = *(const f32x2*)(ts + pos * 32 + bj * 16 + 4 * fq + 2 * n);
#pragma unroll
                            for (int p = 0; p < 2; ++p) { const float xe = acc[ai][bj][m][n][2 * p], xo = acc[ai][bj][m][n][2 * p + 1];
                                o[bj][n * 4 + 2 * p] = (xe * c[p] - xo * s[p]) * sc; o[bj][n * 4 + 2 * p + 1] = (xo * c[p] + xe * s[p]) * sc; }
                        }
                } else {
#pragma unroll
                    for (int bj = 0; bj < 2; ++bj)
#pragma unroll
                        for (int n = 0; n < 2; ++n)
#pragma unroll
                            for (int j = 0; j < 4; ++j) { const float v = acc[ai][bj][m][n][j]; o[bj][n * 4 + j] = (mode == 3) ? silu_f(v) : v; }
                }
#pragma unroll
                for (int bj = 0; bj < 2; ++bj) {
                    u32x4 w; w.x = cvtpk(o[bj][0], o[bj][1]); w.y = cvtpk(o[bj][2], o[bj][3]); w.z = cvtpk(o[bj][4], o[bj][5]); w.w = cvtpk(o[bj][6], o[bj][7]);
                    *(u32x4*)(rowp + bj * 32) = w;
                }
            }
    }
};
}

struct Args {
    const float* x; const float* w_in; const float* w_out; const float* sinks;
    const float* w_gu1; const float* w_d1; const float* w_gu2; const float* w_d2;
    const float* ln_g0; const float* ln_g1; const float* ln_g2; const float* ln_b0; const float* ln_b1; const float* ln_b2;
    float* out; unsigned char* ws; int ph_lo, ph_hi;
};

DI void transpose_item(const float* W, int K, int Nsrc, int srcbase, bf16* WT, int n0, int k0, LAS float* scr, int lane) {
#pragma unroll 8
    for (int i = 0; i < 32; ++i) { const int kk = 2 * i + (lane >> 5); scr[kk * 33 + (lane & 31)] = W[(size_t)(k0 + kk) * Nsrc + srcbase + (lane & 31)]; }
    asm volatile("s_waitcnt lgkmcnt(0)" ::: "memory");
    const int c = lane & 7;
#pragma unroll
    for (int j = 0; j < 4; ++j) { const int n = (lane >> 3) + 8 * j; const LAS float* s = scr + (8 * c) * 33 + n;
        u32x4 o; o.x = cvtpk(s[0 * 33], s[1 * 33]); o.y = cvtpk(s[2 * 33], s[3 * 33]); o.z = cvtpk(s[4 * 33], s[5 * 33]); o.w = cvtpk(s[6 * 33], s[7 * 33]);
        *(u32x4*)(WT + (size_t)(n0 + n) * K + k0 + 8 * c) = o; }
    asm volatile("s_waitcnt lgkmcnt(0)" ::: "memory");
}
DI int src_col(int which, int n0) {
    if (which == 0) { const int pn = n0 >> 8, c = n0 & 255; return (c >> 7) * FF + pn * 128 + (c & 127); }
    if (which == 2) { const int pn = n0 >> 8, c = n0 & 255; return pn * 256 + ((c & 127) >> 5) * 64 + (c >> 7) * 32 + (c & 31); }
    return n0;
}
DI void convert_matrix_items(const float* W, int K, int N, int which, bf16* WT, LAS float* scr, int lane, int first, int gw, int NGW) {
    const int nblk = N / 32, nitems = (K / 64) * nblk;
    int it = gw - (first % NGW); if (it < 0) it += NGW;
    for (; it < nitems; it += NGW) { const int kb = it / nblk, nb = it % nblk; transpose_item(W, K, N, src_col(which, nb * 32), WT, nb * 32, kb * 64, scr, lane); }
}
DI void convert_layer_weights(const Args& a, int l, LAS unsigned char* lds, int wave, int lane, int gw, int NGW) {
    LAS float* scr = (LAS float*)(lds + wave * 16384);
    unsigned char* ws = a.ws;
    constexpr int I_GU = (D / 64) * (GUW / 32), I_D = (FF / 64) * (D / 32), I_IN = (D / 64) * (INW / 32), I_OUT = (D / 64) * (D / 32);
    int first = 0;
    convert_matrix_items(a.w_gu1 + (size_t)l * D * GUW, D, GUW, 0, (bf16*)(ws + WS_WGU1), scr, lane, first, gw, NGW); first += I_GU;
    convert_matrix_items(a.w_d1 + (size_t)l * FF * D, FF, D, 1, (bf16*)(ws + WS_WD1), scr, lane, first, gw, NGW); first += I_D;
    convert_matrix_items(a.w_in + (size_t)l * D * INW, D, INW, 2, (bf16*)(ws + WS_WIN), scr, lane, first, gw, NGW); first += I_IN;
    convert_matrix_items(a.w_out + (size_t)l * D * D, D, D, 1, (bf16*)(ws + WS_WOUT), scr, lane, first, gw, NGW); first += I_OUT;
    convert_matrix_items(a.w_gu2 + (size_t)l * D * GUW, D, GUW, 0, (bf16*)(ws + WS_WGU2), scr, lane, first, gw, NGW); first += I_GU;
    convert_matrix_items(a.w_d2 + (size_t)l * FF * D, FF, D, 1, (bf16*)(ws + WS_WD2), scr, lane, first, gw, NGW);
}
DI void sincos_d(double x, float& c, float& s) {
    const double TWO_PI = 6.283185307179586476925;
    const double k = __builtin_rint(x / TWO_PI), r = x - k * TWO_PI, r2 = r * r;
    double sn = r, cs = 1.0, tsn = r, tcs = 1.0;
#pragma unroll 1
    for (int i = 1; i <= 15; ++i) { tcs *= -r2 / (double)((2 * i - 1) * (2 * i)); cs += tcs; tsn *= -r2 / (double)((2 * i) * (2 * i + 1)); sn += tsn; }
    c = (float)cs; s = (float)sn;
}
DI void build_tables(float* tab, int gtid, int nthreads) {
    for (int e = gtid; e < 2 * SEQ * 32; e += nthreads) {
        const int which = e / (SEQ * 32), r = e % (SEQ * 32), pos = r >> 5, i = r & 31;
        const double base = which == 0 ? 0.7498942093324558 : 0.7429639507594947;
        double f = 1.0;
#pragma unroll 1
        for (int k = 0; k < i; ++k) f *= base;
        float c, s; sincos_d((double)pos * f, c, s);
        tab[(size_t)(2 * which) * SEQ * 32 + r] = c; tab[(size_t)(2 * which + 1) * SEQ * 32 + r] = s;
    }
}
DI void row_to_bf16(const float* xrow, bf16* orow, int lane) {
    const f32x4* xr = (const f32x4*)xrow + lane; u32x2* o8 = (u32x2*)orow + lane;
#pragma unroll
    for (int j = 0; j < 4; ++j) { const f32x4 v = xr[64 * j]; u32x2 w; w.x = cvtpk(v[0], v[1]); w.y = cvtpk(v[2], v[3]); o8[64 * j] = w; }
}
DI void ln_row(const float* yrow, float* xrow, bf16* brow, const float* g, const float* b, int lane) {
    const f32x4* yr = (const f32x4*)yrow + lane;
    f32x4 v[4]; float s = 0.f;
#pragma unroll
    for (int j = 0; j < 4; ++j) { v[j] = yr[64 * j]; s += (v[j][0] + v[j][1]) + (v[j][2] + v[j][3]); }
    const float mean = wave_sum(s) * (1.f / D); float s2 = 0.f;
#pragma unroll
    for (int j = 0; j < 4; ++j) { v[j] = v[j] - mean; s2 += (v[j][0] * v[j][0] + v[j][1] * v[j][1]) + (v[j][2] * v[j][2] + v[j][3] * v[j][3]); }
    const float rstd = 1.f / sqrtf(wave_sum(s2) * (1.f / D) + LN_EPS);
    f32x4* xo = (f32x4*)xrow + lane; u32x2* bo = (u32x2*)brow + lane;
#pragma unroll
    for (int j = 0; j < 4; ++j) {
        const f32x4 gg = ((const f32x4*)g)[lane + 64 * j], bb = ((const f32x4*)b)[lane + 64 * j];
        const f32x4 o = v[j] * rstd * gg + bb; xo[64 * j] = o;
        u32x2 w; w.x = cvtpk(o[0], o[1]); w.y = cvtpk(o[2], o[3]); bo[64 * j] = w;
    }
}

constexpr int A_KS = 0, A_KSTR = 72 * 2;
constexpr int A_VT = 256 * A_KSTR, A_VSTR = 264 * 2;
constexpr int A_STG = A_VT + 64 * A_VSTR, STG_STR = 72 * 2, STG_BYTES = 32 * STG_STR;
static_assert(A_STG + 8 * STG_BYTES <= 131072, "attention LDS");

DI void stage_out_store(lds_u8* stg, const f32x16 (&o)[2], int r32, int hi) {
#pragma unroll
    for (int db = 0; db < 2; ++db)
#pragma unroll
        for (int rg = 0; rg < 4; ++rg) {
            u32x2 w; w.x = cvtpk(o[db][4 * rg], o[db][4 * rg + 1]); w.y = cvtpk(o[db][4 * rg + 2], o[db][4 * rg + 3]);
            *(LAS u32x2*)(stg + r32 * STG_STR + (db * 32 + 8 * rg + 4 * hi) * 2) = w;
        }
}

DI void attn_unit(lds_u8* lds, const bf16* HM, bf16* YM, const float* sinks, int b, int g, int n) {
    const int tid = opaque_tid(), lane = tid & 63, r32 = lane & 31, hi = lane >> 5, wid = __builtin_amdgcn_readfirstlane(tid >> 6);
    const long keyrow0 = (long)b * SEQ + n * 128 - 128;
    {
        const int token = tid & 255; const bool valid = (n > 0) || (token >= 128);
        const bf16* src = HM + (keyrow0 + token) * INW + 512 + g * 64;
#pragma unroll
        for (int i = 0; i < 4; ++i) {
            const int dc = (tid >> 8) + 2 * i;
            u32x4 kv = {0u, 0u, 0u, 0u}, vv = {0u, 0u, 0u, 0u};
            if (valid) { kv = *(const u32x4*)(src + dc * 8); vv = *(const u32x4*)(src + 128 + dc * 8); }
            *(LAS u32x4*)(lds + A_KS + token * A_KSTR + dc * 16) = kv;
            const bf16x8 v8 = __builtin_bit_cast(bf16x8, vv);
#pragma unroll
            for (int ii = 0; ii < 8; ++ii) *(LAS short*)(lds + A_VT + (dc * 8 + ii) * A_VSTR + token * 2) = v8[ii];
        }
    }
    __syncthreads();
    const int hq = g * 4 + (wid >> 1);
    const float sink2 = sinks[hq] * LOG2E;
    lds_u8* stg = lds + A_STG + wid * STG_BYTES;
    const int jmin = (n == 0) ? 128 : 0;
#pragma unroll 1
    for (int qb = 0; qb < 2; ++qb) {
        const int i0 = (wid & 1) * 64 + qb * 32, iq = i0 + r32;
        const long qrow = (long)b * SEQ + n * 128 + iq;
        bf16x8 qf[4];
#pragma unroll
        for (int ks = 0; ks < 4; ++ks) qf[ks] = *(const bf16x8*)(HM + qrow * INW + hq * 64 + ks * 16 + hi * 8);
        float mrun = sink2, lrun = (hi == 0) ? 1.f : 0.f;
        f32x16 o[2];
#pragma unroll
        for (int r = 0; r < 16; ++r) { o[0][r] = 0.f; o[1][r] = 0.f; }
#pragma unroll 1
        for (int t = 0; t < 5; ++t) {
            const int kb = i0 + 32 * t;
            f32x16 s;
#pragma unroll
            for (int r = 0; r < 16; ++r) s[r] = 0.f;
#pragma unroll
            for (int ks = 0; ks < 4; ++ks) {
                const bf16x8 kf = *(const LAS bf16x8*)(lds + A_KS + (kb + r32) * A_KSTR + (ks * 16 + hi * 8) * 2);
                s = MFMA32(kf, qf[ks], s);
            }
            float tmax = -INFINITY;
#pragma unroll
            for (int r = 0; r < 16; ++r) { const int jj = kb + crow(r, hi); const bool vis = (jj > iq) && (jj <= iq + 128) && (jj >= jmin); s[r] = vis ? s[r] : -INFINITY; tmax = fmaxf(tmax, s[r]); }
            tmax = fmaxf(tmax, __shfl_xor(tmax, 32));
            const float mnew = fmaxf(mrun, tmax), scl = fast_exp2(mrun - mnew);
            mrun = mnew;
            float psum = 0.f;
#pragma unroll
            for (int r = 0; r < 16; ++r) { s[r] = fast_exp2(s[r] - mnew); psum += s[r]; }
            lrun = lrun * scl + psum;
#pragma unroll
            for (int r = 0; r < 16; ++r) { o[0][r] *= scl; o[1][r] *= scl; }
#pragma unroll
            for (int gk = 0; gk < 2; ++gk) {
                u32x4 pw; pw.x = cvtpk(s[8 * gk], s[8 * gk + 1]); pw.y = cvtpk(s[8 * gk + 2], s[8 * gk + 3]); pw.z = cvtpk(s[8 * gk + 4], s[8 * gk + 5]); pw.w = cvtpk(s[8 * gk + 6], s[8 * gk + 7]);
                const bf16x8 pf = __builtin_bit_cast(bf16x8, pw);
#pragma unroll
                for (int db = 0; db < 2; ++db) {
                    const lds_u8* vp = lds + A_VT + (db * 32 + r32) * A_VSTR + (kb + 16 * gk + 4 * hi) * 2;
                    const s16x4 lo = *(const LAS s16x4*)vp, hi4 = *(const LAS s16x4*)(vp + 16);
                    const bf16x8 vf = __builtin_shufflevector(lo, hi4, 0, 1, 2, 3, 4, 5, 6, 7);
                    o[db] = MFMA32(vf, pf, o[db]);
                }
            }
        }
        const float ltot = lrun + __shfl_xor(lrun, 32), inv = 1.0f / ltot;
#pragma unroll
        for (int r = 0; r < 16; ++r) { o[0][r] *= inv; o[1][r] *= inv; }
        stage_out_store(stg, o, r32, hi);
        asm volatile("s_waitcnt lgkmcnt(0)" ::: "memory");
        bf16* yw = YM + ((long)b * SEQ + n * 128 + i0) * D + hq * 64;
#pragma unroll
        for (int it = 0; it < 4; ++it) { const int row = it * 8 + (lane >> 3), ch = lane & 7;
            const u32x4 v = *(const LAS u32x4*)(stg + row * STG_STR + ch * 16); *(u32x4*)(yw + (long)row * D + ch * 8) = v; }
        asm volatile("s_waitcnt lgkmcnt(0)" ::: "memory");
    }
    __syncthreads();
}

constexpr int R_QS = 0, R_KS = 128 * 144, R_VT = 2 * 128 * 144, R_TSTR = 136 * 2, R_KT = R_VT + 64 * R_TSTR, R_ST = R_KT + 64 * R_TSTR, R_STG = R_ST + 64 * 144;
static_assert(R_STG + 4 * STG_BYTES <= 131072, "retention LDS");

DI void ret_unit(lds_u8* lds, const bf16* HM, bf16* YM, int b, int h) {
    const int tid = opaque_tid(), lane = tid & 63, r32 = lane & 31, hi = lane >> 5, wid = __builtin_amdgcn_readfirstlane(tid >> 6);
    float lg2;
    { const double x = __builtin_ldexp(1.0, -5 - h); double t = x, s = 0.0;
#pragma unroll 1
      for (int k = 1; k <= 10; ++k) { s -= t / (double)k; t *= x; }
      lg2 = (float)(s * 1.4426950408889634); }
    const float gchunk = fast_exp2(128.f * lg2);
    const int token = tid & 127, dc0 = tid >> 7;
    const float wk = fast_exp2((float)(127 - token) * lg2);
    const long row0 = (long)b * SEQ;
    for (int i = tid; i < 64 * 144 / 4; i += NTHREADS) *(LAS unsigned*)(lds + R_ST + i * 4) = 0u;
    f32x16 st;
#pragma unroll
    for (int r = 0; r < 16; ++r) st[r] = 0.f;
    u32x4 pq[2], pk[2], pv[2];
    { const bf16* src = HM + (row0 + token) * INW + h * 64;
#pragma unroll
      for (int i = 0; i < 2; ++i) { const int dc = dc0 + 4 * i; pq[i] = *(const u32x4*)(src + 768 + dc * 8); pk[i] = *(const u32x4*)(src + 1280 + dc * 8); pv[i] = *(const u32x4*)(src + 1792 + dc * 8); } }
#pragma unroll 1
    for (int n = 0; n < 32; ++n) {
#pragma unroll
        for (int i = 0; i < 2; ++i) {
            const int dc = dc0 + 4 * i;
            *(LAS u32x4*)(lds + R_QS + token * 144 + dc * 16) = pq[i];
            *(LAS u32x4*)(lds + R_KS + token * 144 + dc * 16) = pk[i];
            const bf16x8 k8 = __builtin_bit_cast(bf16x8, pk[i]), v8 = __builtin_bit_cast(bf16x8, pv[i]);
#pragma unroll
            for (int ii = 0; ii < 8; ii += 2) {
                const unsigned kk = cvtpk(bf2f((unsigned short)k8[ii]) * wk, bf2f((unsigned short)k8[ii + 1]) * wk);
                *(LAS short*)(lds + R_KT + (dc * 8 + ii) * R_TSTR + token * 2) = (short)(kk & 0xffffu);
                *(LAS short*)(lds + R_KT + (dc * 8 + ii + 1) * R_TSTR + token * 2) = (short)(kk >> 16);
                *(LAS short*)(lds + R_VT + (dc * 8 + ii) * R_TSTR + token * 2) = v8[ii];
                *(LAS short*)(lds + R_VT + (dc * 8 + ii + 1) * R_TSTR + token * 2) = v8[ii + 1];
            }
        }
        __syncthreads();
        if (n + 1 < 32) { const bf16* src = HM + (row0 + (n + 1) * 128 + token) * INW + h * 64;
#pragma unroll
            for (int i = 0; i < 2; ++i) { const int dc = dc0 + 4 * i; pq[i] = *(const u32x4*)(src + 768 + dc * 8); pk[i] = *(const u32x4*)(src + 1280 + dc * 8); pv[i] = *(const u32x4*)(src + 1792 + dc * 8); } }
        if (wid < 4) {
            const int ib = wid, iq = 32 * ib + r32;
            bf16x8 qf[4];
#pragma unroll
            for (int ks = 0; ks < 4; ++ks) qf[ks] = *(const LAS bf16x8*)(lds + R_QS + iq * 144 + (ks * 16 + hi * 8) * 2);
            f32x16 o[2];
#pragma unroll
            for (int r = 0; r < 16; ++r) { o[0][r] = 0.f; o[1][r] = 0.f; }
#pragma unroll
            for (int eb = 0; eb < 2; ++eb)
#pragma unroll
                for (int ks = 0; ks < 4; ++ks) {
                    const bf16x8 sf = *(const LAS bf16x8*)(lds + R_ST + (eb * 32 + r32) * 144 + (ks * 16 + hi * 8) * 2);
                    o[eb] = MFMA32(sf, qf[ks], o[eb]);
                }
            const float wq = fast_exp2((float)(iq + 1) * lg2);
#pragma unroll
            for (int r = 0; r < 16; ++r) { o[0][r] *= wq; o[1][r] *= wq; }
#pragma unroll 1
            for (int jb = 0; jb <= ib; ++jb) {
                f32x16 s;
#pragma unroll
                for (int r = 0; r < 16; ++r) s[r] = 0.f;
#pragma unroll
                for (int ks = 0; ks < 4; ++ks) {
                    const bf16x8 kf = *(const LAS bf16x8*)(lds + R_KS + (jb * 32 + r32) * 144 + (ks * 16 + hi * 8) * 2);
                    s = MFMA32(kf, qf[ks], s);
                }
#pragma unroll
                for (int r = 0; r < 16; ++r) { const int dj = iq - (jb * 32 + crow(r, hi)); s[r] = (dj >= 0) ? s[r] * fast_exp2((float)dj * lg2) : 0.f; }
#pragma unroll
                for (int gk = 0; gk < 2; ++gk) {
                    u32x4 pw; pw.x = cvtpk(s[8 * gk], s[8 * gk + 1]); pw.y = cvtpk(s[8 * gk + 2], s[8 * gk + 3]); pw.z = cvtpk(s[8 * gk + 4], s[8 * gk + 5]); pw.w = cvtpk(s[8 * gk + 6], s[8 * gk + 7]);
                    const bf16x8 pf = __builtin_bit_cast(bf16x8, pw);
#pragma unroll
                    for (int eb = 0; eb < 2; ++eb) {
                        const lds_u8* vp = lds + R_VT + (eb * 32 + r32) * R_TSTR + (jb * 32 + 16 * gk + 4 * hi) * 2;
                        const s16x4 lo = *(const LAS s16x4*)vp, hi4 = *(const LAS s16x4*)(vp + 16);
                        const bf16x8 vf = __builtin_shufflevector(lo, hi4, 0, 1, 2, 3, 4, 5, 6, 7);
                        o[eb] = MFMA32(vf, pf, o[eb]);
                    }
                }
            }
            float sm = 0.f;
#pragma unroll
            for (int r = 0; r < 16; ++r) sm += o[0][r] + o[1][r];
            sm += __shfl_xor(sm, 32);
            const float mu = sm * (1.f / 64.f);
            float sq = 0.f;
#pragma unroll
            for (int r = 0; r < 16; ++r) { o[0][r] -= mu; o[1][r] -= mu; sq += o[0][r] * o[0][r] + o[1][r] * o[1][r]; }
            sq += __shfl_xor(sq, 32);
            const float rstd = 1.f / sqrtf(sq * (1.f / 64.f) + GN_EPS);
#pragma unroll
            for (int r = 0; r < 16; ++r) { o[0][r] *= rstd; o[1][r] *= rstd; }
            lds_u8* stg = lds + R_STG + wid * STG_BYTES;
            stage_out_store(stg, o, r32, hi);
            asm volatile("s_waitcnt lgkmcnt(0)" ::: "memory");
            const long trow = row0 + n * 128 + 32 * ib;
#pragma unroll
            for (int it = 0; it < 4; ++it) { const int row = it * 8 + (lane >> 3), ch = lane & 7;
                const u32x4 ov = *(const LAS u32x4*)(stg + row * STG_STR + ch * 16);
                const u32x4 gv = *(const u32x4*)(HM + (trow + row) * INW + 2304 + h * 64 + ch * 8);
                const bf16x8 o8 = __builtin_bit_cast(bf16x8, ov), g8 = __builtin_bit_cast(bf16x8, gv);
                u32x4 w;
                w.x = cvtpk(bf2f((unsigned short)o8[0]) * bf2f((unsigned short)g8[0]), bf2f((unsigned short)o8[1]) * bf2f((unsigned short)g8[1]));
                w.y = cvtpk(bf2f((unsigned short)o8[2]) * bf2f((unsigned short)g8[2]), bf2f((unsigned short)o8[3]) * bf2f((unsigned short)g8[3]));
                w.z = cvtpk(bf2f((unsigned short)o8[4]) * bf2f((unsigned short)g8[4]), bf2f((unsigned short)o8[5]) * bf2f((unsigned short)g8[5]));
                w.w = cvtpk(bf2f((unsigned short)o8[6]) * bf2f((unsigned short)g8[6]), bf2f((unsigned short)o8[7]) * bf2f((unsigned short)g8[7]));
                *(u32x4*)(YM + (trow + row) * D + 512 + h * 64 + ch * 8) = w; }
        } else {
            const int eb = (wid - 4) >> 1, dk = (wid - 4) & 1;
#pragma unroll
            for (int r = 0; r < 16; ++r) st[r] *= gchunk;
#pragma unroll
            for (int ks = 0; ks < 8; ++ks) {
                const bf16x8 vf = *(const LAS bf16x8*)(lds + R_VT + (eb * 32 + r32) * R_TSTR + (ks * 16 + hi * 8) * 2);
                const bf16x8 kf = *(const LAS bf16x8*)(lds + R_KT + (dk * 32 + r32) * R_TSTR + (ks * 16 + hi * 8) * 2);
                st = MFMA32(vf, kf, st);
            }
        }
        __syncthreads();
        if (wid >= 4) {
            const int eb = (wid - 4) >> 1, dk = (wid - 4) & 1;
#pragma unroll
            for (int r = 0; r < 16; ++r) *(LAS short*)(lds + R_ST + (eb * 32 + crow(r, hi)) * 144 + (dk * 32 + r32) * 2) = (short)(cvtpk(st[r], 0.f) & 0xffffu);
        }
    }
    __syncthreads();
}

#ifdef SKIP_RET
#define RET_UNIT(bb, hh)
#else
#define RET_UNIT(bb, hh) ret_unit(lds, HB, YM, (bb), (hh))
#endif
#ifdef SKIP_ATT
#define ATT_UNIT(bb, gg, nn)
#else
#define ATT_UNIT(bb, gg, nn) attn_unit(lds, HB, YM, a.sinks + l * 8, (bb), (gg), (nn))
#endif
__global__ void __launch_bounds__(NTHREADS, 2) mk_fwd(Args a) {
    extern __shared__ __attribute__((aligned(16))) unsigned char lds_raw[];
    LAS unsigned char* lds = (LAS unsigned char*)lds_raw;
    const int G = gridDim.x, bx = blockIdx.x;
    const int vcu = (G % 8 == 0) ? (bx % 8) * (G / 8) + bx / 8 : bx;
    const int NGW = G * NWAVES;
    unsigned char* ws = a.ws;
    float* tab = (float*)(ws + WS_TAB);
    bf16* XB = (bf16*)(ws + WS_XB); bf16* HB = (bf16*)(ws + WS_HB); bf16* YM = (bf16*)(ws + WS_YM);
    float* X = a.out;
#pragma unroll 1
    for (int ph = a.ph_lo; ph < a.ph_hi; ++ph) {
        const int tid = opaque_tid(), lane = tid & 63, wave = __builtin_amdgcn_readfirstlane(tid >> 6), gw = vcu * NWAVES + wave;
        if (ph == 0) {
            build_tables(tab, vcu * NTHREADS + tid, G * NTHREADS);
            convert_layer_weights(a, 0, lds, wave, lane, gw, NGW);
            for (int m = gw; m < M; m += NGW) row_to_bf16(a.x + (size_t)m * D, XB + (size_t)m * D, lane);
        } else {
            const int l = (ph - 1) / 10, s = (ph - 1) % 10;
            if (s == 0 || s == 7) {
                pg8::Gemm g{XB, (const bf16*)(ws + (s == 0 ? WS_WGU1 : WS_WGU2)), M, GUW, D}; pg8::StaticOrder S; S.init(M, GUW, G, bx);
                pg8::EpiSwiGLU E{HB};
#ifndef SKIP_UP
                pg8::gemm_phase<pg8::EpiSwiGLU, pg8::StaticOrder, true, true>(lds, g, S, E);
#endif
            } else if (s == 1 || s == 5 || s == 8) {
                const bf16* A = (s == 5) ? YM : HB; const int K = (s == 5) ? D : FF;
                const bf16* Bt = (const bf16*)(ws + (s == 1 ? WS_WD1 : (s == 5 ? WS_WOUT : WS_WD2)));
                pg8::Gemm g{A, Bt, M, D, K}; pg8::StaticOrder S; S.init(M, D, G, bx);
                pg8::EpiResid E{(l == 0 && s == 1) ? a.x : X, X, (s == 5) ? 1.0f : 0.5f};
#ifndef SKIP_DOWN
                pg8::gemm_phase<pg8::EpiResid, pg8::StaticOrder, true, true>(lds, g, S, E);
#endif
            } else if (s == 3) {
                pg8::Gemm g{XB, (const bf16*)(ws + WS_WIN), M, INW, D}; pg8::StaticOrder S; S.init(M, INW, G, bx);
                pg8::EpiInProj E{HB, tab};
#ifndef SKIP_INP
                pg8::gemm_phase<pg8::EpiInProj, pg8::StaticOrder, true, true>(lds, g, S, E);
#endif
            } else if (s == 4) {
                const int NRET = 64;
#ifndef SKIP_MIX
                if (G > NRET) {
                    if (vcu < NRET) { RET_UNIT(vcu >> 3, vcu & 7); }
                    else for (int u = vcu - NRET; u < BATCH * 2 * 32; u += G - NRET) { ATT_UNIT(u >> 6, (u >> 5) & 1, u & 31); }
                } else {
                    for (int u = vcu; u < NRET; u += G) { RET_UNIT(u >> 3, u & 7); }
                    for (int u = vcu; u < BATCH * 2 * 32; u += G) { ATT_UNIT(u >> 6, (u >> 5) & 1, u & 31); }
                }
#endif
            } else {
                const int k = (s == 2) ? 0 : (s == 6 ? 1 : 2);
                const float* gp = (k == 0 ? a.ln_g0 : (k == 1 ? a.ln_g1 : a.ln_g2)) + l * D; const float* bp = (k == 0 ? a.ln_b0 : (k == 1 ? a.ln_b1 : a.ln_b2)) + l * D;
                for (int m = gw; m < M; m += NGW) ln_row(X + (size_t)m * D, X + (size_t)m * D, XB + (size_t)m * D, gp, bp, lane);
                if (s == 9 && l + 1 < DEPTH) convert_layer_weights(a, l + 1, lds, wave, lane, gw, NGW);
            }
        }
        if (ph + 1 < a.ph_hi) { __syncthreads(); cg::this_grid().sync(); }
    }
}

extern "C" void kernel_launch(void* const* d_in, const int* in_sizes, int n_in, void* d_out, int out_size, void* d_ws, size_t ws_size, hipStream_t stream) {
    static int grid = 0;
    if (grid == 0) {
        if (n_in != 14 || in_sizes[0] != M * D || out_size != M * D || ws_size < WS_END) { fprintf(stderr, "kernel_launch: unexpected shapes: n_in %d in0 %d out %d ws %zu\n", n_in, n_in > 0 ? in_sizes[0] : -1, out_size, ws_size); grid = -1; return; }
        int dev = 0, cus = 0, per_cu = 0;
        if (hipGetDevice(&dev) != hipSuccess || hipDeviceGetAttribute(&cus, hipDeviceAttributeMultiprocessorCount, dev) != hipSuccess) { grid = -1; return; }
        if (hipFuncSetAttribute((const void*)mk_fwd, hipFuncAttributeMaxDynamicSharedMemorySize, LDS_BYTES) != hipSuccess) { fprintf(stderr, "kernel_launch: hipFuncSetAttribute failed\n"); grid = -1; return; }
        if (hipOccupancyMaxActiveBlocksPerMultiprocessor(&per_cu, (const void*)mk_fwd, NTHREADS, LDS_BYTES) != hipSuccess || per_cu < 1) { fprintf(stderr, "kernel_launch: occupancy query gave %d\n", per_cu); per_cu = 1; }
        (void)hipGetLastError();
        grid = cus * per_cu;
        fprintf(stderr, "kernel_launch: grid %d (cus %d x %d)\n", grid, cus, per_cu);
    }
    if (grid < 0) return;
    Args a{};
    a.x = (const float*)d_in[0]; a.w_in = (const float*)d_in[1]; a.w_out = (const float*)d_in[2]; a.sinks = (const float*)d_in[3];
    a.w_gu1 = (const float*)d_in[4]; a.w_d1 = (const float*)d_in[5]; a.w_gu2 = (const float*)d_in[6]; a.w_d2 = (const float*)d_in[7];
    a.ln_g0 = (const float*)d_in[8]; a.ln_b0 = (const float*)d_in[9]; a.ln_g1 = (const float*)d_in[10]; a.ln_b1 = (const float*)d_in[11];
    a.ln_g2 = (const float*)d_in[12]; a.ln_b2 = (const float*)d_in[13];
    a.out = (float*)d_out; a.ws = (unsigned char*)d_ws;
    constexpr int NPH = 1 + 10 * DEPTH;
#if MK_ONE_LAUNCH
    a.ph_lo = 0; a.ph_hi = NPH;
    void* params[] = {&a};
    hipError_t e = hipLaunchCooperativeKernel((const void*)mk_fwd, dim3(grid), dim3(NTHREADS), params, LDS_BYTES, stream);
    if (e != hipSuccess) fprintf(stderr, "kernel_launch: cooperative launch failed: %s (grid %d)\n", hipGetErrorString(e), grid);
#else
    for (int p = 0; p < NPH; ++p) { a.ph_lo = p; a.ph_hi = p + 1; hipLaunchKernelGGL(mk_fwd, dim3(grid), dim3(NTHREADS), LDS_BYTES, stream, a); }
#endif
}
```

```cpp
#include <hip/hip_runtime.h>
#include <hip/hip_cooperative_groups.h>
#include <cstdio>
#include <cstdint>
namespace cg = cooperative_groups;
#ifndef MK_ONE_LAUNCH
#define MK_ONE_LAUNCH 1
#endif
namespace pg8 {
#define PG8_LAS __attribute__((address_space(3)))
typedef unsigned short bf16_t;
typedef short bf16x8 __attribute__((ext_vector_type(8)));
typedef float f32x4 __attribute__((ext_vector_type(4)));
typedef unsigned u32x4 __attribute__((ext_vector_type(4)));
constexpr int BM = 256, BK = 64, HALF = 128, HTB = HALF * BK * 2  , STAGE_BYTES = 8 * HTB, NXCD = 8, WGM = 8;

__host__ __device__ __forceinline__ int lds_byte(int r, int c) { const int st = (r >> 4) * 2 + (c >> 5), rr = r & 15, cc = c & 31, ob = rr * 64 + cc * 2; return st * 1024 + (ob ^ (((ob >> 9) & 1) << 5)); }
__host__ __device__ __forceinline__ void stage_rc(int b, int& R, int& C) { const int st = b / 1024, sb = b % 1024, swz = sb ^ (((sb >> 9) & 1) << 5); R = (st >> 1) * 16 + swz / 64; C = (st & 1) * 32 + (swz % 64) / 2; }
__host__ __device__ __forceinline__ int perm32(int rho) { const int n = rho >> 4, i = rho & 15; return 8 * (i >> 2) + 4 * n + (i & 3); }

struct Unit { int pm, pn; };
struct Gemm { const bf16_t* A; const bf16_t* Bt; int M, N, K; };

struct StaticOrder {
    int nM, nN, nwg, G, c;
    __host__ __device__ void init(int M, int N, int G_, int c_) { nM = M / BM; nN = N / BM; nwg = nM * nN; G = G_; c = c_; }
    __host__ __device__ bool next(int i, Unit& u) const {
        const long L = (long)i * G + c; if (L >= nwg) return false;
        int wgid = (int)L; { const int q = nwg / NXCD, r = nwg % NXCD, xcd = wgid % NXCD, off = wgid / NXCD; wgid = (xcd < r ? xcd * (q + 1) : r * (q + 1) + (xcd - r) * q) + off; }
        const int nig = WGM * nN, gid = wgid / nig, fm = gid * WGM, gsz = (nM - fm) < WGM ? (nM - fm) : WGM;
        u.pm = fm + ((wgid % nig) % gsz); u.pn = (wgid % nig) / gsz; return true;
    }
    __device__ __forceinline__ void a_ready(const Unit&) const {}
    __device__ __forceinline__ void done(const Unit&) const {}
};

__device__ __forceinline__ unsigned cvt_pk_bf16(float lo, float hi) { unsigned r; asm volatile("v_cvt_pk_bf16_f32 %0, %1, %2" : "=v"(r) : "v"(lo), "v"(hi)); return r; }
typedef float f32x2 __attribute__((ext_vector_type(2)));
__device__ __forceinline__ f32x2 gelu_pk(f32x2 v) {
    const f32x2 av = __builtin_elementwise_abs(v), d = av * 0.2316418882f + 1.0f;
    f32x2 t; t.x = __builtin_amdgcn_rcpf(d.x); t.y = __builtin_amdgcn_rcpf(d.y);
    f32x2 q = t * 0.5307027145f + (-0.7265760135f); q = q * t + 0.7107068705f; q = q * t + (-0.142248368f); q = q * t + 0.127414796f; q = q * t;
    const f32x2 s = (v * v) * (-0.72134752044f);
    f32x2 e; e.x = __builtin_amdgcn_exp2f(s.x); e.y = __builtin_amdgcn_exp2f(s.y);
    const f32x2 m = v * (q * e), r = v - m;
    f32x2 o; o.x = v.x < 0.f ? m.x : r.x; o.y = v.y < 0.f ? m.y : r.y; return o;
}

template <int ACT  > struct EpiBf16 {
    static constexpr bool PERM = true, AFTER_DRAIN = false; static_assert(ACT == 0 || ACT == 1, "EpiBf16: ACT is 0 (none) or 1 (gelu_pk)");
    bf16_t* O; int ldc; const float* bias; int split_cols; size_t split_stride; float scale0;
    __device__ __forceinline__ void operator()(const f32x4 (&acc)[2][2][4][2], const Unit& u, int wr, int wc, int fr, int fq) const {
        const int row0 = u.pm * BM + wr * 64 + fr; int colt = u.pn * BM; bf16_t* base = O;
        float sc = 1.f; if (split_cols) { const int t = colt / split_cols; base += (size_t)t * split_stride; colt -= t * split_cols; if (t == 0) sc = scale0; }
        const int col0 = colt + wc * 32 + 8 * fq, bcol0 = u.pn * BM + wc * 32 + 8 * fq;
        f32x4 bv[2][2];
#pragma unroll
        for (int bj = 0; bj < 2; ++bj)
#pragma unroll
            for (int n = 0; n < 2; ++n) bv[bj][n] = bias ? *(const f32x4*)(bias + bcol0 + bj * HALF + 4 * n) : (f32x4){0.f, 0.f, 0.f, 0.f};
#pragma unroll
        for (int ai = 0; ai < 2; ++ai)
#pragma unroll
            for (int m = 0; m < 4; ++m) { bf16_t* rowp = base + (size_t)(row0 + ai * HALF + m * 16) * ldc + col0;
#pragma unroll
                for (int bj = 0; bj < 2; ++bj) { f32x4 v0 = acc[ai][bj][m][0] + bv[bj][0], v1 = acc[ai][bj][m][1] + bv[bj][1];
                    if (ACT == 1) { f32x2 a = gelu_pk((f32x2){v0[0], v0[1]}), b = gelu_pk((f32x2){v0[2], v0[3]}), c = gelu_pk((f32x2){v1[0], v1[1]}), d = gelu_pk((f32x2){v1[2], v1[3]});
                        v0 = (f32x4){a.x, a.y, b.x, b.y}; v1 = (f32x4){c.x, c.y, d.x, d.y}; }
                    v0 = v0 * sc; v1 = v1 * sc; u32x4 w; w.x = cvt_pk_bf16(v0[0], v0[1]); w.y = cvt_pk_bf16(v0[2], v0[3]); w.z = cvt_pk_bf16(v1[0], v1[1]); w.w = cvt_pk_bf16(v1[2], v1[3]);
                    *(u32x4*)(rowp + bj * HALF) = w; } }
    }
};
template <class Epi, class Sched, bool ALIGN_EPI = false, bool SP2 = false>
__device__ __forceinline__ void gemm_phase(PG8_LAS unsigned char* lds, const Gemm g, const Sched& S, const Epi& E) {
    int tid_ = threadIdx.x; asm volatile("" : "+v"(tid_)); const int tid = tid_, wid = __builtin_amdgcn_readfirstlane(tid >> 6), lane = tid & 63, wr = wid >> 2, wc = wid & 3, fr = lane & 15, fq = lane >> 4;
    const int K = g.K, nt = K / BK;
    unsigned voffA[2], voffB[2];
#pragma unroll
    for (int i = 0; i < 2; ++i) { int R, C; stage_rc(tid * 16 + i * 8192, R, C); const int Rb = Epi::PERM ? ((R & ~31) + perm32(R & 31)) : R;
        voffA[i] = (unsigned)(R * K + C) * 2u; voffB[i] = (unsigned)(Rb * K + C) * 2u; }
    const size_t kstep = (size_t)(BK * 2);
    const size_t hstep = (size_t)HALF * K * 2;
    const size_t tstep = 2 * hstep;
    const unsigned ldsw = (unsigned)wid * 1024u;
    const int aoff = lds_byte(wr * 64 + fr, fq * 8), boff = lds_byte(wc * 32 + fr, fq * 8);
#define PG8_SA(b, h) (((b) * 2 + (h)) * HTB)
#define PG8_SB(b, h) ((4 + (b) * 2 + (h)) * HTB)
#define PG8_STAGE(bufoff, gbase, voff) do { _Pragma("unroll") for (int _i = 0; _i < 2; ++_i) \
        __builtin_amdgcn_global_load_lds((const unsigned*)((const char*)(gbase) + (voff)[_i]), (PG8_LAS unsigned*)(lds + (bufoff) + ldsw + _i * 8192), 16, 0, 0); } while (0)
#define PG8_LDA(dst, b, h) do { _Pragma("unroll") for (int m = 0; m < 4; ++m) _Pragma("unroll") for (int k = 0; k < 2; ++k) dst[m][k] = *(const PG8_LAS bf16x8*)(lds + PG8_SA(b, h) + aoff + m * 2048 + k * 1024); } while (0)
#define PG8_LDB(dst, b, h) do { _Pragma("unroll") for (int n = 0; n < 2; ++n) _Pragma("unroll") for (int k = 0; k < 2; ++k) dst[n][k] = *(const PG8_LAS bf16x8*)(lds + PG8_SB(b, h) + boff + n * 2048 + k * 1024); } while (0)
#define PG8_MMA(ai, bj, At, Bt) do { __builtin_amdgcn_s_setprio(1); _Pragma("unroll") for (int m = 0; m < 4; ++m) _Pragma("unroll") for (int n = 0; n < 2; ++n) _Pragma("unroll") for (int k = 0; k < 2; ++k) \
        acc[ai][bj][m][n] = __builtin_amdgcn_mfma_f32_16x16x32_bf16(Bt[n][k], At[m][k], acc[ai][bj][m][n], 0, 0, 0); __builtin_amdgcn_s_setprio(0); } while (0)
#define PG8_WAIT_V(n) asm volatile("s_waitcnt vmcnt(" #n ")" ::: "memory")
#define PG8_WAIT_L(n) asm volatile("s_waitcnt lgkmcnt(" #n ")" ::: "memory")
#define PG8_BAR __builtin_amdgcn_s_barrier()
#define PG8_SCHED __builtin_amdgcn_sched_barrier(0)
    Unit cur, nxt; int ui = 0;
    if (!S.next(0, cur)) return;
    f32x4 acc[2][2][4][2];
#pragma unroll
    for (int a = 0; a < 2; ++a)
#pragma unroll
        for (int b = 0; b < 2; ++b)
#pragma unroll
            for (int m = 0; m < 4; ++m)
#pragma unroll
                for (int n = 0; n < 2; ++n) acc[a][b][m][n] = (f32x4){0.f, 0.f, 0.f, 0.f};
    bf16x8 At[4][2], B0[2][2], B1[2][2];
    const char* cA = (const char*)g.A + (size_t)cur.pm * tstep; const char* cB = (const char*)g.Bt + (size_t)cur.pn * tstep;
    S.a_ready(cur);
    if constexpr (SP2) {
        PG8_STAGE(PG8_SB(0, 0), cB, voffB); PG8_STAGE(PG8_SB(0, 1), cB + hstep, voffB); PG8_STAGE(PG8_SA(0, 0), cA, voffA); PG8_STAGE(PG8_SA(0, 1), cA + hstep, voffA);
        if (wr == 1) PG8_BAR;
        PG8_WAIT_V(2); PG8_BAR;
        PG8_STAGE(PG8_SB(1, 0), cB + kstep, voffB); PG8_STAGE(PG8_SA(1, 0), cA + kstep, voffA); PG8_STAGE(PG8_SB(1, 1), cB + hstep + kstep, voffB);
        PG8_WAIT_V(6); PG8_BAR;
    } else {
        PG8_STAGE(PG8_SB(0, 0), cB, voffB); PG8_STAGE(PG8_SA(0, 0), cA, voffA); PG8_STAGE(PG8_SB(0, 1), cB + hstep, voffB); PG8_STAGE(PG8_SA(0, 1), cA + hstep, voffA);
        if (wr == 1) PG8_BAR;
        PG8_WAIT_V(4); PG8_BAR;
        PG8_STAGE(PG8_SB(1, 0), cB + kstep, voffB); PG8_STAGE(PG8_SA(1, 0), cA + kstep, voffA); PG8_STAGE(PG8_SB(1, 1), cB + hstep + kstep, voffB);
        PG8_WAIT_V(6); PG8_BAR;
    }
    for (;;) {
        const bool has_next = S.next(ui + 1, nxt);
        const char* nA = has_next ? (const char*)g.A + (size_t)nxt.pm * tstep : cA; const char* nB = has_next ? (const char*)g.Bt + (size_t)nxt.pn * tstep : cB;
        for (int t = 0; t < nt; t += 2) {
            const bool last = (t == nt - 2);
            const char* a1 = cA + (size_t)(t + 1) * kstep;
            const char* a2 = last ? nA : cA + (size_t)(t + 2) * kstep; const char* b2 = last ? nB : cB + (size_t)(t + 2) * kstep;
            const char* a3 = a2 + kstep; const char* b3 = b2 + kstep;
            if (last && has_next) S.a_ready(nxt);
            if constexpr (SP2) {
            PG8_LDB(B0, 0, 0); PG8_LDB(B1, 0, 1); PG8_SCHED; PG8_LDA(At, 0, 0); PG8_STAGE(PG8_SA(1, 1), a1 + hstep, voffA);
            PG8_WAIT_V(8); PG8_WAIT_L(0); PG8_BAR; PG8_MMA(0, 0, At, B0); PG8_MMA(0, 1, At, B1); PG8_BAR; PG8_SCHED;
            PG8_LDA(At, 0, 1); PG8_STAGE(PG8_SB(0, 0), b2, voffB); PG8_STAGE(PG8_SB(0, 1), b2 + hstep, voffB); PG8_STAGE(PG8_SA(0, 0), a2, voffA);
            PG8_WAIT_V(8); PG8_WAIT_L(0); PG8_BAR; PG8_MMA(1, 0, At, B0); PG8_MMA(1, 1, At, B1); PG8_BAR; PG8_SCHED;
            PG8_LDB(B0, 1, 0); PG8_LDB(B1, 1, 1); PG8_SCHED; PG8_LDA(At, 1, 0); PG8_STAGE(PG8_SA(0, 1), a2 + hstep, voffA);
            PG8_WAIT_V(8); PG8_WAIT_L(0); PG8_BAR; PG8_MMA(0, 0, At, B0); PG8_MMA(0, 1, At, B1); PG8_BAR; PG8_SCHED;
            PG8_LDA(At, 1, 1); PG8_STAGE(PG8_SB(1, 0), b3, voffB); PG8_STAGE(PG8_SB(1, 1), b3 + hstep, voffB); PG8_STAGE(PG8_SA(1, 0), a3, voffA);
            PG8_WAIT_V(8); PG8_WAIT_L(0); PG8_BAR; PG8_MMA(1, 0, At, B0); PG8_MMA(1, 1, At, B1); PG8_BAR; PG8_SCHED;
            } else {
            PG8_LDB(B0, 0, 0); PG8_SCHED; PG8_LDA(At, 0, 0); PG8_STAGE(PG8_SA(1, 1), a1 + hstep, voffA);
            PG8_WAIT_L(8); PG8_BAR; PG8_WAIT_L(0); PG8_MMA(0, 0, At, B0); PG8_BAR; PG8_SCHED;
            PG8_LDB(B1, 0, 1); PG8_STAGE(PG8_SB(0, 0), b2, voffB);
            PG8_BAR; PG8_WAIT_L(0); PG8_MMA(0, 1, At, B1); PG8_BAR;
            PG8_LDA(At, 0, 1); PG8_STAGE(PG8_SA(0, 0), a2, voffA);
            PG8_BAR; PG8_WAIT_L(0); PG8_MMA(1, 0, At, B0); PG8_BAR; PG8_SCHED;
            PG8_STAGE(PG8_SB(0, 1), b2 + hstep, voffB);
            PG8_WAIT_V(6); PG8_BAR; PG8_MMA(1, 1, At, B1); PG8_BAR;
            PG8_LDB(B0, 1, 0); PG8_SCHED; PG8_LDA(At, 1, 0); PG8_STAGE(PG8_SA(0, 1), a2 + hstep, voffA);
            PG8_WAIT_L(8); PG8_BAR; PG8_WAIT_L(0); PG8_MMA(0, 0, At, B0); PG8_BAR; PG8_SCHED;
            PG8_LDB(B1, 1, 1); PG8_STAGE(PG8_SB(1, 0), b3, voffB);
            PG8_BAR; PG8_WAIT_L(0); PG8_MMA(0, 1, At, B1); PG8_BAR;
            PG8_LDA(At, 1, 1); PG8_STAGE(PG8_SA(1, 0), a3, voffA);
            PG8_BAR; PG8_WAIT_L(0); PG8_MMA(1, 0, At, B0); PG8_BAR; PG8_SCHED;
            PG8_STAGE(PG8_SB(1, 1), b3 + hstep, voffB);
            PG8_WAIT_V(6); PG8_BAR; PG8_MMA(1, 1, At, B1); PG8_BAR;
            }
        }
        if constexpr (ALIGN_EPI) { if (wr == 0) PG8_BAR; }
        if constexpr (!Epi::AFTER_DRAIN) { E(acc, cur, wr, wc, fr, fq); S.done(cur); }
        if (!has_next) break;
#pragma unroll
        for (int a = 0; a < 2; ++a)
#pragma unroll
            for (int b = 0; b < 2; ++b)
#pragma unroll
                for (int m = 0; m < 4; ++m)
#pragma unroll
                    for (int n = 0; n < 2; ++n) acc[a][b][m][n] = (f32x4){0.f, 0.f, 0.f, 0.f};
        cur = nxt; cA = nA; cB = nB; ++ui;
        if constexpr (ALIGN_EPI) { if (wr == 1) PG8_BAR; }
    }
    PG8_WAIT_V(0);
    if constexpr (!ALIGN_EPI) { if (wr == 0) PG8_BAR; }
    PG8_BAR;
    if constexpr (Epi::AFTER_DRAIN) { E.fused(acc, cur, wr, wc, fr, fq, lds, wid, lane); S.done(cur); }
#undef PG8_SA
#undef PG8_SB
#undef PG8_STAGE
#undef PG8_LDA
#undef PG8_LDB
#undef PG8_MMA
#undef PG8_WAIT_V
#undef PG8_WAIT_L
#undef PG8_BAR
#undef PG8_SCHED
}
}

#define DI __device__ __forceinline__
#define LAS __attribute__((address_space(3)))
typedef unsigned short bf16;
typedef short bf16x8 __attribute__((ext_vector_type(8)));
typedef short s16x4 __attribute__((ext_vector_type(4)));
typedef float f32x4 __attribute__((ext_vector_type(4)));
typedef float f32x2 __attribute__((ext_vector_type(2)));
typedef float f32x16 __attribute__((ext_vector_type(16)));
typedef unsigned u32x4 __attribute__((ext_vector_type(4)));
typedef unsigned u32x2 __attribute__((ext_vector_type(2)));
typedef __bf16 bf16x2_t __attribute__((ext_vector_type(2)));
typedef LAS unsigned char lds_u8;

constexpr int NWAVES = 8, NTHREADS = 512;
constexpr int BATCH = 8, SEQ = 4096, D = 1024, DEPTH = 4, M = BATCH * SEQ;
constexpr int HD = 64, FF = 2816, INW = 2816, GUW = 2 * FF;
constexpr float ALPHA = 1.681792830507429f;
constexpr float LN_EPS = 1e-5f, GN_EPS = 1e-6f;
constexpr float LOG2E = 1.4426950408889634f;
constexpr float QSCALE = 0.125f * LOG2E;

constexpr size_t MiB = 1u << 20;
constexpr size_t WS_TAB = 1 * MiB;
constexpr size_t WS_WGU1 = 4 * MiB, WS_WD1 = 16 * MiB, WS_WGU2 = 22 * MiB, WS_WD2 = 34 * MiB, WS_WIN = 40 * MiB, WS_WOUT = 46 * MiB;
constexpr size_t WS_XB = 48 * MiB;
constexpr size_t WS_HB = 112 * MiB;
constexpr size_t WS_YM = 288 * MiB;
constexpr size_t WS_END = 352 * MiB;
constexpr int LDS_BYTES = 147456;

DI unsigned cvtpk(float lo, float hi) { f32x2 v = {lo, hi}; bf16x2_t b = __builtin_convertvector(v, bf16x2_t); return __builtin_bit_cast(unsigned, b); }
DI float bf2f(unsigned short b) { return __uint_as_float((unsigned)b << 16); }
DI float fast_exp2(float x) { return __builtin_amdgcn_exp2f(x); }
DI float fast_rcp(float x) { return __builtin_amdgcn_rcpf(x); }
DI float silu_f(float a) { return a * fast_rcp(1.0f + fast_exp2(-a * LOG2E)); }
DI float wave_sum(float v) {
#pragma unroll
    for (int o = 1; o < 64; o <<= 1) v += __shfl_xor(v, o);
    return v;
}
DI int opaque_tid() { int t = threadIdx.x; asm volatile("" : "+v"(t)); return t; }
DI int crow(int r, int hi) { return (r & 3) + 8 * (r >> 2) + 4 * hi; }
#define MFMA32(a, b, c) __builtin_amdgcn_mfma_f32_32x32x16_bf16((a), (b), (c), 0, 0, 0)

namespace pg8 {
struct EpiSwiGLU {
    static constexpr bool PERM = true, AFTER_DRAIN = false;
    bf16_t* H;
    __device__ __forceinline__ void operator()(const f32x4 (&acc)[2][2][4][2], const Unit& u, int wr, int wc, int fr, int fq) const {
        const int row0 = u.pm * BM + wr * 64 + fr, col0 = u.pn * 128 + wc * 32 + 8 * fq;
#pragma unroll
        for (int ai = 0; ai < 2; ++ai)
#pragma unroll
            for (int m = 0; m < 4; ++m) {
                bf16_t* rowp = H + (size_t)(row0 + ai * HALF + m * 16) * FF + col0;
                float h[8];
#pragma unroll
                for (int n = 0; n < 2; ++n)
#pragma unroll
                    for (int j = 0; j < 4; ++j) h[n * 4 + j] = silu_f(acc[ai][0][m][n][j]) * acc[ai][1][m][n][j];
                u32x4 w; w.x = cvtpk(h[0], h[1]); w.y = cvtpk(h[2], h[3]); w.z = cvtpk(h[4], h[5]); w.w = cvtpk(h[6], h[7]);
                *(u32x4*)rowp = w;
            }
    }
};
struct EpiResid {
    static constexpr bool PERM = false, AFTER_DRAIN = false;
    const float* X; float* Y; float s;
    __device__ __forceinline__ void operator()(const f32x4 (&acc)[2][2][4][2], const Unit& u, int wr, int wc, int fr, int fq) const {
        const int col0 = u.pn * BM + wc * 32 + 4 * fq;
#pragma unroll
        for (int ai = 0; ai < 2; ++ai)
#pragma unroll
            for (int m = 0; m < 4; ++m) {
                const size_t off = (size_t)(u.pm * BM + ai * HALF + wr * 64 + m * 16 + fr) * D + col0;
#pragma unroll
                for (int bj = 0; bj < 2; ++bj)
#pragma unroll
                    for (int n = 0; n < 2; ++n) {
                        const f32x4 xv = *(const f32x4*)(X + off + bj * HALF + n * 16);
                        *(f32x4*)(Y + off + bj * HALF + n * 16) = xv * ALPHA + acc[ai][bj][m][n] * s;
                    }
            }
    }
};
struct EpiInProj {
    static constexpr bool PERM = true, AFTER_DRAIN = false;
    bf16_t* O; const float* tab;
    __device__ __forceinline__ void operator()(const f32x4 (&acc)[2][2][4][2], const Unit& u, int wr, int wc, int fr, int fq) const {
        const int pn = u.pn;
        int mode;
        float sc = 1.f;
        if (pn < 2) { mode = 1; sc = QSCALE; } else if (pn == 2) { mode = (wc < 2) ? 1 : 0; } else if (pn < 5) { mode = 2; } else if (pn < 7) { mode = 2; sc = 0.125f; } else if (pn < 9) { mode = 0; } else { mode = 3; }
        const int row0 = u.pm * BM + wr * 64 + fr, col0 = pn * 256 + wc * 64 + 8 * fq;
        const float* rc = tab; const float* rs = tab + SEQ * 32; const float* tc = tab + 2 * SEQ * 32; const float* ts = tab + 3 * SEQ * 32;
#pragma unroll
        for (int ai = 0; ai < 2; ++ai)
#pragma unroll
            for (int m = 0; m < 4; ++m) {
                const int row = row0 + ai * HALF + m * 16, pos = row & (SEQ - 1);
                bf16_t* rowp = O + (size_t)row * INW + col0;
                float o[2][8];
                if (mode == 1) {
#pragma unroll
                    for (int n = 0; n < 2; ++n) {
                        const f32x4 c = *(const f32x4*)(rc + pos * 32 + 8 * fq + 4 * n), s = *(const f32x4*)(rs + pos * 32 + 8 * fq + 4 * n);
#pragma unroll
                        for (int j = 0; j < 4; ++j) { const float x1 = acc[ai][0][m][n][j], x2 = acc[ai][1][m][n][j];
                            o[0][n * 4 + j] = (x1 * c[j] - x2 * s[j]) * sc; o[1][n * 4 + j] = (x2 * c[j] + x1 * s[j]) * sc; }
                    }
                } else if (mode == 2) {
#pragma unroll
                    for (int bj = 0; bj < 2; ++bj)
#pragma unroll
                        for (int n = 0; n < 2; ++n) {
                            const f32x2 c = *(const f32x2*)(tc + pos * 32 + bj * 16 + 4 * fq + 2 * n), s = *(const f32x2*)(ts + pos * 32 + bj * 16 + 4 * fq + 2 * n);
#pragma unroll
                            for (int p = 0; p < 2; ++p) { const float xe = acc[ai][bj][m][n][2 * p], xo = acc[ai][bj][m][n][2 * p + 1];
                                o[bj][n * 4 + 2 * p] = (xe * c[p] - xo * s[p]) * sc; o[bj][n * 4 + 2 * p + 1] = (xo * c[p] + xe * s[p]) * sc; }
                        }
                } else {
#pragma unroll
                    for (int bj = 0; bj < 2; ++bj)
#pragma unroll
                        for (int n = 0; n < 2; ++n)
#pragma unroll
                            for (int j = 0; j < 4; ++j) { const float v = acc[ai][bj][m][n][j]; o[bj][n * 4 + j] = (mode == 3) ? silu_f(v) : v; }
                }
#pragma unroll
                for (int bj = 0; bj < 2; ++bj) {
                    u32x4 w; w.x = cvtpk(o[bj][0], o[bj][1]); w.y = cvtpk(o[bj][2], o[bj][3]); w.z = cvtpk(o[bj][4], o[bj][5]); w.w = cvtpk(o[bj][6], o[bj][7]);
                    *(u32x4*)(rowp + bj * 32) = w;
                }
            }
    }
};
}

struct Args {
    const float* x; const float* w_in; const float* w_out; const float* sinks;
    const float* w_gu1; const float* w_d1; const float* w_gu2; const float* w_d2;
    const float* ln_g0; const float* ln_g1; const float* ln_g2; const float* ln_b0; const float* ln_b1; const float* ln_b2;
    float* out; unsigned char* ws; int ph_lo, ph_hi;
};

DI void transpose_item(const float* W, int K, int Nsrc, int srcbase, bf16* WT, int n0, int k0, LAS float* scr, int lane) {
#pragma unroll 8
    for (int i = 0; i < 32; ++i) { const int kk = 2 * i + (lane >> 5); scr[kk * 33 + (lane & 31)] = W[(size_t)(k0 + kk) * Nsrc + srcbase + (lane & 31)]; }
    asm volatile("s_waitcnt lgkmcnt(0)" ::: "memory");
    const int c = lane & 7;
#pragma unroll
    for (int j = 0; j < 4; ++j) { const int n = (lane >> 3) + 8 * j; const LAS float* s = scr + (8 * c) * 33 + n;
        u32x4 o; o.x = cvtpk(s[0 * 33], s[1 * 33]); o.y = cvtpk(s[2 * 33], s[3 * 33]); o.z = cvtpk(s[4 * 33], s[5 * 33]); o.w = cvtpk(s[6 * 33], s[7 * 33]);
        *(u32x4*)(WT + (size_t)(n0 + n) * K + k0 + 8 * c) = o; }
    asm volatile("s_waitcnt lgkmcnt(0)" ::: "memory");
}
DI int src_col(int which, int n0) {
    if (which == 0) { const int pn = n0 >> 8, c = n0 & 255; return (c >> 7) * FF + pn * 128 + (c & 127); }
    if (which == 2) { const int pn = n0 >> 8, c = n0 & 255; return pn * 256 + ((c & 127) >> 5) * 64 + (c >> 7) * 32 + (c & 31); }
    return n0;
}
DI void convert_matrix_items(const float* W, int K, int N, int which, bf16* WT, LAS float* scr, int lane, int first, int gw, int NGW) {
    const int nblk = N / 32, nitems = (K / 64) * nblk;
    int it = gw - (first % NGW); if (it < 0) it += NGW;
    for (; it < nitems; it += NGW) { const int kb = it / nblk, nb = it % nblk; transpose_item(W, K, N, src_col(which, nb * 32), WT, nb * 32, kb * 64, scr, lane); }
}
DI void convert_layer_weights(const Args& a, int l, LAS unsigned char* lds, int wave, int lane, int gw, int NGW) {
    LAS float* scr = (LAS float*)(lds + wave * 16384);
    unsigned char* ws = a.ws;
    constexpr int I_GU = (D / 64) * (GUW / 32), I_D = (FF / 64) * (D / 32), I_IN = (D / 64) * (INW / 32), I_OUT = (D / 64) * (D / 32);
    int first = 0;
    convert_matrix_items(a.w_gu1 + (size_t)l * D * GUW, D, GUW, 0, (bf16*)(ws + WS_WGU1), scr, lane, first, gw, NGW); first += I_GU;
    convert_matrix_items(a.w_d1 + (size_t)l * FF * D, FF, D, 1, (bf16*)(ws + WS_WD1), scr, lane, first, gw, NGW); first += I_D;
    convert_matrix_items(a.w_in + (size_t)l * D * INW, D, INW, 2, (bf16*)(ws + WS_WIN), scr, lane, first, gw, NGW); first += I_IN;
    convert_matrix_items(a.w_out + (size_t)l * D * D, D, D, 1, (bf16*)(ws + WS_WOUT), scr, lane, first, gw, NGW); first += I_OUT;
    convert_matrix_items(a.w_gu2 + (size_t)l * D * GUW, D, GUW, 0, (bf16*)(ws + WS_WGU2), scr, lane, first, gw, NGW); first += I_GU;
    convert_matrix_items(a.w_d2 + (size_t)l * FF * D, FF, D, 1, (bf16*)(ws + WS_WD2), scr, lane, first, gw, NGW);
}
DI void sincos_d(double x, float& c, float& s) {
    const double TWO_PI = 6.283185307179586476925;
    const double k = __builtin_rint(x / TWO_PI), r = x - k * TWO_PI, r2 = r * r;
    double sn = r, cs = 1.0, tsn = r, tcs = 1.0;
#pragma unroll 1
    for (int i = 1; i <= 15; ++i) { tcs *= -r2 / (double)((2 * i - 1) * (2 * i)); cs += tcs; tsn *= -r2 / (double)((2 * i) * (2 * i + 1)); sn += tsn; }
    c = (float)cs; s = (float)sn;
}
DI void build_tables(float* tab, int gtid, int nthreads) {
    for (int e = gtid; e < 2 * SEQ * 32; e += nthreads) {
        const int which = e / (SEQ * 32), r = e % (SEQ * 32), pos = r >> 5, i = r & 31;
        const double base = which == 0 ? 0.7498942093324558 : 0.7429639507594947;
        double f = 1.0;
#pragma unroll 1
        for (int k = 0; k < i; ++k) f *= base;
        float c, s; sincos_d((double)pos * f, c, s);
        tab[(size_t)(2 * which) * SEQ * 32 + r] = c; tab[(size_t)(2 * which + 1) * SEQ * 32 + r] = s;
    }
}
DI void row_to_bf16(const float* xrow, bf16* orow, int lane) {
    const f32x4* xr = (const f32x4*)xrow + lane; u32x2* o8 = (u32x2*)orow + lane;
#pragma unroll
    for (int j = 0; j < 4; ++j) { const f32x4 v = xr[64 * j]; u32x2 w; w.x = cvtpk(v[0], v[1]); w.y = cvtpk(v[2], v[3]); o8[64 * j] = w; }
}
DI void ln_row(const float* yrow, float* xrow, bf16* brow, const float* g, const float* b, int lane) {
    const f32x4* yr = (const f32x4*)yrow + lane;
    f32x4 v[4]; float s = 0.f;
#pragma unroll
    for (int j = 0; j < 4; ++j) { v[j] = yr[64 * j]; s += (v[j][0] + v[j][1]) + (v[j][2] + v[j][3]); }
    const float mean = wave_sum(s) * (1.f / D); float s2 = 0.f;
#pragma unroll
    for (int j = 0; j < 4; ++j) { v[j] = v[j] - mean; s2 += (v[j][0] * v[j][0] + v[j][1] * v[j][1]) + (v[j][2] * v[j][2] + v[j][3] * v[j][3]); }
    const float rstd = 1.f / sqrtf(wave_sum(s2) * (1.f / D) + LN_EPS);
    f32x4* xo = (f32x4*)xrow + lane; u32x2* bo = (u32x2*)brow + lane;
#pragma unroll
    for (int j = 0; j < 4; ++j) {
        const f32x4 gg = ((const f32x4*)g)[lane + 64 * j], bb = ((const f32x4*)b)[lane + 64 * j];
        const f32x4 o = v[j] * rstd * gg + bb; xo[64 * j] = o;
        u32x2 w; w.x = cvtpk(o[0], o[1]); w.y = cvtpk(o[2], o[3]); bo[64 * j] = w;
    }
}

constexpr int A_KS = 0, A_KSTR = 72 * 2;
constexpr int A_VT = 256 * A_KSTR, A_VSTR = 264 * 2;
constexpr int A_STG = A_VT + 64 * A_VSTR, STG_STR = 72 * 2, STG_BYTES = 32 * STG_STR;
static_assert(A_STG + 8 * STG_BYTES <= 131072, "attention LDS");

DI void stage_out_store(lds_u8* stg, const f32x16 (&o)[2], int r32, int hi) {
#pragma unroll
    for (int db = 0; db < 2; ++db)
#pragma unroll
        for (int rg = 0; rg < 4; ++rg) {
            u32x2 w; w.x = cvtpk(o[db][4 * rg], o[db][4 * rg + 1]); w.y = cvtpk(o[db][4 * rg + 2], o[db][4 * rg + 3]);
            *(LAS u32x2*)(stg + r32 * STG_STR + (db * 32 + 8 * rg + 4 * hi) * 2) = w;
        }
}

DI void attn_unit(lds_u8* lds, const bf16* HM, bf16* YM, const float* sinks, int b, int g, int n) {
    const int tid = opaque_tid(), lane = tid & 63, r32 = lane & 31, hi = lane >> 5, wid = __builtin_amdgcn_readfirstlane(tid >> 6);
    const long keyrow0 = (long)b * SEQ + n * 128 - 128;
    {
        const int token = tid & 255; const bool valid = (n > 0) || (token >= 128);
        const bf16* src = HM + (keyrow0 + token) * INW + 512 + g * 64;
#pragma unroll
        for (int i = 0; i < 4; ++i) {
            const int dc = (tid >> 8) + 2 * i;
            u32x4 kv = {0u, 0u, 0u, 0u}, vv = {0u, 0u, 0u, 0u};
            if (valid) { kv = *(const u32x4*)(src + dc * 8); vv = *(const u32x4*)(src + 128 + dc * 8); }
            *(LAS u32x4*)(lds + A_KS + token * A_KSTR + dc * 16) = kv;
            const bf16x8 v8 = __builtin_bit_cast(bf16x8, vv);
#pragma unroll
            for (int ii = 0; ii < 8; ++ii) *(LAS short*)(lds + A_VT + (dc * 8 + ii) * A_VSTR + token * 2) = v8[ii];
        }
    }
    __syncthreads();
    const int hq = g * 4 + (wid >> 1);
    const float sink2 = sinks[hq] * LOG2E;
    lds_u8* stg = lds + A_STG + wid * STG_BYTES;
    const int jmin = (n == 0) ? 128 : 0;
#pragma unroll 1
    for (int qb = 0; qb < 2; ++qb) {
        const int i0 = (wid & 1) * 64 + qb * 32, iq = i0 + r32;
        const long qrow = (long)b * SEQ + n * 128 + iq;
        bf16x8 qf[4];
#pragma unroll
        for (int ks = 0; ks < 4; ++ks) qf[ks] = *(const bf16x8*)(HM + qrow * INW + hq * 64 + ks * 16 + hi * 8);
        float mrun = sink2, lrun = (hi == 0) ? 1.f : 0.f;
        f32x16 o[2];
#pragma unroll
        for (int r = 0; r < 16; ++r) { o[0][r] = 0.f; o[1][r] = 0.f; }
#pragma unroll 1
        for (int t = 0; t < 5; ++t) {
            const int kb = i0 + 32 * t;
            f32x16 s;
#pragma unroll
            for (int r = 0; r < 16; ++r) s[r] = 0.f;
#pragma unroll
            for (int ks = 0; ks < 4; ++ks) {
                const bf16x8 kf = *(const LAS bf16x8*)(lds + A_KS + (kb + r32) * A_KSTR + (ks * 16 + hi * 8) * 2);
                s = MFMA32(kf, qf[ks], s);
            }
            float tmax = -INFINITY;
#pragma unroll
            for (int r = 0; r < 16; ++r) { const int jj = kb + crow(r, hi); const bool vis = (jj > iq) && (jj <= iq + 128) && (jj >= jmin); s[r] = vis ? s[r] : -INFINITY; tmax = fmaxf(tmax, s[r]); }
            tmax = fmaxf(tmax, __shfl_xor(tmax, 32));
            const float mnew = fmaxf(mrun, tmax), scl = fast_exp2(mrun - mnew);
            mrun = mnew;
            float psum = 0.f;
#pragma unroll
            for (int r = 0; r < 16; ++r) { s[r] = fast_exp2(s[r] - mnew); psum += s[r]; }
            lrun = lrun * scl + psum;
#pragma unroll
            for (int r = 0; r < 16; ++r) { o[0][r] *= scl; o[1][r] *= scl; }
#pragma unroll
            for (int gk = 0; gk < 2; ++gk) {
                u32x4 pw; pw.x = cvtpk(s[8 * gk], s[8 * gk + 1]); pw.y = cvtpk(s[8 * gk + 2], s[8 * gk + 3]); pw.z = cvtpk(s[8 * gk + 4], s[8 * gk + 5]); pw.w = cvtpk(s[8 * gk + 6], s[8 * gk + 7]);
                const bf16x8 pf = __builtin_bit_cast(bf16x8, pw);
#pragma unroll
                for (int db = 0; db < 2; ++db) {
                    const lds_u8* vp = lds + A_VT + (db * 32 + r32) * A_VSTR + (kb + 16 * gk + 4 * hi) * 2;
                    const s16x4 lo = *(const LAS s16x4*)vp, hi4 = *(const LAS s16x4*)(vp + 16);
                    const bf16x8 vf = __builtin_shufflevector(lo, hi4, 0, 1, 2, 3, 4, 5, 6, 7);
                    o[db] = MFMA32(vf, pf, o[db]);
                }
            }
        }
        const float ltot = lrun + __shfl_xor(lrun, 32), inv = 1.0f / ltot;
#pragma unroll
        for (int r = 0; r < 16; ++r) { o[0][r] *= inv; o[1][r] *= inv; }
        stage_out_store(stg, o, r32, hi);
        asm volatile("s_waitcnt lgkmcnt(0)" ::: "memory");
        bf16* yw = YM + ((long)b * SEQ + n * 128 + i0) * D + hq * 64;
#pragma unroll
        for (int it = 0; it < 4; ++it) { const int row = it * 8 + (lane >> 3), ch = lane & 7;
            const u32x4 v = *(const LAS u32x4*)(stg + row * STG_STR + ch * 16); *(u32x4*)(yw + (long)row * D + ch * 8) = v; }
        asm volatile("s_waitcnt lgkmcnt(0)" ::: "memory");
    }
    __syncthreads();
}

constexpr int R_QS = 0, R_KS = 128 * 144, R_VT = 2 * 128 * 144, R_TSTR = 136 * 2, R_KT = R_VT + 64 * R_TSTR, R_ST = R_KT + 64 * R_TSTR, R_STG = R_ST + 64 * 144;
static_assert(R_STG + 4 * STG_BYTES <= 131072, "retention LDS");

DI void ret_unit(lds_u8* lds, const bf16* HM, bf16* YM, int b, int h) {
    const int tid = opaque_tid(), lane = tid & 63, r32 = lane & 31, hi = lane >> 5, wid = __builtin_amdgcn_readfirstlane(tid >> 6);
    float lg2;
    { const double x = __builtin_ldexp(1.0, -5 - h); double t = x, s = 0.0;
#pragma unroll 1
      for (int k = 1; k <= 10; ++k) { s -= t / (double)k; t *= x; }
      lg2 = (float)(s * 1.4426950408889634); }
    const float gchunk = fast_exp2(128.f * lg2);
    const int token = tid & 127, dc0 = tid >> 7;
    const float wk = fast_exp2((float)(127 - token) * lg2);
    const long row0 = (long)b * SEQ;
    for (int i = tid; i < 64 * 144 / 4; i += NTHREADS) *(LAS unsigned*)(lds + R_ST + i * 4) = 0u;
    f32x16 st;
#pragma unroll
    for (int r = 0; r < 16; ++r) st[r] = 0.f;
    u32x4 pq[2], pk[2], pv[2];
    { const bf16* src = HM + (row0 + token) * INW + h * 64;
#pragma unroll
      for (int i = 0; i < 2; ++i) { const int dc = dc0 + 4 * i; pq[i] = *(const u32x4*)(src + 768 + dc * 8); pk[i] = *(const u32x4*)(src + 1280 + dc * 8); pv[i] = *(const u32x4*)(src + 1792 + dc * 8); } }
#pragma unroll 1
    for (int n = 0; n < 32; ++n) {
#pragma unroll
        for (int i = 0; i < 2; ++i) {
            const int dc = dc0 + 4 * i;
            *(LAS u32x4*)(lds + R_QS + token * 144 + dc * 16) = pq[i];
            *(LAS u32x4*)(lds + R_KS + token * 144 + dc * 16) = pk[i];
            const bf16x8 k8 = __builtin_bit_cast(bf16x8, pk[i]), v8 = __builtin_bit_cast(bf16x8, pv[i]);
#pragma unroll
            for (int ii = 0; ii < 8; ii += 2) {
                const unsigned kk = cvtpk(bf2f((unsigned short)k8[ii]) * wk, bf2f((unsigned short)k8[ii + 1]) * wk);
                *(LAS short*)(lds + R_KT + (dc * 8 + ii) * R_TSTR + token * 2) = (short)(kk & 0xffffu);
                *(LAS short*)(lds + R_KT + (dc * 8 + ii + 1) * R_TSTR + token * 2) = (short)(kk >> 16);
                *(LAS short*)(lds + R_VT + (dc * 8 + ii) * R_TSTR + token * 2) = v8[ii];
                *(LAS short*)(lds + R_VT + (dc * 8 + ii + 1) * R_TSTR + token * 2) = v8[ii + 1];
            }
        }
        __syncthreads();
        if (n + 1 < 32) { const bf16* src = HM + (row0 + (n + 1) * 128 + token) * INW + h * 64;
#pragma unroll
            for (int i = 0; i < 2; ++i) { const int dc = dc0 + 4 * i; pq[i] = *(const u32x4*)(src + 768 + dc * 8); pk[i] = *(const u32x4*)(src + 1280 + dc * 8); pv[i] = *(const u32x4*)(src + 1792 + dc * 8); } }
        if (wid < 4) {
            const int ib = wid, iq = 32 * ib + r32;
            bf16x8 qf[4];
#pragma unroll
            for (int ks = 0; ks < 4; ++ks) qf[ks] = *(const LAS bf16x8*)(lds + R_QS + iq * 144 + (ks * 16 + hi * 8) * 2);
            f32x16 o[2];
#pragma unroll
            for (int r = 0; r < 16; ++r) { o[0][r] = 0.f; o[1][r] = 0.f; }
#pragma unroll
            for (int eb = 0; eb < 2; ++eb)
#pragma unroll
                for (int ks = 0; ks < 4; ++ks) {
                    const bf16x8 sf = *(const LAS bf16x8*)(lds + R_ST + (eb * 32 + r32) * 144 + (ks * 16 + hi * 8) * 2);
                    o[eb] = MFMA32(sf, qf[ks], o[eb]);
                }
            const float wq = fast_exp2((float)(iq + 1) * lg2);
#pragma unroll
            for (int r = 0; r < 16; ++r) { o[0][r] *= wq; o[1][r] *= wq; }
#pragma unroll 1
            for (int jb = 0; jb <= ib; ++jb) {
                f32x16 s;
#pragma unroll
                for (int r = 0; r < 16; ++r) s[r] = 0.f;
#pragma unroll
                for (int ks = 0; ks < 4; ++ks) {
                    const bf16x8 kf = *(const LAS bf16x8*)(lds + R_KS + (jb * 32 + r32) * 144 + (ks * 16 + hi * 8) * 2);
                    s = MFMA32(kf, qf[ks], s);
                }
#pragma unroll
                for (int r = 0; r < 16; ++r) { const int dj = iq - (jb * 32 + crow(r, hi)); s[r] = (dj >= 0) ? s[r] * fast_exp2((float)dj * lg2) : 0.f; }
#pragma unroll
                for (int gk = 0; gk < 2; ++gk) {
                    u32x4 pw; pw.x = cvtpk(s[8 * gk], s[8 * gk + 1]); pw.y = cvtpk(s[8 * gk + 2], s[8 * gk + 3]); pw.z = cvtpk(s[8 * gk + 4], s[8 * gk + 5]); pw.w = cvtpk(s[8 * gk + 6], s[8 * gk + 7]);
                    const bf16x8 pf = __builtin_bit_cast(bf16x8, pw);
#pragma unroll
                    for (int eb = 0; eb < 2; ++eb) {
                        const lds_u8* vp = lds + R_VT + (eb * 32 + r32) * R_TSTR + (jb * 32 + 16 * gk + 4 * hi) * 2;
                        const s16x4 lo = *(const LAS s16x4*)vp, hi4 = *(const LAS s16x4*)(vp + 16);
                        const bf16x8 vf = __builtin_shufflevector(lo, hi4, 0, 1, 2, 3, 4, 5, 6, 7);
                        o[eb] = MFMA32(vf, pf, o[eb]);
                    }
                }
            }
            float sm = 0.f;
#pragma unroll
            for (int r = 0; r < 16; ++r) sm += o[0][r] + o[1][r];
            sm += __shfl_xor(sm, 32);
            const float mu = sm * (1.f / 64.f);
            float sq = 0.f;
#pragma unroll
            for (int r = 0; r < 16; ++r) { o[0][r] -= mu; o[1][r] -= mu; sq += o[0][r] * o[0][r] + o[1][r] * o[1][r]; }
            sq += __shfl_xor(sq, 32);
            const float rstd = 1.f / sqrtf(sq * (1.f / 64.f) + GN_EPS);
#pragma unroll
            for (int r = 0; r < 16; ++r) { o[0][r] *= rstd; o[1][r] *= rstd; }
            lds_u8* stg = lds + R_STG + wid * STG_BYTES;
            stage_out_store(stg, o, r32, hi);
            asm volatile("s_waitcnt lgkmcnt(0)" ::: "memory");
            const long trow = row0 + n * 128 + 32 * ib;
#pragma unroll
            for (int it = 0; it < 4; ++it) { const int row = it * 8 + (lane >> 3), ch = lane & 7;
                const u32x4 ov = *(const LAS u32x4*)(stg + row * STG_STR + ch * 16);
                const u32x4 gv = *(const u32x4*)(HM + (trow + row) * INW + 2304 + h * 64 + ch * 8);
                const bf16x8 o8 = __builtin_bit_cast(bf16x8, ov), g8 = __builtin_bit_cast(bf16x8, gv);
                u32x4 w;
                w.x = cvtpk(bf2f((unsigned short)o8[0]) * bf2f((unsigned short)g8[0]), bf2f((unsigned short)o8[1]) * bf2f((unsigned short)g8[1]));
                w.y = cvtpk(bf2f((unsigned short)o8[2]) * bf2f((unsigned short)g8[2]), bf2f((unsigned short)o8[3]) * bf2f((unsigned short)g8[3]));
                w.z = cvtpk(bf2f((unsigned short)o8[4]) * bf2f((unsigned short)g8[4]), bf2f((unsigned short)o8[5]) * bf2f((unsigned short)g8[5]));
                w.w = cvtpk(bf2f((unsigned short)o8[6]) * bf2f((unsigned short)g8[6]), bf2f((unsigned short)o8[7]) * bf2f((unsigned short)g8[7]));
                *(u32x4*)(YM + (trow + row) * D + 512 + h * 64 + ch * 8) = w; }
        } else {
            const int eb = (wid - 4) >> 1, dk = (wid - 4) & 1;
#pragma unroll
            for (int r = 0; r < 16; ++r) st[r] *= gchunk;
#pragma unroll
            for (int ks = 0; ks < 8; ++ks) {
                const bf16x8 vf = *(const LAS bf16x8*)(lds + R_VT + (eb * 32 + r32) * R_TSTR + (ks * 16 + hi * 8) * 2);
                const bf16x8 kf = *(const LAS bf16x8*)(lds + R_KT + (dk * 32 + r32) * R_TSTR + (ks * 16 + hi * 8) * 2);
                st = MFMA32(vf, kf, st);
            }
        }
        __syncthreads();
        if (wid >= 4) {
            const int eb = (wid - 4) >> 1, dk = (wid - 4) & 1;
#pragma unroll
            for (int r = 0; r < 16; ++r) *(LAS short*)(lds + R_ST + (eb * 32 + crow(r, hi)) * 144 + (dk * 32 + r32) * 2) = (short)(cvtpk(st[r], 0.f) & 0xffffu);
        }
    }
    __syncthreads();
}

#define XB_TMO      128
#define XB_XCNT(j)  (256  + 64 * (j))
#define XB_XSUB(j)  (1280 + 64 * (j))
#define XB_XGEN(j)  (2304 + 64 * (j))
#define XB_TOP      3328
#define XB_TOPGEN   3392
#define XCD_BAR_WORDS 3456
#define XB_SPIN_CAP (1u << 18)

__device__ __forceinline__ unsigned xb_ld(unsigned* p)              { return __hip_atomic_load(p, __ATOMIC_RELAXED, __HIP_MEMORY_SCOPE_AGENT); }
__device__ __forceinline__ unsigned xb_add(unsigned* p, unsigned v) { return __hip_atomic_fetch_add(p, v, __ATOMIC_RELAXED, __HIP_MEMORY_SCOPE_AGENT); }
__device__ __forceinline__ unsigned xb_xcc_id() { return (unsigned)__builtin_amdgcn_s_getreg((3 << 11) | 20) & 0xFu; }
#define XB_SPIN(cond, bar) do { unsigned _sp = 0; while (cond) { __builtin_amdgcn_s_sleep(1); \
    if ((++_sp & 255u) == 0u) { if (xb_ld(&(bar)[XB_TMO])) break; if (_sp > XB_SPIN_CAP) { atomicAdd(&(bar)[XB_TMO], 1u); break; } } } } while (0)

struct XcdBarrier {
    unsigned* bar; unsigned x;
    volatile LAS unsigned* st;
};

__device__ __forceinline__ XcdBarrier xcd_barrier_post(unsigned* bar, volatile LAS unsigned* st) {
    XcdBarrier b; b.bar = bar; b.x = xb_xcc_id(); b.st = st;
    if (threadIdx.x == 0) (void)xb_add(&bar[XB_XCNT(b.x)], 1u);
    return b;
}
__device__ __forceinline__ void xcd_barrier_complete(unsigned* bar, unsigned x, unsigned& nloc, unsigned& nx) {
    const unsigned G = gridDim.x * gridDim.y * gridDim.z;
    unsigned sum, cnt, mine, sp = 0u;
    for (;;) {
        sum = 0u; cnt = 0u; mine = 0u;
#pragma unroll
        for (unsigned j = 0; j < 16; ++j) { const unsigned c = xb_ld(&bar[XB_XCNT(j)]); sum += c; cnt += (c > 0u) ? 1u : 0u; mine = (j == x) ? c : mine; }
        if (sum == G) break;
        __builtin_amdgcn_s_sleep(1);
        if ((++sp & 255u) == 0u) { if (xb_ld(&bar[XB_TMO])) break; if (sp > XB_SPIN_CAP) { atomicAdd(&bar[XB_TMO], 1u); break; } }
    }
    nloc = mine > 0u ? mine : 1u; nx = cnt > 0u ? cnt : 1u;
}

__device__ __forceinline__ void xcd_barrier(const XcdBarrier& b) {
    asm volatile("s_waitcnt vmcnt(0)" ::: "memory");
    __syncthreads();
    if (threadIdx.x == 0) {
        unsigned* bar = b.bar;
        __builtin_amdgcn_s_waitcnt(0);
        unsigned nloc = b.st[0], nx = b.st[1];
        if (nloc == 0u) { xcd_barrier_complete(bar, b.x, nloc, nx); b.st[0] = nloc; b.st[1] = nx; }
        const unsigned old = xb_add(&bar[XB_XSUB(b.x)], 1u);
        const unsigned gen = old / nloc;
        if (old + 1u == (gen + 1u) * nloc) {
            __builtin_amdgcn_fence(__ATOMIC_RELEASE, "agent");
            asm volatile("s_waitcnt vmcnt(0)" ::: "memory");
            const unsigned og = xb_add(&bar[XB_TOP], 1u);
            const unsigned tg = og / nx;
            if (og + 1u == (tg + 1u) * nx) xb_add(&bar[XB_TOPGEN], 1u);
            else XB_SPIN(xb_ld(&bar[XB_TOPGEN]) == tg, bar);
            __builtin_amdgcn_fence(__ATOMIC_ACQUIRE, "agent");
            xb_add(&bar[XB_XGEN(b.x)], 1u);
            asm volatile("s_waitcnt vmcnt(0)" ::: "memory");
        } else {
            XB_SPIN(xb_ld(&bar[XB_XGEN(b.x)]) == gen, bar);
            __builtin_amdgcn_fence(__ATOMIC_ACQUIRE, "agent");
            asm volatile("s_waitcnt vmcnt(0)" ::: "memory");
        }
    }
    __syncthreads();
}
#ifdef SKIP_RET
#define RET_UNIT(bb, hh)
#else
#define RET_UNIT(bb, hh) ret_unit(lds, HB, YM, (bb), (hh))
#endif
#ifdef SKIP_ATT
#define ATT_UNIT(bb, gg, nn)
#else
#define ATT_UNIT(bb, gg, nn) attn_unit(lds, HB, YM, a.sinks + l * 8, (bb), (gg), (nn))
#endif
__global__ void __launch_bounds__(NTHREADS, 2) mk_fwd(Args a) {
    extern __shared__ __attribute__((aligned(16))) unsigned char lds_raw[];
    LAS unsigned char* lds = (LAS unsigned char*)lds_raw;
    const int G = gridDim.x, bx = blockIdx.x;
    const int vcu = (G % 8 == 0) ? (bx % 8) * (G / 8) + bx / 8 : bx;
    const int NGW = G * NWAVES;
    unsigned char* ws = a.ws;
    float* tab = (float*)(ws + WS_TAB);
    bf16* XB = (bf16*)(ws + WS_XB); bf16* HB = (bf16*)(ws + WS_HB); bf16* YM = (bf16*)(ws + WS_YM);
    float* X = a.out;
    volatile LAS unsigned* MISC = (volatile LAS unsigned*)(lds + 131072 + 320);
    if (threadIdx.x < 64) MISC[threadIdx.x] = 0u;
    __syncthreads();
    unsigned* barw = (unsigned*)ws;
    XcdBarrier bar; bar.bar = barw; bar.x = 0; bar.st = MISC + 8;
    bool bar_ready = false;
#pragma unroll 1
    for (int ph = a.ph_lo; ph < a.ph_hi; ++ph) {
        const int tid = opaque_tid(), lane = tid & 63, wave = __builtin_amdgcn_readfirstlane(tid >> 6), gw = vcu * NWAVES + wave;
        if (ph == 0) {
            if (bx == 0) for (int i = tid; i < XCD_BAR_WORDS; i += NTHREADS) barw[i] = 0u;
            build_tables(tab, vcu * NTHREADS + tid, G * NTHREADS);
            convert_layer_weights(a, 0, lds, wave, lane, gw, NGW);
            for (int m = gw; m < M; m += NGW) row_to_bf16(a.x + (size_t)m * D, XB + (size_t)m * D, lane);
        } else {
            const int l = (ph - 1) / 10, s = (ph - 1) % 10;
            if (s == 0 || s == 7) {
                pg8::Gemm g{XB, (const bf16*)(ws + (s == 0 ? WS_WGU1 : WS_WGU2)), M, GUW, D}; pg8::StaticOrder S; S.init(M, GUW, G, bx);
                pg8::EpiSwiGLU E{HB};
#ifndef SKIP_UP
#ifdef PROBE_UP2
#pragma unroll 1
                for (int rep = 0; rep < (s == 0 ? 2 : 1); ++rep)
#endif
                pg8::gemm_phase<pg8::EpiSwiGLU, pg8::StaticOrder, true, true>(lds, g, S, E);
#endif
            } else if (s == 1 || s == 5 || s == 8) {
                const bf16* A = (s == 5) ? YM : HB; const int K = (s == 5) ? D : FF;
                const bf16* Bt = (const bf16*)(ws + (s == 1 ? WS_WD1 : (s == 5 ? WS_WOUT : WS_WD2)));
                pg8::Gemm g{A, Bt, M, D, K}; pg8::StaticOrder S; S.init(M, D, G, bx);
                pg8::EpiResid E{(l == 0 && s == 1) ? a.x : X, X, (s == 5) ? 1.0f : 0.5f};
#ifndef SKIP_DOWN
#ifdef PROBE_DOWN2
#pragma unroll 1
                for (int rep = 0; rep < (s == 1 ? 2 : 1); ++rep) {
                    if (s == 1) E.Y = (rep == 0) ? (float*)(ws + 352 * MiB) : X;
#endif
                pg8::gemm_phase<pg8::EpiResid, pg8::StaticOrder, true, true>(lds, g, S, E);
#ifdef PROBE_DOWN2
                }
#endif
#endif
            } else if (s == 3) {
                pg8::Gemm g{XB, (const bf16*)(ws + WS_WIN), M, INW, D}; pg8::StaticOrder S; S.init(M, INW, G, bx);
                pg8::EpiInProj E{HB, tab};
#ifndef SKIP_INP
                pg8::gemm_phase<pg8::EpiInProj, pg8::StaticOrder, true, true>(lds, g, S, E);
#endif
            } else if (s == 4) {
#ifdef PROBE_MIX2
              for (int rep = 0; rep < 2; ++rep) {
#endif
                const int NRET = 64;
#ifndef SKIP_MIX
                if (G > NRET) {
                    if (vcu < NRET) { RET_UNIT(vcu >> 3, vcu & 7); }
                    else for (int u = vcu - NRET; u < BATCH * 2 * 32; u += G - NRET) { ATT_UNIT(u >> 6, (u >> 5) & 1, u & 31); }
                } else {
                    for (int u = vcu; u < NRET; u += G) { RET_UNIT(u >> 3, u & 7); }
                    for (int u = vcu; u < BATCH * 2 * 32; u += G) { ATT_UNIT(u >> 6, (u >> 5) & 1, u & 31); }
                }
#endif
#ifdef PROBE_MIX2
              __syncthreads(); }
#endif
            } else {
                const int k = (s == 2) ? 0 : (s == 6 ? 1 : 2);
                const float* gp = (k == 0 ? a.ln_g0 : (k == 1 ? a.ln_g1 : a.ln_g2)) + l * D; const float* bp = (k == 0 ? a.ln_b0 : (k == 1 ? a.ln_b1 : a.ln_b2)) + l * D;
                for (int m = gw; m < M; m += NGW) ln_row(X + (size_t)m * D, X + (size_t)m * D, XB + (size_t)m * D, gp, bp, lane);
#ifdef PROBE_LN2
                if (s == 2) for (int m = gw; m < M; m += NGW) ln_row(X + (size_t)m * D, (float*)HB + (size_t)m * D, YM + (size_t)m * D, gp, bp, lane);
#endif
                if (s == 9 && l + 1 < DEPTH) convert_layer_weights(a, l + 1, lds, wave, lane, gw, NGW);
            }
        }
        if (ph + 1 < a.ph_hi) {
            if (!bar_ready) { __syncthreads(); cg::this_grid().sync(); bar = xcd_barrier_post(barw, MISC + 8); bar_ready = true; }
            else {
                xcd_barrier(bar);
#ifdef PROBE_SYNC2
                xcd_barrier(bar);
#endif
            }
        }
    }
}

extern "C" void kernel_launch(void* const* d_in, const int* in_sizes, int n_in, void* d_out, int out_size, void* d_ws, size_t ws_size, hipStream_t stream) {
    static int grid = 0;
    if (grid == 0) {
        if (n_in != 14 || in_sizes[0] != M * D || out_size != M * D || ws_size < WS_END) { fprintf(stderr, "kernel_launch: unexpected shapes: n_in %d in0 %d out %d ws %zu\n", n_in, n_in > 0 ? in_sizes[0] : -1, out_size, ws_size); grid = -1; return; }
        int dev = 0, cus = 0, per_cu = 0;
        if (hipGetDevice(&dev) != hipSuccess || hipDeviceGetAttribute(&cus, hipDeviceAttributeMultiprocessorCount, dev) != hipSuccess) { grid = -1; return; }
        if (hipFuncSetAttribute((const void*)mk_fwd, hipFuncAttributeMaxDynamicSharedMemorySize, LDS_BYTES) != hipSuccess) { fprintf(stderr, "kernel_launch: hipFuncSetAttribute failed\n"); grid = -1; return; }
        if (hipOccupancyMaxActiveBlocksPerMultiprocessor(&per_cu, (const void*)mk_fwd, NTHREADS, LDS_BYTES) != hipSuccess || per_cu < 1) { fprintf(stderr, "kernel_launch: occupancy query gave %d\n", per_cu); per_cu = 1; }
        (void)hipGetLastError();
        grid = cus * per_cu;
        fprintf(stderr, "kernel_launch: grid %d (cus %d x %d)\n", grid, cus, per_cu);
    }
    if (grid < 0) return;
    Args a{};
    a.x = (const float*)d_in[0]; a.w_in = (const float*)d_in[1]; a.w_out = (const float*)d_in[2]; a.sinks = (const float*)d_in[3];
    a.w_gu1 = (const float*)d_in[4]; a.w_d1 = (const float*)d_in[5]; a.w_gu2 = (const float*)d_in[6]; a.w_d2 = (const float*)d_in[7];
    a.ln_g0 = (const float*)d_in[8]; a.ln_b0 = (const float*)d_in[9]; a.ln_g1 = (const float*)d_in[10]; a.ln_b1 = (const float*)d_in[11];
    a.ln_g2 = (const float*)d_in[12]; a.ln_b2 = (const float*)d_in[13];
    a.out = (float*)d_out; a.ws = (unsigned char*)d_ws;
    constexpr int NPH = 1 + 10 * DEPTH;
#if MK_ONE_LAUNCH
    a.ph_lo = 0; a.ph_hi = NPH;
    void* params[] = {&a};
    hipError_t e = hipLaunchCooperativeKernel((const void*)mk_fwd, dim3(grid), dim3(NTHREADS), params, LDS_BYTES, stream);
    if (e != hipSuccess) fprintf(stderr, "kernel_launch: cooperative launch failed: %s (grid %d)\n", hipGetErrorString(e), grid);
#else
    for (int p = 0; p < NPH; ++p) { a.ph_lo = p; a.ph_hi = p + 1; hipLaunchKernelGGL(mk_fwd, dim3(grid), dim3(NTHREADS), LDS_BYTES, stream, a); }
#endif
}
```

```cpp
#include <hip/hip_runtime.h>
#include <hip/hip_cooperative_groups.h>
#include <cstdio>
#include <cstdint>
namespace cg = cooperative_groups;
#ifndef MK_ONE_LAUNCH
#define MK_ONE_LAUNCH 1
#endif
namespace pg8 {
#define PG8_LAS __attribute__((address_space(3)))
typedef unsigned short bf16_t;
typedef short bf16x8 __attribute__((ext_vector_type(8)));
typedef float f32x4 __attribute__((ext_vector_type(4)));
typedef unsigned u32x4 __attribute__((ext_vector_type(4)));
constexpr int BM = 256, BK = 64, HALF = 128, HTB = HALF * BK * 2  , STAGE_BYTES = 8 * HTB, NXCD = 8, WGM = 8;

__host__ __device__ __forceinline__ int lds_byte(int r, int c) { const int st = (r >> 4) * 2 + (c >> 5), rr = r & 15, cc = c & 31, ob = rr * 64 + cc * 2; return st * 1024 + (ob ^ (((ob >> 9) & 1) << 5)); }
__host__ __device__ __forceinline__ void stage_rc(int b, int& R, int& C) { const int st = b / 1024, sb = b % 1024, swz = sb ^ (((sb >> 9) & 1) << 5); R = (st >> 1) * 16 + swz / 64; C = (st & 1) * 32 + (swz % 64) / 2; }
__host__ __device__ __forceinline__ int perm32(int rho) { const int n = rho >> 4, i = rho & 15; return 8 * (i >> 2) + 4 * n + (i & 3); }

struct Unit { int pm, pn; };
struct Gemm { const bf16_t* A; const bf16_t* Bt; int M, N, K; };

struct StaticOrder {
    int nM, nN, nwg, G, c;
    __host__ __device__ void init(int M, int N, int G_, int c_) { nM = M / BM; nN = N / BM; nwg = nM * nN; G = G_; c = c_; }
    __host__ __device__ bool next(int i, Unit& u) const {
        const long L = (long)i * G + c; if (L >= nwg) return false;
        int wgid = (int)L; { const int q = nwg / NXCD, r = nwg % NXCD, xcd = wgid % NXCD, off = wgid / NXCD; wgid = (xcd < r ? xcd * (q + 1) : r * (q + 1) + (xcd - r) * q) + off; }
        const int nig = WGM * nN, gid = wgid / nig, fm = gid * WGM, gsz = (nM - fm) < WGM ? (nM - fm) : WGM;
        u.pm = fm + ((wgid % nig) % gsz); u.pn = (wgid % nig) / gsz; return true;
    }
    __device__ __forceinline__ void a_ready(const Unit&) const {}
    __device__ __forceinline__ void done(const Unit&) const {}
};

__device__ __forceinline__ unsigned cvt_pk_bf16(float lo, float hi) { unsigned r; asm volatile("v_cvt_pk_bf16_f32 %0, %1, %2" : "=v"(r) : "v"(lo), "v"(hi)); return r; }
typedef float f32x2 __attribute__((ext_vector_type(2)));
__device__ __forceinline__ f32x2 gelu_pk(f32x2 v) {
    const f32x2 av = __builtin_elementwise_abs(v), d = av * 0.2316418882f + 1.0f;
    f32x2 t; t.x = __builtin_amdgcn_rcpf(d.x); t.y = __builtin_amdgcn_rcpf(d.y);
    f32x2 q = t * 0.5307027145f + (-0.7265760135f); q = q * t + 0.7107068705f; q = q * t + (-0.142248368f); q = q * t + 0.127414796f; q = q * t;
    const f32x2 s = (v * v) * (-0.72134752044f);
    f32x2 e; e.x = __builtin_amdgcn_exp2f(s.x); e.y = __builtin_amdgcn_exp2f(s.y);
    const f32x2 m = v * (q * e), r = v - m;
    f32x2 o; o.x = v.x < 0.f ? m.x : r.x; o.y = v.y < 0.f ? m.y : r.y; return o;
}

template <int ACT  > struct EpiBf16 {
    static constexpr bool PERM = true, AFTER_DRAIN = false; static_assert(ACT == 0 || ACT == 1, "EpiBf16: ACT is 0 (none) or 1 (gelu_pk)");
    bf16_t* O; int ldc; const float* bias; int split_cols; size_t split_stride; float scale0;
    __device__ __forceinline__ void operator()(const f32x4 (&acc)[2][2][4][2], const Unit& u, int wr, int wc, int fr, int fq) const {
        const int row0 = u.pm * BM + wr * 64 + fr; int colt = u.pn * BM; bf16_t* base = O;
        float sc = 1.f; if (split_cols) { const int t = colt / split_cols; base += (size_t)t * split_stride; colt -= t * split_cols; if (t == 0) sc = scale0; }
        const int col0 = colt + wc * 32 + 8 * fq, bcol0 = u.pn * BM + wc * 32 + 8 * fq;
        f32x4 bv[2][2];
#pragma unroll
        for (int bj = 0; bj < 2; ++bj)
#pragma unroll
            for (int n = 0; n < 2; ++n) bv[bj][n] = bias ? *(const f32x4*)(bias + bcol0 + bj * HALF + 4 * n) : (f32x4){0.f, 0.f, 0.f, 0.f};
#pragma unroll
        for (int ai = 0; ai < 2; ++ai)
#pragma unroll
            for (int m = 0; m < 4; ++m) { bf16_t* rowp = base + (size_t)(row0 + ai * HALF + m * 16) * ldc + col0;
#pragma unroll
                for (int bj = 0; bj < 2; ++bj) { f32x4 v0 = acc[ai][bj][m][0] + bv[bj][0], v1 = acc[ai][bj][m][1] + bv[bj][1];
                    if (ACT == 1) { f32x2 a = gelu_pk((f32x2){v0[0], v0[1]}), b = gelu_pk((f32x2){v0[2], v0[3]}), c = gelu_pk((f32x2){v1[0], v1[1]}), d = gelu_pk((f32x2){v1[2], v1[3]});
                        v0 = (f32x4){a.x, a.y, b.x, b.y}; v1 = (f32x4){c.x, c.y, d.x, d.y}; }
                    v0 = v0 * sc; v1 = v1 * sc; u32x4 w; w.x = cvt_pk_bf16(v0[0], v0[1]); w.y = cvt_pk_bf16(v0[2], v0[3]); w.z = cvt_pk_bf16(v1[0], v1[1]); w.w = cvt_pk_bf16(v1[2], v1[3]);
                    *(u32x4*)(rowp + bj * HALF) = w; } }
    }
};
typedef int i32x4_t __attribute__((ext_vector_type(4))); typedef int i32x8_t __attribute__((ext_vector_type(8)));
__device__ __forceinline__ i32x8_t cat8(bf16x8 lo, bf16x8 hi) { return __builtin_shufflevector(__builtin_bit_cast(i32x4_t, lo), __builtin_bit_cast(i32x4_t, hi), 0, 1, 2, 3, 4, 5, 6, 7); }
template <class Epi, class Sched, bool ALIGN_EPI = false, bool SP2 = false, bool F8 = false>
__device__ __forceinline__ void gemm_phase(PG8_LAS unsigned char* lds, const Gemm g, const Sched& S, const Epi& E) {
    int tid_ = threadIdx.x; asm volatile("" : "+v"(tid_)); const int tid = tid_, wid = __builtin_amdgcn_readfirstlane(tid >> 6), lane = tid & 63, wr = wid >> 2, wc = wid & 3, fr = lane & 15, fq = lane >> 4;
    const int K = g.K, nt = K / BK;
    unsigned voffA, voffB;
    { int R, C; stage_rc(tid * 16, R, C); const int Rb = Epi::PERM ? ((R & ~31) + perm32(R & 31)) : R;
        voffA = (unsigned)(R * K + C) * 2u; voffB = (unsigned)(Rb * K + C) * 2u; }
    const size_t rstep = (size_t)64 * K * 2;
    const size_t kstep = (size_t)(BK * 2);
    const size_t hstep = (size_t)HALF * K * 2;
    const size_t tstep = 2 * hstep;
    const unsigned ldsw = (unsigned)wid * 1024u;
    const int aoff = lds_byte(wr * 64 + fr, fq * 8), boff = lds_byte(wc * 32 + fr, fq * 8);
#define PG8_SA(b, h) (((b) * 2 + (h)) * HTB)
#define PG8_SB(b, h) ((4 + (b) * 2 + (h)) * HTB)
#define PG8_STAGE(bufoff, gbase, voff) do { _Pragma("unroll") for (int _i = 0; _i < 2; ++_i) \
        __builtin_amdgcn_global_load_lds((const unsigned*)((const char*)(gbase) + _i * rstep + (voff)), (PG8_LAS unsigned*)(lds + (bufoff) + ldsw + _i * 8192), 16, 0, 0); } while (0)
#define PG8_LDA(dst, b, h) do { _Pragma("unroll") for (int m = 0; m < 4; ++m) _Pragma("unroll") for (int k = 0; k < 2; ++k) dst[m][k] = *(const PG8_LAS bf16x8*)(lds + PG8_SA(b, h) + aoff + m * 2048 + k * 1024); } while (0)
#define PG8_LDB(dst, b, h) do { _Pragma("unroll") for (int n = 0; n < 2; ++n) _Pragma("unroll") for (int k = 0; k < 2; ++k) dst[n][k] = *(const PG8_LAS bf16x8*)(lds + PG8_SB(b, h) + boff + n * 2048 + k * 1024); } while (0)
#define PG8_MMA(ai, bj, At, Bt) do { __builtin_amdgcn_s_setprio(1); _Pragma("unroll") for (int m = 0; m < 4; ++m) _Pragma("unroll") for (int n = 0; n < 2; ++n) { \
        if constexpr (F8) { acc[ai][bj][m][n] = __builtin_amdgcn_mfma_scale_f32_16x16x128_f8f6f4(cat8(Bt[n][0], Bt[n][1]), cat8(At[m][0], At[m][1]), acc[ai][bj][m][n], 0, 0, 0, 0, 0, 0); } \
        else { _Pragma("unroll") for (int k = 0; k < 2; ++k) acc[ai][bj][m][n] = __builtin_amdgcn_mfma_f32_16x16x32_bf16(Bt[n][k], At[m][k], acc[ai][bj][m][n], 0, 0, 0); } } __builtin_amdgcn_s_setprio(0); } while (0)
#define PG8_WAIT_V(n) asm volatile("s_waitcnt vmcnt(" #n ")" ::: "memory")
#define PG8_WAIT_L(n) asm volatile("s_waitcnt lgkmcnt(" #n ")" ::: "memory")
#define PG8_BAR __builtin_amdgcn_s_barrier()
#define PG8_SCHED __builtin_amdgcn_sched_barrier(0)
    Unit cur, nxt; int ui = 0;
    if (!S.next(0, cur)) return;
    f32x4 acc[2][2][4][2];
#pragma unroll
    for (int a = 0; a < 2; ++a)
#pragma unroll
        for (int b = 0; b < 2; ++b)
#pragma unroll
            for (int m = 0; m < 4; ++m)
#pragma unroll
                for (int n = 0; n < 2; ++n) acc[a][b][m][n] = (f32x4){0.f, 0.f, 0.f, 0.f};
    bf16x8 At[4][2], B0[2][2], B1[2][2];
    const char* cA = (const char*)g.A + (size_t)cur.pm * tstep; const char* cB = (const char*)g.Bt + (size_t)cur.pn * tstep;
    S.a_ready(cur);
    if constexpr (SP2) {
        PG8_STAGE(PG8_SB(0, 0), cB, voffB); PG8_STAGE(PG8_SB(0, 1), cB + hstep, voffB); PG8_STAGE(PG8_SA(0, 0), cA, voffA); PG8_STAGE(PG8_SA(0, 1), cA + hstep, voffA);
        if (wr == 1) PG8_BAR;
        PG8_WAIT_V(2); PG8_BAR;
        PG8_STAGE(PG8_SB(1, 0), cB + kstep, voffB); PG8_STAGE(PG8_SA(1, 0), cA + kstep, voffA); PG8_STAGE(PG8_SB(1, 1), cB + hstep + kstep, voffB);
        PG8_WAIT_V(6); PG8_BAR;
    } else {
        PG8_STAGE(PG8_SB(0, 0), cB, voffB); PG8_STAGE(PG8_SA(0, 0), cA, voffA); PG8_STAGE(PG8_SB(0, 1), cB + hstep, voffB); PG8_STAGE(PG8_SA(0, 1), cA + hstep, voffA);
        if (wr == 1) PG8_BAR;
        PG8_WAIT_V(4); PG8_BAR;
        PG8_STAGE(PG8_SB(1, 0), cB + kstep, voffB); PG8_STAGE(PG8_SA(1, 0), cA + kstep, voffA); PG8_STAGE(PG8_SB(1, 1), cB + hstep + kstep, voffB);
        PG8_WAIT_V(6); PG8_BAR;
    }
    for (;;) {
        const bool has_next = S.next(ui + 1, nxt);
        const char* nA = has_next ? (const char*)g.A + (size_t)nxt.pm * tstep : cA; const char* nB = has_next ? (const char*)g.Bt + (size_t)nxt.pn * tstep : cB;
#pragma unroll 1
        for (int t = 0; t < nt; t += 2) {
            const bool last = (t == nt - 2);
            const char* a1 = cA + (size_t)(t + 1) * kstep;
            const char* a2 = last ? nA : cA + (size_t)(t + 2) * kstep; const char* b2 = last ? nB : cB + (size_t)(t + 2) * kstep;
            const char* a3 = a2 + kstep; const char* b3 = b2 + kstep;
            if (last && has_next) S.a_ready(nxt);
            if constexpr (SP2) {
            PG8_LDB(B0, 0, 0); PG8_LDB(B1, 0, 1); PG8_SCHED; PG8_LDA(At, 0, 0); PG8_STAGE(PG8_SA(1, 1), a1 + hstep, voffA);
            PG8_WAIT_V(8); PG8_WAIT_L(0); PG8_BAR; PG8_MMA(0, 0, At, B0); PG8_MMA(0, 1, At, B1); PG8_BAR; PG8_SCHED;
            PG8_LDA(At, 0, 1); PG8_STAGE(PG8_SB(0, 0), b2, voffB); PG8_STAGE(PG8_SB(0, 1), b2 + hstep, voffB); PG8_STAGE(PG8_SA(0, 0), a2, voffA);
            PG8_WAIT_V(8); PG8_WAIT_L(0); PG8_BAR; PG8_MMA(1, 0, At, B0); PG8_MMA(1, 1, At, B1); PG8_BAR; PG8_SCHED;
            PG8_LDB(B0, 1, 0); PG8_LDB(B1, 1, 1); PG8_SCHED; PG8_LDA(At, 1, 0); PG8_STAGE(PG8_SA(0, 1), a2 + hstep, voffA);
            PG8_WAIT_V(8); PG8_WAIT_L(0); PG8_BAR; PG8_MMA(0, 0, At, B0); PG8_MMA(0, 1, At, B1); PG8_BAR; PG8_SCHED;
            PG8_LDA(At, 1, 1); PG8_STAGE(PG8_SB(1, 0), b3, voffB); PG8_STAGE(PG8_SB(1, 1), b3 + hstep, voffB); PG8_STAGE(PG8_SA(1, 0), a3, voffA);
            PG8_WAIT_V(8); PG8_WAIT_L(0); PG8_BAR; PG8_MMA(1, 0, At, B0); PG8_MMA(1, 1, At, B1); PG8_BAR; PG8_SCHED;
            } else {
            PG8_LDB(B0, 0, 0); PG8_SCHED; PG8_LDA(At, 0, 0); PG8_STAGE(PG8_SA(1, 1), a1 + hstep, voffA);
            PG8_WAIT_L(8); PG8_BAR; PG8_WAIT_L(0); PG8_MMA(0, 0, At, B0); PG8_BAR; PG8_SCHED;
            PG8_LDB(B1, 0, 1); PG8_STAGE(PG8_SB(0, 0), b2, voffB);
            PG8_BAR; PG8_WAIT_L(0); PG8_MMA(0, 1, At, B1); PG8_BAR;
            PG8_LDA(At, 0, 1); PG8_STAGE(PG8_SA(0, 0), a2, voffA);
            PG8_BAR; PG8_WAIT_L(0); PG8_MMA(1, 0, At, B0); PG8_BAR; PG8_SCHED;
            PG8_STAGE(PG8_SB(0, 1), b2 + hstep, voffB);
            PG8_WAIT_V(6); PG8_BAR; PG8_MMA(1, 1, At, B1); PG8_BAR;
            PG8_LDB(B0, 1, 0); PG8_SCHED; PG8_LDA(At, 1, 0); PG8_STAGE(PG8_SA(0, 1), a2 + hstep, voffA);
            PG8_WAIT_L(8); PG8_BAR; PG8_WAIT_L(0); PG8_MMA(0, 0, At, B0); PG8_BAR; PG8_SCHED;
            PG8_LDB(B1, 1, 1); PG8_STAGE(PG8_SB(1, 0), b3, voffB);
            PG8_BAR; PG8_WAIT_L(0); PG8_MMA(0, 1, At, B1); PG8_BAR;
            PG8_LDA(At, 1, 1); PG8_STAGE(PG8_SA(1, 0), a3, voffA);
            PG8_BAR; PG8_WAIT_L(0); PG8_MMA(1, 0, At, B0); PG8_BAR; PG8_SCHED;
            PG8_STAGE(PG8_SB(1, 1), b3 + hstep, voffB);
            PG8_WAIT_V(6); PG8_BAR; PG8_MMA(1, 1, At, B1); PG8_BAR;
            }
        }
        if constexpr (ALIGN_EPI) { if (wr == 0) PG8_BAR; }
        if constexpr (!Epi::AFTER_DRAIN) { int t2_ = threadIdx.x; asm volatile("" : "+v"(t2_)); E(acc, cur, wr, wc, t2_ & 15, (t2_ & 63) >> 4); S.done(cur); }
        if (!has_next) break;
#pragma unroll
        for (int a = 0; a < 2; ++a)
#pragma unroll
            for (int b = 0; b < 2; ++b)
#pragma unroll
                for (int m = 0; m < 4; ++m)
#pragma unroll
                    for (int n = 0; n < 2; ++n) acc[a][b][m][n] = (f32x4){0.f, 0.f, 0.f, 0.f};
        cur = nxt; cA = nA; cB = nB; ++ui;
        if constexpr (ALIGN_EPI) { if (wr == 1) PG8_BAR; }
    }
    PG8_WAIT_V(0);
    if constexpr (!ALIGN_EPI) { if (wr == 0) PG8_BAR; }
    PG8_BAR;
    if constexpr (Epi::AFTER_DRAIN) { E.fused(acc, cur, wr, wc, fr, fq, lds, wid, lane); S.done(cur); }
#undef PG8_SA
#undef PG8_SB
#undef PG8_STAGE
#undef PG8_LDA
#undef PG8_LDB
#undef PG8_MMA
#undef PG8_WAIT_V
#undef PG8_WAIT_L
#undef PG8_BAR
#undef PG8_SCHED
}
}

#define DI __device__ __forceinline__
#define LAS __attribute__((address_space(3)))
typedef unsigned short bf16;
typedef short bf16x8 __attribute__((ext_vector_type(8)));
typedef short s16x4 __attribute__((ext_vector_type(4)));
typedef float f32x4 __attribute__((ext_vector_type(4)));
typedef float f32x2 __attribute__((ext_vector_type(2)));
typedef float f32x16 __attribute__((ext_vector_type(16)));
typedef unsigned u32x4 __attribute__((ext_vector_type(4)));
typedef unsigned u32x2 __attribute__((ext_vector_type(2)));
typedef __bf16 bf16x2_t __attribute__((ext_vector_type(2)));
typedef LAS unsigned char lds_u8;

constexpr int NWAVES = 8, NTHREADS = 512;
constexpr int BATCH = 8, SEQ = 4096, D = 1024, DEPTH = 4, M = BATCH * SEQ;
constexpr int HD = 64, FF = 2816, INW = 2816, GUW = 2 * FF;
constexpr float ALPHA = 1.681792830507429f;
constexpr float LN_EPS = 1e-5f, GN_EPS = 1e-6f;
constexpr float LOG2E = 1.4426950408889634f;
constexpr float QSCALE = 0.125f * LOG2E;

constexpr size_t MiB = 1u << 20;
constexpr size_t WS_TAB = 1 * MiB;
constexpr size_t WS_WGU1 = 4 * MiB, WS_WD1 = 16 * MiB, WS_WGU2 = 22 * MiB, WS_WD2 = 34 * MiB, WS_WIN = 40 * MiB, WS_WOUT = 46 * MiB;
constexpr size_t WS_XB = 48 * MiB;
constexpr size_t WS_HB = 112 * MiB;
constexpr size_t WS_YM = 288 * MiB;
constexpr size_t WS_END = 352 * MiB;
constexpr int LDS_BYTES = 147456;

DI unsigned cvtpk(float lo, float hi) { f32x2 v = {lo, hi}; bf16x2_t b = __builtin_convertvector(v, bf16x2_t); return __builtin_bit_cast(unsigned, b); }
DI float bf2f(unsigned short b) { return __uint_as_float((unsigned)b << 16); }
DI float fast_exp2(float x) { return __builtin_amdgcn_exp2f(x); }
DI float fast_rcp(float x) { return __builtin_amdgcn_rcpf(x); }
DI unsigned pk4_fp8(float a, float b, float c, float d) {
    a = fminf(fmaxf(a, -448.f), 448.f); b = fminf(fmaxf(b, -448.f), 448.f); c = fminf(fmaxf(c, -448.f), 448.f); d = fminf(fmaxf(d, -448.f), 448.f);
    int v = __builtin_amdgcn_cvt_pk_fp8_f32(a, b, 0, false); v = __builtin_amdgcn_cvt_pk_fp8_f32(c, d, v, true); return (unsigned)v;
}
constexpr float WGU_SCALE = 64.f, WD_SCALE = 128.f, H_SCALE = 8.f;
DI float q8(float v) {
    const float a = fabsf(v);
    if (a >= 448.f) return copysignf(448.f, v);
    if (a < 0.015625f) return rintf(v * 512.f) * (1.f / 512.f);
    unsigned u = __float_as_uint(v); u += 0x7FFFFu + ((u >> 20) & 1u); u &= 0xFFF00000u; return __uint_as_float(u);
}
#ifdef EMU_FP8
#define Q8S(v, s) (q8((v) * (s)) * (1.0f / (s)))
#else
#define Q8S(v, s) (v)
#endif
DI float silu_f(float a) { return a * fast_rcp(1.0f + fast_exp2(-a * LOG2E)); }
DI float shx(float v, int mask, int lane) { return __builtin_bit_cast(float, __builtin_amdgcn_ds_bpermute(((lane ^ mask) & 63) << 2, __builtin_bit_cast(int, v))); }
DI float wave_sum(float v, int lane) {
#pragma unroll
    for (int o = 1; o < 64; o <<= 1) v += shx(v, o, lane);
    return v;
}
DI int opaque_tid() { int t = threadIdx.x; asm volatile("" : "+v"(t)); return t; }
DI int crow(int r, int hi) { return (r & 3) + 8 * (r >> 2) + 4 * hi; }
#define MFMA32(a, b, c) __builtin_amdgcn_mfma_f32_32x32x16_bf16((a), (b), (c), 0, 0, 0)

namespace pg8 {
struct EpiSwiGLU {
    static constexpr bool PERM = true, AFTER_DRAIN = false;
    bf16_t* H;
    __device__ __forceinline__ void operator()(const f32x4 (&acc)[2][2][4][2], const Unit& u, int wr, int wc, int fr, int fq) const {
        const int row0 = u.pm * BM + wr * 64 + fr, col0 = u.pn * 128 + wc * 32 + 8 * fq;
#pragma unroll
        for (int ai = 0; ai < 2; ++ai)
#pragma unroll
            for (int m = 0; m < 4; ++m) {
                bf16_t* rowp = H + (size_t)(row0 + ai * HALF + m * 16) * FF + col0;
                float h[8];
#pragma unroll
                for (int n = 0; n < 2; ++n)
#pragma unroll
                    for (int j = 0; j < 4; ++j) h[n * 4 + j] = Q8S(silu_f(acc[ai][0][m][n][j]) * acc[ai][1][m][n][j], 8.0f);
                u32x4 w; w.x = cvtpk(h[0], h[1]); w.y = cvtpk(h[2], h[3]); w.z = cvtpk(h[4], h[5]); w.w = cvtpk(h[6], h[7]);
                *(u32x4*)rowp = w;
            }
    }
};
struct EpiSwiGLU8 {
    static constexpr bool PERM = true, AFTER_DRAIN = false;
    unsigned char* H;
    __device__ __forceinline__ void operator()(const f32x4 (&acc)[2][2][4][2], const Unit& u, int wr, int wc, int fr, int fq) const {
        const int row0 = u.pm * BM + wr * 64 + fr, col0 = u.pn * 128 + wc * 32 + 8 * fq;
        const float is = 1.0f / WGU_SCALE;
#pragma unroll
        for (int ai = 0; ai < 2; ++ai)
#pragma unroll
            for (int m = 0; m < 4; ++m) {
                unsigned char* rowp = H + (size_t)(row0 + ai * HALF + m * 16) * FF + col0;
                float h[8];
#pragma unroll
                for (int n = 0; n < 2; ++n)
#pragma unroll
                    for (int j = 0; j < 4; ++j) h[n * 4 + j] = silu_f(acc[ai][0][m][n][j] * is) * (acc[ai][1][m][n][j] * (is * H_SCALE));
                u32x2 w; w.x = pk4_fp8(h[0], h[1], h[2], h[3]); w.y = pk4_fp8(h[4], h[5], h[6], h[7]);
                *(u32x2*)rowp = w;
            }
    }
};
struct EpiResid {
    static constexpr bool PERM = false, AFTER_DRAIN = false;
    const float* X; float* Y; float s;
    __device__ __forceinline__ void operator()(const f32x4 (&acc)[2][2][4][2], const Unit& u, int wr, int wc, int fr, int fq) const {
        const int col0 = u.pn * BM + wc * 32 + 4 * fq;
#pragma unroll
        for (int ai = 0; ai < 2; ++ai)
#pragma unroll
            for (int m = 0; m < 4; ++m) {
                const size_t off = (size_t)(u.pm * BM + ai * HALF + wr * 64 + m * 16 + fr) * D + col0;
#pragma unroll
                for (int bj = 0; bj < 2; ++bj)
#pragma unroll
                    for (int n = 0; n < 2; ++n) {
                        const f32x4 xv = *(const f32x4*)(X + off + bj * HALF + n * 16);
                        *(f32x4*)(Y + off + bj * HALF + n * 16) = xv * ALPHA + acc[ai][bj][m][n] * s;
                    }
            }
    }
};
struct EpiInProj {
    static constexpr bool PERM = true, AFTER_DRAIN = false;
    bf16_t* O; const float* tab;
    __device__ __forceinline__ void operator()(const f32x4 (&acc)[2][2][4][2], const Unit& u, int wr, int wc, int fr, int fq) const {
        const int pn = u.pn;
        int mode;
        float sc = 1.f;
        if (pn < 2) { mode = 1; sc = QSCALE; } else if (pn == 2) { mode = (wc < 2) ? 1 : 0; } else if (pn < 5) { mode = 2; } else if (pn < 7) { mode = 2; sc = 0.125f; } else if (pn < 9) { mode = 0; } else { mode = 3; }
        const int row0 = u.pm * BM + wr * 64 + fr, col0 = pn * 256 + wc * 64 + 8 * fq;
        const float* rc = tab; const float* rs = tab + SEQ * 32; const float* tc = tab + 2 * SEQ * 32; const float* ts = tab + 3 * SEQ * 32;
#pragma unroll
        for (int ai = 0; ai < 2; ++ai)
#pragma unroll
            for (int m = 0; m < 4; ++m) {
                const int row = row0 + ai * HALF + m * 16, pos = row & (SEQ - 1);
                bf16_t* rowp = O + (size_t)row * INW + col0;
                float o[2][8];
                if (mode == 1) {
#pragma unroll
                    for (int n = 0; n < 2; ++n) {
                        const f32x4 c = *(const f32x4*)(rc + pos * 32 + 8 * fq + 4 * n), s = *(const f32x4*)(rs + pos * 32 + 8 * fq + 4 * n);
#pragma unroll
                        for (int j = 0; j < 4; ++j) { const float x1 = acc[ai][0][m][n][j], x2 = acc[ai][1][m][n][j];
                            o[0][n * 4 + j] = (x1 * c[j] - x2 * s[j]) * sc; o[1][n * 4 + j] = (x2 * c[j] + x1 * s[j]) * sc; }
                    }
                } else if (mode == 2) {
#pragma unroll
                    for (int bj = 0; bj < 2; ++bj)
#pragma unroll
                        for (int n = 0; n < 2; ++n) {
                            const f32x2 c = *(const f32x2*)(tc + pos * 32 + bj * 16 + 4 * fq + 2 * n), s = *(const f32x2*)(ts + pos * 32 + bj * 16 + 4 * fq + 2 * n);
#pragma unroll
                            for (int p = 0; p < 2; ++p) { const float xe = acc[ai][bj][m][n][2 * p], xo = acc[ai][bj][m][n][2 * p + 1];
                                o[bj][n * 4 + 2 * p] = (xe * c[p] - xo * s[p]) * sc; o[bj][n * 4 + 2 * p + 1] = (xo * c[p] + xe * s[p]) * sc; }
                        }
                } else {
#pragma unroll
                    for (int bj = 0; bj < 2; ++bj)
#pragma unroll
                        for (int n = 0; n < 2; ++n)
#pragma unroll
                            for (int j = 0; j < 4; ++j) { const float v = acc[ai][bj][m][n][j]; o[bj][n * 4 + j] = (mode == 3) ? silu_f(v) : v; }
                }
#pragma unroll
                for (int bj = 0; bj < 2; ++bj) {
                    u32x4 w; w.x = cvtpk(o[bj][0], o[bj][1]); w.y = cvtpk(o[bj][2], o[bj][3]); w.z = cvtpk(o[bj][4], o[bj][5]); w.w = cvtpk(o[bj][6], o[bj][7]);
                    *(u32x4*)(rowp + bj * 32) = w;
                }
            }
    }
};
}

struct Args {
    const float* x; const float* w_in; const float* w_out; const float* sinks;
    const float* w_gu1; const float* w_d1; const float* w_gu2; const float* w_d2;
    const float* ln_g0; const float* ln_g1; const float* ln_g2; const float* ln_b0; const float* ln_b1; const float* ln_b2;
    float* out; unsigned char* ws; int ph_lo, ph_hi;
};

DI void transpose_item(const float* W, int K, int Nsrc, int srcbase, void* WT, int n0, int k0, LAS float* scr, int lane, float f8s) {
#pragma unroll 8
    for (int i = 0; i < 32; ++i) { const int kk = 2 * i + (lane >> 5); scr[kk * 33 + (lane & 31)] = W[(size_t)(k0 + kk) * Nsrc + srcbase + (lane & 31)]; }
    asm volatile("s_waitcnt lgkmcnt(0)" ::: "memory");
    const int c = lane & 7;
#pragma unroll
    for (int j = 0; j < 4; ++j) { const int n = (lane >> 3) + 8 * j; const LAS float* s = scr + (8 * c) * 33 + n;
        if (f8s == 0.f) {
            u32x4 o; o.x = cvtpk(s[0 * 33], s[1 * 33]); o.y = cvtpk(s[2 * 33], s[3 * 33]); o.z = cvtpk(s[4 * 33], s[5 * 33]); o.w = cvtpk(s[6 * 33], s[7 * 33]);
            *(u32x4*)((bf16*)WT + (size_t)(n0 + n) * K + k0 + 8 * c) = o;
        } else {
            u32x2 o; o.x = pk4_fp8(s[0 * 33] * f8s, s[1 * 33] * f8s, s[2 * 33] * f8s, s[3 * 33] * f8s); o.y = pk4_fp8(s[4 * 33] * f8s, s[5 * 33] * f8s, s[6 * 33] * f8s, s[7 * 33] * f8s);
            *(u32x2*)((unsigned char*)WT + (size_t)(n0 + n) * K + k0 + 8 * c) = o;
        } }
    asm volatile("s_waitcnt lgkmcnt(0)" ::: "memory");
}
DI int src_col(int which, int n0) {
    if (which == 0) { const int pn = n0 >> 8, c = n0 & 255; return (c >> 7) * FF + pn * 128 + (c & 127); }
    if (which == 2) { const int pn = n0 >> 8, c = n0 & 255; return pn * 256 + ((c & 127) >> 5) * 64 + (c >> 7) * 32 + (c & 31); }
    return n0;
}
DI void convert_matrix_items(const float* W, int K, int N, int which, void* WT, LAS float* scr, int lane, int first, int gw, int NGW) {
    const int nblk = N / 32, nitems = (K / 64) * nblk;
    int it = gw - (first % NGW); if (it < 0) it += NGW;
    for (; it < nitems; it += NGW) { const int kb = it / nblk, nb = it % nblk; transpose_item(W, K, N, src_col(which, nb * 32), WT, nb * 32, kb * 64, scr, lane, which == 0 ? WGU_SCALE : (which == 3 ? WD_SCALE : 0.f)); }
}
typedef const Args __attribute__((address_space(4))) CArgs;
DI void convert_layer_weights(const CArgs& a, int l, unsigned char* ws, LAS unsigned char* lds, int wave, int lane, int gw, int NGW) {
    LAS float* scr = (LAS float*)(lds + wave * 16384);
    constexpr int I_GU = (D / 64) * (GUW / 32), I_D = (FF / 64) * (D / 32), I_IN = (D / 64) * (INW / 32), I_OUT = (D / 64) * (D / 32);
    int first = 0;
    convert_matrix_items(a.w_gu1 + (size_t)l * D * GUW, D, GUW, 0, (bf16*)(ws + WS_WGU1), scr, lane, first, gw, NGW); first += I_GU;
    convert_matrix_items(a.w_d1 + (size_t)l * FF * D, FF, D, 3, (bf16*)(ws + WS_WD1), scr, lane, first, gw, NGW); first += I_D;
    convert_matrix_items(a.w_in + (size_t)l * D * INW, D, INW, 2, (bf16*)(ws + WS_WIN), scr, lane, first, gw, NGW); first += I_IN;
    convert_matrix_items(a.w_out + (size_t)l * D * D, D, D, 1, (bf16*)(ws + WS_WOUT), scr, lane, first, gw, NGW); first += I_OUT;
    convert_matrix_items(a.w_gu2 + (size_t)l * D * GUW, D, GUW, 0, (bf16*)(ws + WS_WGU2), scr, lane, first, gw, NGW); first += I_GU;
    convert_matrix_items(a.w_d2 + (size_t)l * FF * D, FF, D, 3, (bf16*)(ws + WS_WD2), scr, lane, first, gw, NGW);
}
DI void sincos_d(double x, float& c, float& s) {
    const double TWO_PI = 6.283185307179586476925;
    const double k = __builtin_rint(x / TWO_PI), r = x - k * TWO_PI, r2 = r * r;
    double sn = r, cs = 1.0, tsn = r, tcs = 1.0;
#pragma unroll 1
    for (int i = 1; i <= 15; ++i) { tcs *= -r2 / (double)((2 * i - 1) * (2 * i)); cs += tcs; tsn *= -r2 / (double)((2 * i) * (2 * i + 1)); sn += tsn; }
    c = (float)cs; s = (float)sn;
}
DI void build_tables(float* tab, int gtid, int nthreads) {
    for (int e = gtid; e < 2 * SEQ * 32; e += nthreads) {
        const int which = e / (SEQ * 32), r = e % (SEQ * 32), pos = r >> 5, i = r & 31;
        const double base = which == 0 ? 0.7498942093324558 : 0.7429639507594947;
        double f = 1.0;
#pragma unroll 1
        for (int k = 0; k < i; ++k) f *= base;
        float c, s; sincos_d((double)pos * f, c, s);
        tab[(size_t)(2 * which) * SEQ * 32 + r] = c; tab[(size_t)(2 * which + 1) * SEQ * 32 + r] = s;
    }
}
DI void row_to_fp8(const float* xrow, unsigned char* orow, int lane) {
    const f32x4* xr = (const f32x4*)xrow + lane; unsigned* o4 = (unsigned*)orow + lane;
#pragma unroll
    for (int j = 0; j < 4; ++j) { const f32x4 v = xr[64 * j]; o4[64 * j] = pk4_fp8(v[0], v[1], v[2], v[3]); }
}
DI void ln_row(const float* yrow, float* xrow, bf16* brow, const float* g, const float* b, int lane, bool quant) {
    const f32x4* yr = (const f32x4*)yrow + lane;
    f32x4 v[4]; float s = 0.f;
#pragma unroll
    for (int j = 0; j < 4; ++j) { v[j] = yr[64 * j]; s += (v[j][0] + v[j][1]) + (v[j][2] + v[j][3]); }
    const float mean = wave_sum(s, lane) * (1.f / D); float s2 = 0.f;
#pragma unroll
    for (int j = 0; j < 4; ++j) { v[j] = v[j] - mean; s2 += (v[j][0] * v[j][0] + v[j][1] * v[j][1]) + (v[j][2] * v[j][2] + v[j][3] * v[j][3]); }
    const float rstd = 1.f / sqrtf(wave_sum(s2, lane) * (1.f / D) + LN_EPS);
    f32x4* xo = (f32x4*)xrow + lane; u32x2* bo = (u32x2*)brow + lane;
#pragma unroll
    for (int j = 0; j < 4; ++j) {
        const f32x4 gg = ((const f32x4*)g)[lane + 64 * j], bb = ((const f32x4*)b)[lane + 64 * j];
        const f32x4 o = v[j] * rstd * gg + bb; xo[64 * j] = o;
        if (quant) { ((unsigned*)brow)[lane + 64 * j] = pk4_fp8(o[0], o[1], o[2], o[3]); }
        else { u32x2 w; w.x = cvtpk(o[0], o[1]); w.y = cvtpk(o[2], o[3]); bo[64 * j] = w; }
    }
}

constexpr int A_KS = 0, A_KSTR = 72 * 2;
constexpr int A_VT = 256 * A_KSTR, A_VSTR = 264 * 2;
constexpr int A_STG = A_VT + 64 * A_VSTR, STG_STR = 72 * 2, STG_BYTES = 32 * STG_STR;
static_assert(A_STG + 8 * STG_BYTES <= 131072, "attention LDS");

DI void stage_out_store(lds_u8* stg, const f32x16 (&o)[2], int r32, int hi) {
#pragma unroll
    for (int db = 0; db < 2; ++db)
#pragma unroll
        for (int rg = 0; rg < 4; ++rg) {
            u32x2 w; w.x = cvtpk(o[db][4 * rg], o[db][4 * rg + 1]); w.y = cvtpk(o[db][4 * rg + 2], o[db][4 * rg + 3]);
            *(LAS u32x2*)(stg + r32 * STG_STR + (db * 32 + 8 * rg + 4 * hi) * 2) = w;
        }
}

DI void attn_unit(lds_u8* lds, const bf16* HM, bf16* YM, const float* sinks, int b, int g, int n) {
    const int tid = opaque_tid(), lane = tid & 63, r32 = lane & 31, hi = lane >> 5, wid = __builtin_amdgcn_readfirstlane(tid >> 6);
    const long keyrow0 = (long)b * SEQ + n * 128 - 128;
    {
        const int token = tid & 255; const bool valid = (n > 0) || (token >= 128);
        const bf16* src = HM + (keyrow0 + token) * INW + 512 + g * 64;
#pragma unroll
        for (int i = 0; i < 4; ++i) {
            const int dc = (tid >> 8) + 2 * i;
            u32x4 kv = {0u, 0u, 0u, 0u}, vv = {0u, 0u, 0u, 0u};
            if (valid) { kv = *(const u32x4*)(src + dc * 8); vv = *(const u32x4*)(src + 128 + dc * 8); }
            *(LAS u32x4*)(lds + A_KS + token * A_KSTR + dc * 16) = kv;
            const bf16x8 v8 = __builtin_bit_cast(bf16x8, vv);
#pragma unroll
            for (int ii = 0; ii < 8; ++ii) *(LAS short*)(lds + A_VT + (dc * 8 + ii) * A_VSTR + token * 2) = v8[ii];
        }
    }
    __syncthreads();
    const int hq = g * 4 + (wid >> 1);
    const float sink2 = sinks[hq] * LOG2E;
    lds_u8* stg = lds + A_STG + wid * STG_BYTES;
    const int jmin = (n == 0) ? 128 : 0;
#pragma unroll 1
    for (int qb = 0; qb < 2; ++qb) {
        const int i0 = (wid & 1) * 64 + qb * 32, iq = i0 + r32;
        const long qrow = (long)b * SEQ + n * 128 + iq;
        bf16x8 qf[4];
#pragma unroll
        for (int ks = 0; ks < 4; ++ks) qf[ks] = *(const bf16x8*)(HM + qrow * INW + hq * 64 + ks * 16 + hi * 8);
        float mrun = sink2, lrun = (hi == 0) ? 1.f : 0.f;
        f32x16 o[2];
#pragma unroll
        for (int r = 0; r < 16; ++r) { o[0][r] = 0.f; o[1][r] = 0.f; }
#pragma unroll 1
        for (int t = 0; t < 5; ++t) {
            const int kb = i0 + 32 * t;
            f32x16 s;
#pragma unroll
            for (int r = 0; r < 16; ++r) s[r] = 0.f;
#pragma unroll
            for (int ks = 0; ks < 4; ++ks) {
                const bf16x8 kf = *(const LAS bf16x8*)(lds + A_KS + (kb + r32) * A_KSTR + (ks * 16 + hi * 8) * 2);
                s = MFMA32(kf, qf[ks], s);
            }
            float tmax = -INFINITY;
#pragma unroll
            for (int r = 0; r < 16; ++r) { const int jj = kb + crow(r, hi); const bool vis = (jj > iq) && (jj <= iq + 128) && (jj >= jmin); s[r] = vis ? s[r] : -INFINITY; tmax = fmaxf(tmax, s[r]); }
            tmax = fmaxf(tmax, shx(tmax, 32, lane));
            const float mnew = fmaxf(mrun, tmax), scl = fast_exp2(mrun - mnew);
            mrun = mnew;
            float psum = 0.f;
#pragma unroll
            for (int r = 0; r < 16; ++r) { s[r] = fast_exp2(s[r] - mnew); psum += s[r]; }
            lrun = lrun * scl + psum;
#pragma unroll
            for (int r = 0; r < 16; ++r) { o[0][r] *= scl; o[1][r] *= scl; }
#pragma unroll
            for (int gk = 0; gk < 2; ++gk) {
                u32x4 pw; pw.x = cvtpk(s[8 * gk], s[8 * gk + 1]); pw.y = cvtpk(s[8 * gk + 2], s[8 * gk + 3]); pw.z = cvtpk(s[8 * gk + 4], s[8 * gk + 5]); pw.w = cvtpk(s[8 * gk + 6], s[8 * gk + 7]);
                const bf16x8 pf = __builtin_bit_cast(bf16x8, pw);
#pragma unroll
                for (int db = 0; db < 2; ++db) {
                    const lds_u8* vp = lds + A_VT + (db * 32 + r32) * A_VSTR + (kb + 16 * gk + 4 * hi) * 2;
                    const s16x4 lo = *(const LAS s16x4*)vp, hi4 = *(const LAS s16x4*)(vp + 16);
                    const bf16x8 vf = __builtin_shufflevector(lo, hi4, 0, 1, 2, 3, 4, 5, 6, 7);
                    o[db] = MFMA32(vf, pf, o[db]);
                }
            }
        }
        const float ltot = lrun + shx(lrun, 32, lane), inv = 1.0f / ltot;
#pragma unroll
        for (int r = 0; r < 16; ++r) { o[0][r] *= inv; o[1][r] *= inv; }
        stage_out_store(stg, o, r32, hi);
        asm volatile("s_waitcnt lgkmcnt(0)" ::: "memory");
        bf16* yw = YM + ((long)b * SEQ + n * 128 + i0) * D + hq * 64;
#pragma unroll
        for (int it = 0; it < 4; ++it) { const int row = it * 8 + (lane >> 3), ch = lane & 7;
            const u32x4 v = *(const LAS u32x4*)(stg + row * STG_STR + ch * 16); *(u32x4*)(yw + (long)row * D + ch * 8) = v; }
        asm volatile("s_waitcnt lgkmcnt(0)" ::: "memory");
    }
    __syncthreads();
}

constexpr int R_QS = 0, R_KS = 128 * 144, R_VT = 2 * 128 * 144, R_TSTR = 136 * 2, R_KT = R_VT + 64 * R_TSTR, R_ST = R_KT + 64 * R_TSTR, R_STG = R_ST + 64 * 144;
static_assert(R_STG + 4 * STG_BYTES <= 131072, "retention LDS");

DI void ret_unit(lds_u8* lds, const bf16* HM, bf16* YM, int b, int h, int seg) {
    const int tid = opaque_tid(), lane = tid & 63, r32 = lane & 31, hi = lane >> 5, wid = __builtin_amdgcn_readfirstlane(tid >> 6);
    float lg2;
    { int hh_ = h; asm volatile("" : "+s"(hh_)); const double x = __builtin_ldexp(1.0, -5 - hh_); double t = x, s = 0.0;
#pragma unroll 1
      for (int k = 1; k <= 10; ++k) { s -= t / (double)k; t *= x; }
      lg2 = (float)(s * 1.4426950408889634); }
    const float gchunk = fast_exp2(128.f * lg2);
    const int token = tid & 127, dc0 = tid >> 7;
    const float wk = fast_exp2((float)(127 - token) * lg2);
    const long row0 = (long)b * SEQ;
    const int nfull0 = 8 * seg, nend = nfull0 + 8;
    for (int i = tid; i < 64 * 144 / 4; i += NTHREADS) *(LAS unsigned*)(lds + R_ST + i * 4) = 0u;
    f32x16 st;
#pragma unroll
    for (int r = 0; r < 16; ++r) st[r] = 0.f;
    u32x4 pq[2], pk[2], pv[2];
#pragma unroll
    for (int i = 0; i < 2; ++i) pq[i] = (u32x4){0u, 0u, 0u, 0u};
    { const bf16* src = HM + (row0 + token) * INW + h * 64;
#pragma unroll
      for (int i = 0; i < 2; ++i) { const int dc = dc0 + 4 * i; if (nfull0 == 0) pq[i] = *(const u32x4*)(src + 768 + dc * 8); pk[i] = *(const u32x4*)(src + 1280 + dc * 8); pv[i] = *(const u32x4*)(src + 1792 + dc * 8); } }
#pragma unroll 1
    for (int n = 0; n < nend; ++n) {
        const bool full = (n >= nfull0);
#pragma unroll
        for (int i = 0; i < 2; ++i) {
            const int dc = dc0 + 4 * i;
            if (full) { *(LAS u32x4*)(lds + R_QS + token * 144 + dc * 16) = pq[i]; *(LAS u32x4*)(lds + R_KS + token * 144 + dc * 16) = pk[i]; }
            const bf16x8 k8 = __builtin_bit_cast(bf16x8, pk[i]), v8 = __builtin_bit_cast(bf16x8, pv[i]);
#pragma unroll
            for (int ii = 0; ii < 8; ii += 2) {
                const unsigned kk = cvtpk(bf2f((unsigned short)k8[ii]) * wk, bf2f((unsigned short)k8[ii + 1]) * wk);
                *(LAS short*)(lds + R_KT + (dc * 8 + ii) * R_TSTR + token * 2) = (short)(kk & 0xffffu);
                *(LAS short*)(lds + R_KT + (dc * 8 + ii + 1) * R_TSTR + token * 2) = (short)(kk >> 16);
                *(LAS short*)(lds + R_VT + (dc * 8 + ii) * R_TSTR + token * 2) = v8[ii];
                *(LAS short*)(lds + R_VT + (dc * 8 + ii + 1) * R_TSTR + token * 2) = v8[ii + 1];
            }
        }
        __syncthreads();
        if (n + 1 < nend) { const bf16* src = HM + (row0 + (n + 1) * 128 + token) * INW + h * 64; const bool nq = (n + 1 >= nfull0);
#pragma unroll
            for (int i = 0; i < 2; ++i) { const int dc = dc0 + 4 * i; if (nq) pq[i] = *(const u32x4*)(src + 768 + dc * 8); pk[i] = *(const u32x4*)(src + 1280 + dc * 8); pv[i] = *(const u32x4*)(src + 1792 + dc * 8); } }
        if (wid < 4) {
          if (full) {
            const int ib = wid, iq = 32 * ib + r32;
            const long trow = row0 + n * 128 + 32 * ib;
            u32x4 gv[4];
#pragma unroll
            for (int it = 0; it < 4; ++it) gv[it] = *(const u32x4*)(HM + (trow + it * 8 + (lane >> 3)) * INW + 2304 + h * 64 + (lane & 7) * 8);
            bf16x8 qf[4];
#pragma unroll
            for (int ks = 0; ks < 4; ++ks) qf[ks] = *(const LAS bf16x8*)(lds + R_QS + iq * 144 + (ks * 16 + hi * 8) * 2);
            f32x16 o[2];
#pragma unroll
            for (int r = 0; r < 16; ++r) { o[0][r] = 0.f; o[1][r] = 0.f; }
#pragma unroll
            for (int eb = 0; eb < 2; ++eb)
#pragma unroll
                for (int ks = 0; ks < 4; ++ks) {
                    const bf16x8 sf = *(const LAS bf16x8*)(lds + R_ST + (eb * 32 + r32) * 144 + (ks * 16 + hi * 8) * 2);
                    o[eb] = MFMA32(sf, qf[ks], o[eb]);
                }
            const float wq = fast_exp2((float)(iq + 1) * lg2);
#pragma unroll
            for (int r = 0; r < 16; ++r) { o[0][r] *= wq; o[1][r] *= wq; }
#pragma unroll 1
            for (int jb = 0; jb <= ib; ++jb) {
                f32x16 s;
#pragma unroll
                for (int r = 0; r < 16; ++r) s[r] = 0.f;
#pragma unroll
                for (int ks = 0; ks < 4; ++ks) {
                    const bf16x8 kf = *(const LAS bf16x8*)(lds + R_KS + (jb * 32 + r32) * 144 + (ks * 16 + hi * 8) * 2);
                    s = MFMA32(kf, qf[ks], s);
                }
#pragma unroll
                for (int r = 0; r < 16; ++r) { const int dj = iq - (jb * 32 + crow(r, hi)); s[r] = (dj >= 0) ? s[r] * fast_exp2((float)dj * lg2) : 0.f; }
#pragma unroll
                for (int gk = 0; gk < 2; ++gk) {
                    u32x4 pw; pw.x = cvtpk(s[8 * gk], s[8 * gk + 1]); pw.y = cvtpk(s[8 * gk + 2], s[8 * gk + 3]); pw.z = cvtpk(s[8 * gk + 4], s[8 * gk + 5]); pw.w = cvtpk(s[8 * gk + 6], s[8 * gk + 7]);
                    const bf16x8 pf = __builtin_bit_cast(bf16x8, pw);
#pragma unroll
                    for (int eb = 0; eb < 2; ++eb) {
                        const lds_u8* vp = lds + R_VT + (eb * 32 + r32) * R_TSTR + (jb * 32 + 16 * gk + 4 * hi) * 2;
                        const s16x4 lo = *(const LAS s16x4*)vp, hi4 = *(const LAS s16x4*)(vp + 16);
                        const bf16x8 vf = __builtin_shufflevector(lo, hi4, 0, 1, 2, 3, 4, 5, 6, 7);
                        o[eb] = MFMA32(vf, pf, o[eb]);
                    }
                }
            }
            float sm = 0.f;
#pragma unroll
            for (int r = 0; r < 16; ++r) sm += o[0][r] + o[1][r];
            sm += shx(sm, 32, lane);
            const float mu = sm * (1.f / 64.f);
            float sq = 0.f;
#pragma unroll
            for (int r = 0; r < 16; ++r) { o[0][r] -= mu; o[1][r] -= mu; sq += o[0][r] * o[0][r] + o[1][r] * o[1][r]; }
            sq += shx(sq, 32, lane);
            const float rstd = 1.f / sqrtf(sq * (1.f / 64.f) + GN_EPS);
#pragma unroll
            for (int r = 0; r < 16; ++r) { o[0][r] *= rstd; o[1][r] *= rstd; }
            lds_u8* stg = lds + R_STG + wid * STG_BYTES;
            stage_out_store(stg, o, r32, hi);
            asm volatile("s_waitcnt lgkmcnt(0)" ::: "memory");
#pragma unroll
            for (int it = 0; it < 4; ++it) { const int row = it * 8 + (lane >> 3), ch = lane & 7;
                const u32x4 ov = *(const LAS u32x4*)(stg + row * STG_STR + ch * 16);
                const bf16x8 o8 = __builtin_bit_cast(bf16x8, ov), g8 = __builtin_bit_cast(bf16x8, gv[it]);
                u32x4 w;
                w.x = cvtpk(bf2f((unsigned short)o8[0]) * bf2f((unsigned short)g8[0]), bf2f((unsigned short)o8[1]) * bf2f((unsigned short)g8[1]));
                w.y = cvtpk(bf2f((unsigned short)o8[2]) * bf2f((unsigned short)g8[2]), bf2f((unsigned short)o8[3]) * bf2f((unsigned short)g8[3]));
                w.z = cvtpk(bf2f((unsigned short)o8[4]) * bf2f((unsigned short)g8[4]), bf2f((unsigned short)o8[5]) * bf2f((unsigned short)g8[5]));
                w.w = cvtpk(bf2f((unsigned short)o8[6]) * bf2f((unsigned short)g8[6]), bf2f((unsigned short)o8[7]) * bf2f((unsigned short)g8[7]));
                *(u32x4*)(YM + (trow + row) * D + 512 + h * 64 + ch * 8) = w; }
          }
        } else {
            const int eb = (wid - 4) >> 1, dk = (wid - 4) & 1;
#pragma unroll
            for (int r = 0; r < 16; ++r) st[r] *= gchunk;
#pragma unroll
            for (int ks = 0; ks < 8; ++ks) {
                const bf16x8 vf = *(const LAS bf16x8*)(lds + R_VT + (eb * 32 + r32) * R_TSTR + (ks * 16 + hi * 8) * 2);
                const bf16x8 kf = *(const LAS bf16x8*)(lds + R_KT + (dk * 32 + r32) * R_TSTR + (ks * 16 + hi * 8) * 2);
                st = MFMA32(vf, kf, st);
            }
        }
        __syncthreads();
        if (wid >= 4 && n + 1 >= nfull0) {
            const int eb = (wid - 4) >> 1, dk = (wid - 4) & 1;
#pragma unroll
            for (int r = 0; r < 16; ++r) *(LAS short*)(lds + R_ST + (eb * 32 + crow(r, hi)) * 144 + (dk * 32 + r32) * 2) = (short)(cvtpk(st[r], 0.f) & 0xffffu);
        }
    }
    __syncthreads();
}

#define XB_TMO      128
#define XB_XCNT(j)  (256  + 64 * (j))
#define XB_XSUB(j)  (1280 + 64 * (j))
#define XB_XGEN(j)  (2304 + 64 * (j))
#define XB_TOP      3328
#define XB_TOPGEN   3392
#define XCD_BAR_WORDS 3456
#define XB_SPIN_CAP (1u << 18)

__device__ __forceinline__ unsigned xb_ld(unsigned* p)              { return __hip_atomic_load(p, __ATOMIC_RELAXED, __HIP_MEMORY_SCOPE_AGENT); }
__device__ __forceinline__ unsigned xb_add(unsigned* p, unsigned v) { return __hip_atomic_fetch_add(p, v, __ATOMIC_RELAXED, __HIP_MEMORY_SCOPE_AGENT); }
__device__ __forceinline__ unsigned xb_xcc_id() { return (unsigned)__builtin_amdgcn_s_getreg((3 << 11) | 20) & 0xFu; }
#define XB_SPIN(cond, bar) do { unsigned _sp = 0; while (cond) { __builtin_amdgcn_s_sleep(1); \
    if ((++_sp & 255u) == 0u) { if (xb_ld(&(bar)[XB_TMO])) break; if (_sp > XB_SPIN_CAP) { atomicAdd(&(bar)[XB_TMO], 1u); break; } } } } while (0)

struct XcdBarrier {
    unsigned* bar; unsigned x;
    volatile LAS unsigned* st;
};

__device__ __forceinline__ XcdBarrier xcd_barrier_post(unsigned* bar, volatile LAS unsigned* st) {
    XcdBarrier b; b.bar = bar; b.x = xb_xcc_id(); b.st = st;
    if (opaque_tid() == 0) (void)xb_add(&bar[XB_XCNT(b.x)], 1u);
    return b;
}
__device__ __forceinline__ void xcd_barrier_complete(unsigned* bar, unsigned x, unsigned& nloc, unsigned& nx) {
    const unsigned G = gridDim.x * gridDim.y * gridDim.z;
    unsigned sum, cnt, mine, sp = 0u;
    for (;;) {
        sum = 0u; cnt = 0u; mine = 0u;
#pragma unroll
        for (unsigned j = 0; j < 16; ++j) { const unsigned c = xb_ld(&bar[XB_XCNT(j)]); sum += c; cnt += (c > 0u) ? 1u : 0u; mine = (j == x) ? c : mine; }
        if (sum == G) break;
        __builtin_amdgcn_s_sleep(1);
        if ((++sp & 255u) == 0u) { if (xb_ld(&bar[XB_TMO])) break; if (sp > XB_SPIN_CAP) { atomicAdd(&bar[XB_TMO], 1u); break; } }
    }
    nloc = mine > 0u ? mine : 1u; nx = cnt > 0u ? cnt : 1u;
}

__device__ __forceinline__ void xcd_barrier(const XcdBarrier& b) {
    asm volatile("s_waitcnt vmcnt(0)" ::: "memory");
    __syncthreads();
    if (opaque_tid() == 0) {
        unsigned* bar = b.bar;
        __builtin_amdgcn_s_waitcnt(0);
        unsigned nloc = b.st[0], nx = b.st[1];
        if (nloc == 0u) { xcd_barrier_complete(bar, b.x, nloc, nx); b.st[0] = nloc; b.st[1] = nx; }
        const unsigned old = xb_add(&bar[XB_XSUB(b.x)], 1u);
        const unsigned gen = old / nloc;
        if (old + 1u == (gen + 1u) * nloc) {
            __builtin_amdgcn_fence(__ATOMIC_RELEASE, "agent");
            asm volatile("s_waitcnt vmcnt(0)" ::: "memory");
            const unsigned og = xb_add(&bar[XB_TOP], 1u);
            const unsigned tg = og / nx;
            if (og + 1u == (tg + 1u) * nx) xb_add(&bar[XB_TOPGEN], 1u);
            else XB_SPIN(xb_ld(&bar[XB_TOPGEN]) == tg, bar);
            __builtin_amdgcn_fence(__ATOMIC_ACQUIRE, "agent");
            xb_add(&bar[XB_XGEN(b.x)], 1u);
            asm volatile("s_waitcnt vmcnt(0)" ::: "memory");
        } else {
            XB_SPIN(xb_ld(&bar[XB_XGEN(b.x)]) == gen, bar);
            __builtin_amdgcn_fence(__ATOMIC_ACQUIRE, "agent");
            asm volatile("s_waitcnt vmcnt(0)" ::: "memory");
        }
    }
    __syncthreads();
}
#ifdef SKIP_RET
#define RET_UNIT(bb, hh, ss)
#else
#define RET_UNIT(bb, hh, ss) ret_unit(lds, HB, YM, (bb), (hh), (ss))
#endif
#ifdef SKIP_ATT
#define ATT_UNIT(bb, gg, nn)
#else
#define ATT_UNIT(bb, gg, nn) attn_unit(lds, HB, YM, a.sinks + l * 8, (bb), (gg), (nn))
#endif
__global__ void __launch_bounds__(NTHREADS, 2) mk_fwd(Args a_) {
    extern __shared__ __attribute__((aligned(16))) unsigned char lds_raw[];
    {
        volatile LAS unsigned* MISC0 = (volatile LAS unsigned*)((LAS unsigned char*)lds_raw + 131072 + 320);
        if (opaque_tid() < 64) MISC0[opaque_tid()] = 0u;
        __syncthreads();
    }
    bool bar_ready = false;
    const int ph_lo = a_.ph_lo, ph_hi = a_.ph_hi;
#pragma unroll 1
    for (int ph = ph_lo; ph < ph_hi; ++ph) {
        int z_ = 0; asm volatile("" : "+s"(z_));
        const CArgs* ap_ = (const CArgs*)__builtin_amdgcn_kernarg_segment_ptr(); asm volatile("" : "+s"(ap_)); const CArgs& a = *ap_;
        LAS unsigned char* lds = (LAS unsigned char*)lds_raw + z_;
        const int G = gridDim.x + z_, bx = blockIdx.x + z_;
        const int vcu = (G % 8 == 0) ? (bx % 8) * (G / 8) + bx / 8 : bx;
        const int NGW = G * NWAVES;
        unsigned char* ws = a.ws + z_;
        float* tab = (float*)(ws + WS_TAB);
        bf16* XB = (bf16*)(ws + WS_XB); bf16* HB = (bf16*)(ws + WS_HB); bf16* YM = (bf16*)(ws + WS_YM);
        float* X = a.out + z_;
        if (ph == 0) {
            const int tid = opaque_tid(), lane = tid & 63, wave = __builtin_amdgcn_readfirstlane(tid >> 6), gw = vcu * NWAVES + wave;
            if (bx == 0) for (int i = tid; i < XCD_BAR_WORDS; i += NTHREADS) ((unsigned*)ws)[i] = 0u;
            build_tables(tab, vcu * NTHREADS + tid, G * NTHREADS);
            convert_layer_weights(a, 0, ws, lds, wave, lane, gw, NGW);
            for (int m = gw; m < M; m += NGW) row_to_fp8(a.x + (size_t)m * D, (unsigned char*)XB + (size_t)m * D, lane);
        } else {
            const int l = (ph - 1) / 10, s = (ph - 1) % 10;
            if (s == 0 || s == 7) {
                pg8::Gemm g{XB, (const bf16*)(ws + (s == 0 ? WS_WGU1 : WS_WGU2)), M, GUW, D / 2}; pg8::StaticOrder S; S.init(M, GUW, G, bx);
                pg8::EpiSwiGLU8 E{(unsigned char*)HB};
                pg8::gemm_phase<pg8::EpiSwiGLU8, pg8::StaticOrder, true, true, true>(lds, g, S, E);
            } else if (s == 1 || s == 8) {
                pg8::Gemm g{HB, (const bf16*)(ws + (s == 1 ? WS_WD1 : WS_WD2)), M, D, FF / 2}; pg8::StaticOrder S; S.init(M, D, G, bx);
                pg8::EpiResid E{(l == 0 && s == 1) ? a.x : X, X, 0.5f / (WD_SCALE * H_SCALE)};
                pg8::gemm_phase<pg8::EpiResid, pg8::StaticOrder, true, true, true>(lds, g, S, E);
            } else if (s == 5) {
                pg8::Gemm g{YM, (const bf16*)(ws + WS_WOUT), M, D, D}; pg8::StaticOrder S; S.init(M, D, G, bx);
                pg8::EpiResid E{X, X, 1.0f};
                pg8::gemm_phase<pg8::EpiResid, pg8::StaticOrder, true, true, false>(lds, g, S, E);
            } else if (s == 3) {
                pg8::Gemm g{XB, (const bf16*)(ws + WS_WIN), M, INW, D}; pg8::StaticOrder S; S.init(M, INW, G, bx);
                pg8::EpiInProj E{HB, tab};
                pg8::gemm_phase<pg8::EpiInProj, pg8::StaticOrder, true, true, false>(lds, g, S, E);
            } else if (s == 4) {
                if (G == 256) {
                    const int seg = vcu & 3, a0 = (vcu >> 2) * 8 + (seg == 0 ? 0 : (seg == 1 ? 3 : (seg == 2 ? 5 : 7))), an = (seg == 0 ? 3 : (seg == 3 ? 1 : 2));
                    RET_UNIT(vcu >> 5, (vcu >> 2) & 7, seg);
                    for (int u = a0; u < a0 + an; ++u) { ATT_UNIT(u >> 6, (u >> 5) & 1, u & 31); }
                } else {
                    for (int u = vcu; u < 256; u += G) { RET_UNIT(u >> 5, (u >> 2) & 7, u & 3); }
                    for (int u = vcu; u < BATCH * 2 * 32; u += G) { ATT_UNIT(u >> 6, (u >> 5) & 1, u & 31); }
                }
            } else {
                const int tid = opaque_tid(), lane = tid & 63, wave = __builtin_amdgcn_readfirstlane(tid >> 6), gw = vcu * NWAVES + wave;
                const int k = (s == 2) ? 0 : (s == 6 ? 1 : 2);
                const float* gp = (k == 0 ? a.ln_g0 : (k == 1 ? a.ln_g1 : a.ln_g2)) + l * D; const float* bp = (k == 0 ? a.ln_b0 : (k == 1 ? a.ln_b1 : a.ln_b2)) + l * D;
                for (int m = gw; m < M; m += NGW) ln_row(X + (size_t)m * D, X + (size_t)m * D, (s != 2) ? (bf16*)((unsigned char*)XB + (size_t)m * D) : XB + (size_t)m * D, gp, bp, lane, s != 2);
                if (s == 9 && l + 1 < DEPTH) convert_layer_weights(a, l + 1, ws, lds, wave, lane, gw, NGW);
            }
        }
        if (ph + 1 < ph_hi) {
            unsigned* bw_ = (unsigned*)ws; volatile LAS unsigned* st_ = (volatile LAS unsigned*)(lds + 131072 + 320) + 8;
            if (!bar_ready) { __syncthreads(); cg::this_grid().sync(); (void)xcd_barrier_post(bw_, st_); bar_ready = true; }
            else { XcdBarrier bar; bar.bar = bw_; bar.x = xb_xcc_id(); bar.st = st_; xcd_barrier(bar); }
        }
    }
}

extern "C" void kernel_launch(void* const* d_in, const int* in_sizes, int n_in, void* d_out, int out_size, void* d_ws, size_t ws_size, hipStream_t stream) {
    static int grid = 0;
    if (grid == 0) {
        if (n_in != 14 || in_sizes[0] != M * D || out_size != M * D || ws_size < WS_END) { fprintf(stderr, "kernel_launch: unexpected shapes: n_in %d in0 %d out %d ws %zu\n", n_in, n_in > 0 ? in_sizes[0] : -1, out_size, ws_size); grid = -1; return; }
        int dev = 0, cus = 0, per_cu = 0;
        if (hipGetDevice(&dev) != hipSuccess || hipDeviceGetAttribute(&cus, hipDeviceAttributeMultiprocessorCount, dev) != hipSuccess) { grid = -1; return; }
        if (hipFuncSetAttribute((const void*)mk_fwd, hipFuncAttributeMaxDynamicSharedMemorySize, LDS_BYTES) != hipSuccess) { fprintf(stderr, "kernel_launch: hipFuncSetAttribute failed\n"); grid = -1; return; }
        if (hipOccupancyMaxActiveBlocksPerMultiprocessor(&per_cu, (const void*)mk_fwd, NTHREADS, LDS_BYTES) != hipSuccess || per_cu < 1) { fprintf(stderr, "kernel_launch: occupancy query gave %d\n", per_cu); per_cu = 1; }
        (void)hipGetLastError();
        grid = cus * per_cu;
        fprintf(stderr, "kernel_launch: grid %d (cus %d x %d)\n", grid, cus, per_cu);
    }
    if (grid < 0) return;
    Args a{};
    a.x = (const float*)d_in[0]; a.w_in = (const float*)d_in[1]; a.w_out = (const float*)d_in[2]; a.sinks = (const float*)d_in[3];
    a.w_gu1 = (const float*)d_in[4]; a.w_d1 = (const float*)d_in[5]; a.w_gu2 = (const float*)d_in[6]; a.w_d2 = (const float*)d_in[7];
    a.ln_g0 = (const float*)d_in[8]; a.ln_b0 = (const float*)d_in[9]; a.ln_g1 = (const float*)d_in[10]; a.ln_b1 = (const float*)d_in[11];
    a.ln_g2 = (const float*)d_in[12]; a.ln_b2 = (const float*)d_in[13];
    a.out = (float*)d_out; a.ws = (unsigned char*)d_ws;
    constexpr int NPH = 1 + 10 * DEPTH;
#if MK_ONE_LAUNCH
    a.ph_lo = 0; a.ph_hi = NPH;
    void* params[] = {&a};
    hipError_t e = hipLaunchCooperativeKernel((const void*)mk_fwd, dim3(grid), dim3(NTHREADS), params, LDS_BYTES, stream);
    if (e != hipSuccess) fprintf(stderr, "kernel_launch: cooperative launch failed: %s (grid %d)\n", hipGetErrorString(e), grid);
#else
    for (int p = 0; p < NPH; ++p) { a.ph_lo = p; a.ph_hi = p + 1; hipLaunchKernelGGL(mk_fwd, dim3(grid), dim3(NTHREADS), LDS_BYTES, stream, a); }
#endif
}
```

```cpp
#include <hip/hip_runtime.h>
#include <hip/hip_cooperative_groups.h>
#include <cstdio>
#include <cstdint>
namespace cg = cooperative_groups;
#ifndef MK_ONE_LAUNCH
#define MK_ONE_LAUNCH 1
#endif
namespace pg8 {
#define PG8_LAS __attribute__((address_space(3)))
typedef unsigned short bf16_t;
typedef short bf16x8 __attribute__((ext_vector_type(8)));
typedef float f32x4 __attribute__((ext_vector_type(4)));
typedef unsigned u32x4 __attribute__((ext_vector_type(4)));
constexpr int BM = 256, BK = 64, HALF = 128, HTB = HALF * BK * 2  , STAGE_BYTES = 8 * HTB, NXCD = 8, WGM = 8;

__host__ __device__ __forceinline__ int lds_byte(int r, int c) { const int st = (r >> 4) * 2 + (c >> 5), rr = r & 15, cc = c & 31, ob = rr * 64 + cc * 2; return st * 1024 + (ob ^ (((ob >> 9) & 1) << 5)); }
__host__ __device__ __forceinline__ void stage_rc(int b, int& R, int& C) { const int st = b / 1024, sb = b % 1024, swz = sb ^ (((sb >> 9) & 1) << 5); R = (st >> 1) * 16 + swz / 64; C = (st & 1) * 32 + (swz % 64) / 2; }
__host__ __device__ __forceinline__ int perm32(int rho) { const int n = rho >> 4, i = rho & 15; return 8 * (i >> 2) + 4 * n + (i & 3); }

struct Unit { int pm, pn; };
struct Gemm { const bf16_t* A; const bf16_t* Bt; int M, N, K; };

struct StaticOrder {
    int nM, nN, nwg, G, c;
    __host__ __device__ void init(int M, int N, int G_, int c_) { nM = M / BM; nN = N / BM; nwg = nM * nN; G = G_; c = c_; }
    __host__ __device__ bool next(int i, Unit& u) const {
        const long L = (long)i * G + c; if (L >= nwg) return false;
        int wgid = (int)L; { const int q = nwg / NXCD, r = nwg % NXCD, xcd = wgid % NXCD, off = wgid / NXCD; wgid = (xcd < r ? xcd * (q + 1) : r * (q + 1) + (xcd - r) * q) + off; }
        const int nig = WGM * nN, gid = wgid / nig, fm = gid * WGM, gsz = (nM - fm) < WGM ? (nM - fm) : WGM;
        u.pm = fm + ((wgid % nig) % gsz); u.pn = (wgid % nig) / gsz; return true;
    }
    __device__ __forceinline__ void a_ready(const Unit&) const {}
    __device__ __forceinline__ void done(const Unit&) const {}
};

__device__ __forceinline__ unsigned cvt_pk_bf16(float lo, float hi) { unsigned r; asm volatile("v_cvt_pk_bf16_f32 %0, %1, %2" : "=v"(r) : "v"(lo), "v"(hi)); return r; }
typedef float f32x2 __attribute__((ext_vector_type(2)));
__device__ __forceinline__ f32x2 gelu_pk(f32x2 v) {
    const f32x2 av = __builtin_elementwise_abs(v), d = av * 0.2316418882f + 1.0f;
    f32x2 t; t.x = __builtin_amdgcn_rcpf(d.x); t.y = __builtin_amdgcn_rcpf(d.y);
    f32x2 q = t * 0.5307027145f + (-0.7265760135f); q = q * t + 0.7107068705f; q = q * t + (-0.142248368f); q = q * t + 0.127414796f; q = q * t;
    const f32x2 s = (v * v) * (-0.72134752044f);
    f32x2 e; e.x = __builtin_amdgcn_exp2f(s.x); e.y = __builtin_amdgcn_exp2f(s.y);
    const f32x2 m = v * (q * e), r = v - m;
    f32x2 o; o.x = v.x < 0.f ? m.x : r.x; o.y = v.y < 0.f ? m.y : r.y; return o;
}

template <int ACT  > struct EpiBf16 {
    static constexpr bool PERM = true, AFTER_DRAIN = false; static_assert(ACT == 0 || ACT == 1, "EpiBf16: ACT is 0 (none) or 1 (gelu_pk)");
    bf16_t* O; int ldc; const float* bias; int split_cols; size_t split_stride; float scale0;
    __device__ __forceinline__ void operator()(const f32x4 (&acc)[2][2][4][2], const Unit& u, int wr, int wc, int fr, int fq) const {
        const int row0 = u.pm * BM + wr * 64 + fr; int colt = u.pn * BM; bf16_t* base = O;
        float sc = 1.f; if (split_cols) { const int t = colt / split_cols; base += (size_t)t * split_stride; colt -= t * split_cols; if (t == 0) sc = scale0; }
        const int col0 = colt + wc * 32 + 8 * fq, bcol0 = u.pn * BM + wc * 32 + 8 * fq;
        f32x4 bv[2][2];
#pragma unroll
        for (int bj = 0; bj < 2; ++bj)
#pragma unroll
            for (int n = 0; n < 2; ++n) bv[bj][n] = bias ? *(const f32x4*)(bias + bcol0 + bj * HALF + 4 * n) : (f32x4){0.f, 0.f, 0.f, 0.f};
#pragma unroll
        for (int ai = 0; ai < 2; ++ai)
#pragma unroll
            for (int m = 0; m < 4; ++m) { bf16_t* rowp = base + (size_t)(row0 + ai * HALF + m * 16) * ldc + col0;
#pragma unroll
                for (int bj = 0; bj < 2; ++bj) { f32x4 v0 = acc[ai][bj][m][0] + bv[bj][0], v1 = acc[ai][bj][m][1] + bv[bj][1];
                    if (ACT == 1) { f32x2 a = gelu_pk((f32x2){v0[0], v0[1]}), b = gelu_pk((f32x2){v0[2], v0[3]}), c = gelu_pk((f32x2){v1[0], v1[1]}), d = gelu_pk((f32x2){v1[2], v1[3]});
                        v0 = (f32x4){a.x, a.y, b.x, b.y}; v1 = (f32x4){c.x, c.y, d.x, d.y}; }
                    v0 = v0 * sc; v1 = v1 * sc; u32x4 w; w.x = cvt_pk_bf16(v0[0], v0[1]); w.y = cvt_pk_bf16(v0[2], v0[3]); w.z = cvt_pk_bf16(v1[0], v1[1]); w.w = cvt_pk_bf16(v1[2], v1[3]);
                    *(u32x4*)(rowp + bj * HALF) = w; } }
    }
};
typedef int i32x4_t __attribute__((ext_vector_type(4))); typedef int i32x8_t __attribute__((ext_vector_type(8)));
__device__ __forceinline__ i32x8_t cat8(bf16x8 lo, bf16x8 hi) { return __builtin_shufflevector(__builtin_bit_cast(i32x4_t, lo), __builtin_bit_cast(i32x4_t, hi), 0, 1, 2, 3, 4, 5, 6, 7); }
template <class Epi, class Sched, bool ALIGN_EPI = false, bool SP2 = false, bool F8 = false>
__device__ __forceinline__ void gemm_phase(PG8_LAS unsigned char* lds, const Gemm g, const Sched& S, const Epi& E) {
    int tid_ = threadIdx.x; asm volatile("" : "+v"(tid_)); const int tid = tid_, wid = __builtin_amdgcn_readfirstlane(tid >> 6), lane = tid & 63, wr = wid >> 2, wc = wid & 3, fr = lane & 15, fq = lane >> 4;
    const int K = g.K, nt = K / BK;
    unsigned voffA, voffB;
    { int R, C; stage_rc(tid * 16, R, C); const int Rb = Epi::PERM ? ((R & ~31) + perm32(R & 31)) : R;
        voffA = (unsigned)(R * K + C) * 2u; voffB = (unsigned)(Rb * K + C) * 2u; }
    const size_t rstep = (size_t)64 * K * 2;
    const size_t kstep = (size_t)(BK * 2);
    const size_t hstep = (size_t)HALF * K * 2;
    const size_t tstep = 2 * hstep;
    const unsigned ldsw = (unsigned)wid * 1024u;
    const int aoff = lds_byte(wr * 64 + fr, fq * 8), boff = lds_byte(wc * 32 + fr, fq * 8);
#define PG8_SA(b, h) (((b) * 2 + (h)) * HTB)
#define PG8_SB(b, h) ((4 + (b) * 2 + (h)) * HTB)
#define PG8_STAGE(bufoff, gbase, voff) do { _Pragma("unroll") for (int _i = 0; _i < 2; ++_i) \
        __builtin_amdgcn_global_load_lds((const unsigned*)((const char*)(gbase) + _i * rstep + (voff)), (PG8_LAS unsigned*)(lds + (bufoff) + ldsw + _i * 8192), 16, 0, 0); } while (0)
#define PG8_LDA(dst, b, h) do { _Pragma("unroll") for (int m = 0; m < 4; ++m) _Pragma("unroll") for (int k = 0; k < 2; ++k) dst[m][k] = *(const PG8_LAS bf16x8*)(lds + PG8_SA(b, h) + aoff + m * 2048 + k * 1024); } while (0)
#define PG8_LDB(dst, b, h) do { _Pragma("unroll") for (int n = 0; n < 2; ++n) _Pragma("unroll") for (int k = 0; k < 2; ++k) dst[n][k] = *(const PG8_LAS bf16x8*)(lds + PG8_SB(b, h) + boff + n * 2048 + k * 1024); } while (0)
#define PG8_MMA(ai, bj, At, Bt) do { __builtin_amdgcn_s_setprio(1); _Pragma("unroll") for (int m = 0; m < 4; ++m) _Pragma("unroll") for (int n = 0; n < 2; ++n) { \
        if constexpr (F8) { acc[ai][bj][m][n] = __builtin_amdgcn_mfma_scale_f32_16x16x128_f8f6f4(cat8(Bt[n][0], Bt[n][1]), cat8(At[m][0], At[m][1]), acc[ai][bj][m][n], 0, 0, 0, 0, 0, 0); } \
        else { _Pragma("unroll") for (int k = 0; k < 2; ++k) acc[ai][bj][m][n] = __builtin_amdgcn_mfma_f32_16x16x32_bf16(Bt[n][k], At[m][k], acc[ai][bj][m][n], 0, 0, 0); } } __builtin_amdgcn_s_setprio(0); } while (0)
#define PG8_WAIT_V(n) asm volatile("s_waitcnt vmcnt(" #n ")" ::: "memory")
#define PG8_WAIT_L(n) asm volatile("s_waitcnt lgkmcnt(" #n ")" ::: "memory")
#define PG8_BAR __builtin_amdgcn_s_barrier()
#define PG8_SCHED __builtin_amdgcn_sched_barrier(0)
    Unit cur, nxt; int ui = 0;
    if (!S.next(0, cur)) return;
    f32x4 acc[2][2][4][2];
#pragma unroll
    for (int a = 0; a < 2; ++a)
#pragma unroll
        for (int b = 0; b < 2; ++b)
#pragma unroll
            for (int m = 0; m < 4; ++m)
#pragma unroll
                for (int n = 0; n < 2; ++n) acc[a][b][m][n] = (f32x4){0.f, 0.f, 0.f, 0.f};
    bf16x8 At[4][2], B0[2][2], B1[2][2];
    const char* cA = (const char*)g.A + (size_t)cur.pm * tstep; const char* cB = (const char*)g.Bt + (size_t)cur.pn * tstep;
    S.a_ready(cur);
    if constexpr (SP2) {
        PG8_STAGE(PG8_SB(0, 0), cB, voffB); PG8_STAGE(PG8_SB(0, 1), cB + hstep, voffB); PG8_STAGE(PG8_SA(0, 0), cA, voffA); PG8_STAGE(PG8_SA(0, 1), cA + hstep, voffA);
        if (wr == 1) PG8_BAR;
        PG8_WAIT_V(2); PG8_BAR;
        PG8_STAGE(PG8_SB(1, 0), cB + kstep, voffB); PG8_STAGE(PG8_SA(1, 0), cA + kstep, voffA); PG8_STAGE(PG8_SB(1, 1), cB + hstep + kstep, voffB);
        PG8_WAIT_V(6); PG8_BAR;
    } else {
        PG8_STAGE(PG8_SB(0, 0), cB, voffB); PG8_STAGE(PG8_SA(0, 0), cA, voffA); PG8_STAGE(PG8_SB(0, 1), cB + hstep, voffB); PG8_STAGE(PG8_SA(0, 1), cA + hstep, voffA);
        if (wr == 1) PG8_BAR;
        PG8_WAIT_V(4); PG8_BAR;
        PG8_STAGE(PG8_SB(1, 0), cB + kstep, voffB); PG8_STAGE(PG8_SA(1, 0), cA + kstep, voffA); PG8_STAGE(PG8_SB(1, 1), cB + hstep + kstep, voffB);
        PG8_WAIT_V(6); PG8_BAR;
    }
    for (;;) {
        const bool has_next = S.next(ui + 1, nxt);
        const char* nA = has_next ? (const char*)g.A + (size_t)nxt.pm * tstep : cA; const char* nB = has_next ? (const char*)g.Bt + (size_t)nxt.pn * tstep : cB;
#pragma unroll 1
        for (int t = 0; t < nt; t += 2) {
            const bool last = (t == nt - 2);
            const char* a1 = cA + (size_t)(t + 1) * kstep;
            const char* a2 = last ? nA : cA + (size_t)(t + 2) * kstep; const char* b2 = last ? nB : cB + (size_t)(t + 2) * kstep;
            const char* a3 = a2 + kstep; const char* b3 = b2 + kstep;
            if (last && has_next) S.a_ready(nxt);
            if constexpr (SP2) {
            PG8_LDB(B0, 0, 0); PG8_LDB(B1, 0, 1); PG8_SCHED; PG8_LDA(At, 0, 0); PG8_STAGE(PG8_SA(1, 1), a1 + hstep, voffA);
            PG8_WAIT_V(8); PG8_WAIT_L(0); PG8_BAR; PG8_MMA(0, 0, At, B0); PG8_MMA(0, 1, At, B1); PG8_BAR; PG8_SCHED;
            PG8_LDA(At, 0, 1); PG8_STAGE(PG8_SB(0, 0), b2, voffB); PG8_STAGE(PG8_SB(0, 1), b2 + hstep, voffB); PG8_STAGE(PG8_SA(0, 0), a2, voffA);
            PG8_WAIT_V(8); PG8_WAIT_L(0); PG8_BAR; PG8_MMA(1, 0, At, B0); PG8_MMA(1, 1, At, B1); PG8_BAR; PG8_SCHED;
            PG8_LDB(B0, 1, 0); PG8_LDB(B1, 1, 1); PG8_SCHED; PG8_LDA(At, 1, 0); PG8_STAGE(PG8_SA(0, 1), a2 + hstep, voffA);
            PG8_WAIT_V(8); PG8_WAIT_L(0); PG8_BAR; PG8_MMA(0, 0, At, B0); PG8_MMA(0, 1, At, B1); PG8_BAR; PG8_SCHED;
            PG8_LDA(At, 1, 1); PG8_STAGE(PG8_SB(1, 0), b3, voffB); PG8_STAGE(PG8_SB(1, 1), b3 + hstep, voffB); PG8_STAGE(PG8_SA(1, 0), a3, voffA);
            PG8_WAIT_V(8); PG8_WAIT_L(0); PG8_BAR; PG8_MMA(1, 0, At, B0); PG8_MMA(1, 1, At, B1); PG8_BAR; PG8_SCHED;
            } else {
            PG8_LDB(B0, 0, 0); PG8_SCHED; PG8_LDA(At, 0, 0); PG8_STAGE(PG8_SA(1, 1), a1 + hstep, voffA);
            PG8_WAIT_L(8); PG8_BAR; PG8_WAIT_L(0); PG8_MMA(0, 0, At, B0); PG8_BAR; PG8_SCHED;
            PG8_LDB(B1, 0, 1); PG8_STAGE(PG8_SB(0, 0), b2, voffB);
            PG8_BAR; PG8_WAIT_L(0); PG8_MMA(0, 1, At, B1); PG8_BAR;
            PG8_LDA(At, 0, 1); PG8_STAGE(PG8_SA(0, 0), a2, voffA);
            PG8_BAR; PG8_WAIT_L(0); PG8_MMA(1, 0, At, B0); PG8_BAR; PG8_SCHED;
            PG8_STAGE(PG8_SB(0, 1), b2 + hstep, voffB);
            PG8_WAIT_V(6); PG8_BAR; PG8_MMA(1, 1, At, B1); PG8_BAR;
            PG8_LDB(B0, 1, 0); PG8_SCHED; PG8_LDA(At, 1, 0); PG8_STAGE(PG8_SA(0, 1), a2 + hstep, voffA);
            PG8_WAIT_L(8); PG8_BAR; PG8_WAIT_L(0); PG8_MMA(0, 0, At, B0); PG8_BAR; PG8_SCHED;
            PG8_LDB(B1, 1, 1); PG8_STAGE(PG8_SB(1, 0), b3, voffB);
            PG8_BAR; PG8_WAIT_L(0); PG8_MMA(0, 1, At, B1); PG8_BAR;
            PG8_LDA(At, 1, 1); PG8_STAGE(PG8_SA(1, 0), a3, voffA);
            PG8_BAR; PG8_WAIT_L(0); PG8_MMA(1, 0, At, B0); PG8_BAR; PG8_SCHED;
            PG8_STAGE(PG8_SB(1, 1), b3 + hstep, voffB);
            PG8_WAIT_V(6); PG8_BAR; PG8_MMA(1, 1, At, B1); PG8_BAR;
            }
        }
        if constexpr (ALIGN_EPI) { if (wr == 0) PG8_BAR; }
        if constexpr (!Epi::AFTER_DRAIN) { int t2_ = threadIdx.x; asm volatile("" : "+v"(t2_)); E(acc, cur, wr, wc, t2_ & 15, (t2_ & 63) >> 4); S.done(cur); }
        if (!has_next) break;
#pragma unroll
        for (int a = 0; a < 2; ++a)
#pragma unroll
            for (int b = 0; b < 2; ++b)
#pragma unroll
                for (int m = 0; m < 4; ++m)
#pragma unroll
                    for (int n = 0; n < 2; ++n) acc[a][b][m][n] = (f32x4){0.f, 0.f, 0.f, 0.f};
        cur = nxt; cA = nA; cB = nB; ++ui;
        if constexpr (ALIGN_EPI) { if (wr == 1) PG8_BAR; }
    }
    PG8_WAIT_V(0);
    if constexpr (!ALIGN_EPI) { if (wr == 0) PG8_BAR; }
    PG8_BAR;
    if constexpr (Epi::AFTER_DRAIN) { E.fused(acc, cur, wr, wc, fr, fq, lds, wid, lane); S.done(cur); }
#undef PG8_SA
#undef PG8_SB
#undef PG8_STAGE
#undef PG8_LDA
#undef PG8_LDB
#undef PG8_MMA
#undef PG8_WAIT_V
#undef PG8_WAIT_L
#undef PG8_BAR
#undef PG8_SCHED
}
}

#define DI __device__ __forceinline__
#define LAS __attribute__((address_space(3)))
typedef unsigned short bf16;
typedef short bf16x8 __attribute__((ext_vector_type(8)));
typedef short s16x4 __attribute__((ext_vector_type(4)));
typedef float f32x4 __attribute__((ext_vector_type(4)));
typedef float f32x2 __attribute__((ext_vector_type(2)));
typedef float f32x16 __attribute__((ext_vector_type(16)));
typedef unsigned u32x4 __attribute__((ext_vector_type(4)));
typedef unsigned u32x2 __attribute__((ext_vector_type(2)));
typedef __bf16 bf16x2_t __attribute__((ext_vector_type(2)));
typedef _Float16 f16x4 __attribute__((ext_vector_type(4)));
typedef _Float16 f16x8 __attribute__((ext_vector_type(8)));
typedef LAS unsigned char lds_u8;

constexpr int NWAVES = 8, NTHREADS = 512;
constexpr int BATCH = 8, SEQ = 4096, D = 1024, DEPTH = 4, M = BATCH * SEQ;
constexpr int HD = 64, FF = 2816, INW = 2816, GUW = 2 * FF;
constexpr float ALPHA = 1.681792830507429f;
constexpr float LN_EPS = 1e-5f, GN_EPS = 1e-6f;
constexpr float LOG2E = 1.4426950408889634f;
constexpr float QSCALE = 0.125f * LOG2E;

constexpr size_t MiB = 1u << 20;
constexpr size_t WS_STAT0 = 3 * MiB + 256 * 1024, WS_ONES = 3 * MiB + 512 * 1024;
constexpr size_t WS_STAT = 3 * MiB;
constexpr size_t WS_TAB = 1 * MiB;
constexpr size_t WS_WGU1 = 4 * MiB, WS_WD1 = 16 * MiB, WS_WGU2 = 22 * MiB, WS_WD2 = 34 * MiB, WS_WIN = 40 * MiB, WS_WOUT = 46 * MiB;
constexpr size_t WS_XB = 48 * MiB;
constexpr size_t WS_HB = 112 * MiB;
constexpr size_t WS_YM = 288 * MiB;
constexpr size_t WS_Y = 352 * MiB;
constexpr size_t WS_END = 416 * MiB;
constexpr int LDS_BYTES = 147456;

DI unsigned cvtpk(float lo, float hi) { f32x2 v = {lo, hi}; bf16x2_t b = __builtin_convertvector(v, bf16x2_t); return __builtin_bit_cast(unsigned, b); }
DI float bf2f(unsigned short b) { return __uint_as_float((unsigned)b << 16); }
DI float fast_exp2(float x) { return __builtin_amdgcn_exp2f(x); }
DI float fast_rcp(float x) { return __builtin_amdgcn_rcpf(x); }
DI unsigned pk4_fp8(float a, float b, float c, float d) {
    a = fminf(fmaxf(a, -448.f), 448.f); b = fminf(fmaxf(b, -448.f), 448.f); c = fminf(fmaxf(c, -448.f), 448.f); d = fminf(fmaxf(d, -448.f), 448.f);
    int v = __builtin_amdgcn_cvt_pk_fp8_f32(a, b, 0, false); v = __builtin_amdgcn_cvt_pk_fp8_f32(c, d, v, true); return (unsigned)v;
}
constexpr float WGU_SCALE = 64.f, WD_SCALE = 128.f, H_SCALE = 8.f;
DI float q8(float v) {
    const float a = fabsf(v);
    if (a >= 448.f) return copysignf(448.f, v);
    if (a < 0.015625f) return rintf(v * 512.f) * (1.f / 512.f);
    unsigned u = __float_as_uint(v); u += 0x7FFFFu + ((u >> 20) & 1u); u &= 0xFFF00000u; return __uint_as_float(u);
}
#ifdef EMU_FP8
#define Q8S(v, s) (q8((v) * (s)) * (1.0f / (s)))
#else
#define Q8S(v, s) (v)
#endif
DI float silu_f(float a) { return a * fast_rcp(1.0f + fast_exp2(-a * LOG2E)); }
DI float shx(float v, int mask, int lane) { return __builtin_bit_cast(float, __builtin_amdgcn_ds_bpermute(((lane ^ mask) & 63) << 2, __builtin_bit_cast(int, v))); }
DI float wave_sum(float v, int lane) {
#pragma unroll
    for (int o = 1; o < 64; o <<= 1) v += shx(v, o, lane);
    return v;
}
DI int opaque_tid() { int t = threadIdx.x; asm volatile("" : "+v"(t)); return t; }
DI int crow(int r, int hi) { return (r & 3) + 8 * (r >> 2) + 4 * hi; }
#define MFMA32(a, b, c) __builtin_amdgcn_mfma_f32_32x32x16_bf16((a), (b), (c), 0, 0, 0)

namespace pg8 {
struct EpiSwiGLU {
    static constexpr bool PERM = true, AFTER_DRAIN = false;
    bf16_t* H;
    __device__ __forceinline__ void operator()(const f32x4 (&acc)[2][2][4][2], const Unit& u, int wr, int wc, int fr, int fq) const {
        const int row0 = u.pm * BM + wr * 64 + fr, col0 = u.pn * 128 + wc * 32 + 8 * fq;
#pragma unroll
        for (int ai = 0; ai < 2; ++ai)
#pragma unroll
            for (int m = 0; m < 4; ++m) {
                bf16_t* rowp = H + (size_t)(row0 + ai * HALF + m * 16) * FF + col0;
                float h[8];
#pragma unroll
                for (int n = 0; n < 2; ++n)
#pragma unroll
                    for (int j = 0; j < 4; ++j) h[n * 4 + j] = Q8S(silu_f(acc[ai][0][m][n][j]) * acc[ai][1][m][n][j], 8.0f);
                u32x4 w; w.x = cvtpk(h[0], h[1]); w.y = cvtpk(h[2], h[3]); w.z = cvtpk(h[4], h[5]); w.w = cvtpk(h[6], h[7]);
                *(u32x4*)rowp = w;
            }
    }
};
struct EpiSwiGLU8 {
    static constexpr bool PERM = true, AFTER_DRAIN = false;
    unsigned char* H;
    __device__ __forceinline__ void operator()(const f32x4 (&acc)[2][2][4][2], const Unit& u, int wr, int wc, int fr, int fq) const {
        const int row0 = u.pm * BM + wr * 64 + fr, col0 = u.pn * 128 + wc * 32 + 8 * fq;
        const float is = 1.0f / WGU_SCALE;
#pragma unroll
        for (int ai = 0; ai < 2; ++ai)
#pragma unroll
            for (int m = 0; m < 4; ++m) {
                unsigned char* rowp = H + (size_t)(row0 + ai * HALF + m * 16) * FF + col0;
                float h[8];
#pragma unroll
                for (int n = 0; n < 2; ++n)
#pragma unroll
                    for (int j = 0; j < 4; ++j) h[n * 4 + j] = silu_f(acc[ai][0][m][n][j] * is) * (acc[ai][1][m][n][j] * (is * H_SCALE));
                u32x2 w; w.x = pk4_fp8(h[0], h[1], h[2], h[3]); w.y = pk4_fp8(h[4], h[5], h[6], h[7]);
                *(u32x2*)rowp = w;
            }
    }
};
struct EpiResid {
    static constexpr bool PERM = true, AFTER_DRAIN = false;
    _Float16* Y; float s; const f32x2* stats; const float* g; const float* b;
    __device__ __forceinline__ void operator()(const f32x4 (&acc)[2][2][4][2], const Unit& u, int wr, int wc, int fr, int fq) const {
        const int col0 = u.pn * BM + wc * 32 + 8 * fq, row0 = u.pm * BM + wr * 64 + fr;
        f32x2 st[2][4];
#pragma unroll
        for (int ai = 0; ai < 2; ++ai)
#pragma unroll
            for (int m = 0; m < 4; ++m) st[ai][m] = stats[row0 + ai * HALF + m * 16];
#pragma unroll
        for (int bj = 0; bj < 2; ++bj) {
            f32x4 ga[2], ab[2];
#pragma unroll
            for (int n = 0; n < 2; ++n) { ga[n] = *(const f32x4*)(g + col0 + bj * HALF + 4 * n) * ALPHA; ab[n] = *(const f32x4*)(b + col0 + bj * HALF + 4 * n) * ALPHA; }
#pragma unroll
            for (int ai = 0; ai < 2; ++ai)
#pragma unroll
                for (int m = 0; m < 4; ++m) {
                    _Float16* p = Y + (size_t)(row0 + ai * HALF + m * 16) * D + col0 + bj * HALF;
                    const f16x8 xh = *(const f16x8*)p;
                    f16x8 oh;
#pragma unroll
                    for (int n = 0; n < 2; ++n) {
                        const f32x4 xv = {(float)xh[4 * n], (float)xh[4 * n + 1], (float)xh[4 * n + 2], (float)xh[4 * n + 3]};
                        const f32x4 y = (xv - st[ai][m].x) * (ga[n] * st[ai][m].y) + (ab[n] + acc[ai][bj][m][n] * s);
                        oh[4 * n] = (_Float16)y[0]; oh[4 * n + 1] = (_Float16)y[1]; oh[4 * n + 2] = (_Float16)y[2]; oh[4 * n + 3] = (_Float16)y[3];
                    }
                    *(f16x8*)p = oh;
                }
        }
    }
};
struct EpiInProj {
    static constexpr bool PERM = true, AFTER_DRAIN = false;
    bf16_t* O; const float* tab;
    __device__ __forceinline__ void operator()(const f32x4 (&acc)[2][2][4][2], const Unit& u, int wr, int wc, int fr, int fq) const {
        const int pn = u.pn;
        int mode;
        float sc = 1.f;
        if (pn < 2) { mode = 1; sc = QSCALE; } else if (pn == 2) { mode = (wc < 2) ? 1 : 0; } else if (pn < 5) { mode = 2; } else if (pn < 7) { mode = 2; sc = 0.125f; } else if (pn < 9) { mode = 0; } else { mode = 3; }
        const int row0 = u.pm * BM + wr * 64 + fr, col0 = pn * 256 + wc * 64 + 8 * fq;
        const float* rc = tab; const float* rs = tab + SEQ * 32; const float* tc = tab + 2 * SEQ * 32; const float* ts = tab + 3 * SEQ * 32;
#pragma unroll
        for (int ai = 0; ai < 2; ++ai)
#pragma unroll
            for (int m = 0; m < 4; ++m) {
                const int row = row0 + ai * HALF + m * 16, pos = row & (SEQ - 1);
                bf16_t* rowp = O + (size_t)row * INW + col0;
                float o[2][8];
                if (mode == 1) {
#pragma unroll
                    for (int n = 0; n < 2; ++n) {
                        const f32x4 c = *(const f32x4*)(rc + pos * 32 + 8 * fq + 4 * n), s = *(const f32x4*)(rs + pos * 32 + 8 * fq + 4 * n);
#pragma unroll
                        for (int j = 0; j < 4; ++j) { const float x1 = acc[ai][0][m][n][j], x2 = acc[ai][1][m][n][j];
                            o[0][n * 4 + j] = (x1 * c[j] - x2 * s[j]) * sc; o[1][n * 4 + j] = (x2 * c[j] + x1 * s[j]) * sc; }
                    }
                } else if (mode == 2) {
#pragma unroll
                    for (int bj = 0; bj < 2; ++bj)
#pragma unroll
                        for (int n = 0; n < 2; ++n) {
                            const f32x2 c = *(const f32x2*)(tc + pos * 32 + bj * 16 + 4 * fq + 2 * n), s = *(const f32x2*)(ts + pos * 32 + bj * 16 + 4 * fq + 2 * n);
#pragma unroll
                            for (int p = 0; p < 2; ++p) { const float xe = acc[ai][bj][m][n][2 * p], xo = acc[ai][bj][m][n][2 * p + 1];
                                o[bj][n * 4 + 2 * p] = (xe * c[p] - xo * s[p]) * sc; o[bj][n * 4 + 2 * p + 1] = (xo * c[p] + xe * s[p]) * sc; }
                        }
                } else {
#pragma unroll
                    for (int bj = 0; bj < 2; ++bj)
#pragma unroll
                        for (int n = 0; n < 2; ++n)
#pragma unroll
                            for (int j = 0; j < 4; ++j) { const float v = acc[ai][bj][m][n][j]; o[bj][n * 4 + j] = (mode == 3) ? silu_f(v) : v; }
                }
#pragma unroll
                for (int bj = 0; bj < 2; ++bj) {
                    u32x4 w; w.x = cvtpk(o[bj][0], o[bj][1]); w.y = cvtpk(o[bj][2], o[bj][3]); w.z = cvtpk(o[bj][4], o[bj][5]); w.w = cvtpk(o[bj][6], o[bj][7]);
                    *(u32x4*)(rowp + bj * 32) = w;
                }
            }
    }
};
}

struct Args {
    const float* x; const float* w_in; const float* w_out; const float* sinks;
    const float* w_gu1; const float* w_d1; const float* w_gu2; const float* w_d2;
    const float* ln_g0; const float* ln_g1; const float* ln_g2; const float* ln_b0; const float* ln_b1; const float* ln_b2;
    float* out; unsigned char* ws; int ph_lo, ph_hi;
};

DI void transpose_item(const float* W, int K, int Nsrc, int srcbase, void* WT, int n0, int k0, LAS float* scr, int lane, float f8s) {
#pragma unroll 8
    for (int i = 0; i < 32; ++i) { const int kk = 2 * i + (lane >> 5); scr[kk * 33 + (lane & 31)] = W[(size_t)(k0 + kk) * Nsrc + srcbase + (lane & 31)]; }
    asm volatile("s_waitcnt lgkmcnt(0)" ::: "memory");
    const int c = lane & 7;
#pragma unroll
    for (int j = 0; j < 4; ++j) { const int n = (lane >> 3) + 8 * j; const LAS float* s = scr + (8 * c) * 33 + n;
        if (f8s == 0.f) {
            u32x4 o; o.x = cvtpk(s[0 * 33], s[1 * 33]); o.y = cvtpk(s[2 * 33], s[3 * 33]); o.z = cvtpk(s[4 * 33], s[5 * 33]); o.w = cvtpk(s[6 * 33], s[7 * 33]);
            *(u32x4*)((bf16*)WT + (size_t)(n0 + n) * K + k0 + 8 * c) = o;
        } else {
            u32x2 o; o.x = pk4_fp8(s[0 * 33] * f8s, s[1 * 33] * f8s, s[2 * 33] * f8s, s[3 * 33] * f8s); o.y = pk4_fp8(s[4 * 33] * f8s, s[5 * 33] * f8s, s[6 * 33] * f8s, s[7 * 33] * f8s);
            *(u32x2*)((unsigned char*)WT + (size_t)(n0 + n) * K + k0 + 8 * c) = o;
        } }
    asm volatile("s_waitcnt lgkmcnt(0)" ::: "memory");
}
DI int src_col(int which, int n0) {
    if (which == 0) { const int pn = n0 >> 8, c = n0 & 255; return (c >> 7) * FF + pn * 128 + (c & 127); }
    if (which == 2) { const int pn = n0 >> 8, c = n0 & 255; return pn * 256 + ((c & 127) >> 5) * 64 + (c >> 7) * 32 + (c & 31); }
    return n0;
}
DI void convert_matrix_items(const float* W, int K, int N, int which, void* WT, LAS float* scr, int lane, int first, int gw, int NGW) {
    const int nblk = N / 32, nitems = (K / 64) * nblk;
    int it = gw - (first % NGW); if (it < 0) it += NGW;
    for (; it < nitems; it += NGW) { const int kb = it / nblk, nb = it % nblk; transpose_item(W, K, N, src_col(which, nb * 32), WT, nb * 32, kb * 64, scr, lane, which == 0 ? WGU_SCALE : (which == 3 ? WD_SCALE : 0.f)); }
}
typedef const Args __attribute__((address_space(4))) CArgs;
DI void convert_layer_weights(const CArgs& a, int l, unsigned char* ws, LAS unsigned char* lds, int wave, int lane, int gw, int NGW) {
    LAS float* scr = (LAS float*)(lds + wave * 16384);
    constexpr int I_GU = (D / 64) * (GUW / 32), I_D = (FF / 64) * (D / 32), I_IN = (D / 64) * (INW / 32), I_OUT = (D / 64) * (D / 32);
    int first = 0;
    convert_matrix_items(a.w_gu1 + (size_t)l * D * GUW, D, GUW, 0, (bf16*)(ws + WS_WGU1), scr, lane, first, gw, NGW); first += I_GU;
    convert_matrix_items(a.w_d1 + (size_t)l * FF * D, FF, D, 3, (bf16*)(ws + WS_WD1), scr, lane, first, gw, NGW); first += I_D;
    convert_matrix_items(a.w_in + (size_t)l * D * INW, D, INW, 2, (bf16*)(ws + WS_WIN), scr, lane, first, gw, NGW); first += I_IN;
    convert_matrix_items(a.w_out + (size_t)l * D * D, D, D, 1, (bf16*)(ws + WS_WOUT), scr, lane, first, gw, NGW); first += I_OUT;
    convert_matrix_items(a.w_gu2 + (size_t)l * D * GUW, D, GUW, 0, (bf16*)(ws + WS_WGU2), scr, lane, first, gw, NGW); first += I_GU;
    convert_matrix_items(a.w_d2 + (size_t)l * FF * D, FF, D, 3, (bf16*)(ws + WS_WD2), scr, lane, first, gw, NGW);
}
DI void sincos_d(double x, float& c, float& s) {
    const double TWO_PI = 6.283185307179586476925;
    const double k = __builtin_rint(x / TWO_PI), r = x - k * TWO_PI, r2 = r * r;
    double sn = r, cs = 1.0, tsn = r, tcs = 1.0;
#pragma unroll 1
    for (int i = 1; i <= 15; ++i) { tcs *= -r2 / (double)((2 * i - 1) * (2 * i)); cs += tcs; tsn *= -r2 / (double)((2 * i) * (2 * i + 1)); sn += tsn; }
    c = (float)cs; s = (float)sn;
}
DI void build_tables(float* tab, int gtid, int nthreads) {
    for (int e = gtid; e < 2 * SEQ * 32; e += nthreads) {
        const int which = e / (SEQ * 32), r = e % (SEQ * 32), pos = r >> 5, i = r & 31;
        const double base = which == 0 ? 0.7498942093324558 : 0.7429639507594947;
        double f = 1.0;
#pragma unroll 1
        for (int k = 0; k < i; ++k) f *= base;
        float c, s; sincos_d((double)pos * f, c, s);
        tab[(size_t)(2 * which) * SEQ * 32 + r] = c; tab[(size_t)(2 * which + 1) * SEQ * 32 + r] = s;
    }
}
DI void row_to_fp8_f16(const float* xrow, unsigned char* orow, _Float16* hrow, int lane) {
    const f32x4* xr = (const f32x4*)xrow + lane; unsigned* o4 = (unsigned*)orow + lane; f16x4* h4 = (f16x4*)hrow + lane;
#pragma unroll
    for (int j = 0; j < 4; ++j) { const f32x4 v = xr[64 * j]; o4[64 * j] = pk4_fp8(v[0], v[1], v[2], v[3]); h4[64 * j] = (f16x4){(_Float16)v[0], (_Float16)v[1], (_Float16)v[2], (_Float16)v[3]}; }
}
template <int NR> DI void ln_rows(const _Float16* Y, float* Xo, void* XBv, f32x2* stat, const float* g, const float* b, int lane, bool quant, bool write_x, int m0, int mstep) {
    f32x4 v[NR][4]; float s[NR], s2[NR];
    {   f16x8 h[NR][2];
#pragma unroll
        for (int r = 0; r < NR; ++r) { const f16x8* yr = (const f16x8*)(Y + (size_t)(m0 + r * mstep) * D) + lane; h[r][0] = yr[0]; h[r][1] = yr[64]; }
#pragma unroll
        for (int r = 0; r < NR; ++r)
#pragma unroll
            for (int c = 0; c < 2; ++c)
#pragma unroll
                for (int q = 0; q < 2; ++q) v[r][2 * c + q] = (f32x4){(float)h[r][c][4 * q], (float)h[r][c][4 * q + 1], (float)h[r][c][4 * q + 2], (float)h[r][c][4 * q + 3]};
    }
#pragma unroll
    for (int r = 0; r < NR; ++r) { s[r] = 0.f;
#pragma unroll
        for (int j = 0; j < 4; ++j) s[r] += (v[r][j][0] + v[r][j][1]) + (v[r][j][2] + v[r][j][3]); }
#pragma unroll
    for (int o = 1; o < 64; o <<= 1)
#pragma unroll
        for (int r = 0; r < NR; ++r) s[r] += shx(s[r], o, lane);
#pragma unroll
    for (int r = 0; r < NR; ++r) { const float mean = s[r] * (1.f / D); s[r] = mean; s2[r] = 0.f;
#pragma unroll
        for (int j = 0; j < 4; ++j) { v[r][j] = v[r][j] - mean; s2[r] += (v[r][j][0] * v[r][j][0] + v[r][j][1] * v[r][j][1]) + (v[r][j][2] * v[r][j][2] + v[r][j][3] * v[r][j][3]); } }
#pragma unroll
    for (int o = 1; o < 64; o <<= 1)
#pragma unroll
        for (int r = 0; r < NR; ++r) s2[r] += shx(s2[r], o, lane);
#pragma unroll
    for (int c = 0; c < 2; ++c) {
        const int e0 = c * 512 + 8 * lane;
        const f32x4 g0 = *(const f32x4*)(g + e0), g1 = *(const f32x4*)(g + e0 + 4), b0 = *(const f32x4*)(b + e0), b1 = *(const f32x4*)(b + e0 + 4);
#pragma unroll
        for (int r = 0; r < NR; ++r) {
            const int m = m0 + r * mstep;
            const float rstd = 1.f / sqrtf(s2[r] * (1.f / D) + LN_EPS);
            if (c == 0 && lane == 0) stat[m] = (f32x2){s[r], rstd};
            const f32x4 o0 = v[r][2 * c] * rstd * g0 + b0, o1 = v[r][2 * c + 1] * rstd * g1 + b1;
            if (write_x) { float* xo = Xo + (size_t)m * D + e0; *(f32x4*)xo = o0; *(f32x4*)(xo + 4) = o1; }
            if (quant) { u32x2 w; w.x = pk4_fp8(o0[0], o0[1], o0[2], o0[3]); w.y = pk4_fp8(o1[0], o1[1], o1[2], o1[3]); *(u32x2*)((unsigned char*)XBv + (size_t)m * D + e0) = w; }
            else { u32x4 w; w.x = cvtpk(o0[0], o0[1]); w.y = cvtpk(o0[2], o0[3]); w.z = cvtpk(o1[0], o1[1]); w.w = cvtpk(o1[2], o1[3]); *(u32x4*)((bf16*)XBv + (size_t)m * D + e0) = w; }
        }
    }
}

constexpr int A_KS = 0, A_KSTR = 72 * 2;
constexpr int A_VT = 256 * A_KSTR, A_VSTR = 264 * 2;
constexpr int A_STG = A_VT + 64 * A_VSTR, STG_STR = 72 * 2, STG_BYTES = 32 * STG_STR;
static_assert(A_STG + 8 * STG_BYTES <= 131072, "attention LDS");

DI void stage_out_store(lds_u8* stg, const f32x16 (&o)[2], int r32, int hi) {
#pragma unroll
    for (int db = 0; db < 2; ++db)
#pragma unroll
        for (int rg = 0; rg < 4; ++rg) {
            u32x2 w; w.x = cvtpk(o[db][4 * rg], o[db][4 * rg + 1]); w.y = cvtpk(o[db][4 * rg + 2], o[db][4 * rg + 3]);
            *(LAS u32x2*)(stg + r32 * STG_STR + (db * 32 + 8 * rg + 4 * hi) * 2) = w;
        }
}

DI void attn_unit(lds_u8* lds, const bf16* HM, bf16* YM, const float* sinks, int b, int g, int n) {
    const int tid = opaque_tid(), lane = tid & 63, r32 = lane & 31, hi = lane >> 5, wid = __builtin_amdgcn_readfirstlane(tid >> 6);
    const long keyrow0 = (long)b * SEQ + n * 128 - 128;
    {
        const int token = tid & 255; const bool valid = (n > 0) || (token >= 128);
        const bf16* src = HM + (keyrow0 + token) * INW + 512 + g * 64;
#pragma unroll
        for (int i = 0; i < 4; ++i) {
            const int dc = (tid >> 8) + 2 * i;
            u32x4 kv = {0u, 0u, 0u, 0u}, vv = {0u, 0u, 0u, 0u};
            if (valid) { kv = *(const u32x4*)(src + dc * 8); vv = *(const u32x4*)(src + 128 + dc * 8); }
            *(LAS u32x4*)(lds + A_KS + token * A_KSTR + dc * 16) = kv;
            const bf16x8 v8 = __builtin_bit_cast(bf16x8, vv);
#pragma unroll
            for (int ii = 0; ii < 8; ++ii) *(LAS short*)(lds + A_VT + (dc * 8 + ii) * A_VSTR + token * 2) = v8[ii];
        }
    }
    __syncthreads();
    const int hq = g * 4 + (wid >> 1);
    const float sink2 = sinks[hq] * LOG2E;
    lds_u8* stg = lds + A_STG + wid * STG_BYTES;
    const int jmin = (n == 0) ? 128 : 0;
#pragma unroll 1
    for (int qb = 0; qb < 2; ++qb) {
        const int i0 = (wid & 1) * 64 + qb * 32, iq = i0 + r32;
        const long qrow = (long)b * SEQ + n * 128 + iq;
        bf16x8 qf[4];
#pragma unroll
        for (int ks = 0; ks < 4; ++ks) qf[ks] = *(const bf16x8*)(HM + qrow * INW + hq * 64 + ks * 16 + hi * 8);
        float mrun = sink2, lrun = (hi == 0) ? 1.f : 0.f;
        f32x16 o[2];
#pragma unroll
        for (int r = 0; r < 16; ++r) { o[0][r] = 0.f; o[1][r] = 0.f; }
#pragma unroll 1
        for (int t = 0; t < 5; ++t) {
            const int kb = i0 + 32 * t;
            f32x16 s;
#pragma unroll
            for (int r = 0; r < 16; ++r) s[r] = 0.f;
#pragma unroll
            for (int ks = 0; ks < 4; ++ks) {
                const bf16x8 kf = *(const LAS bf16x8*)(lds + A_KS + (kb + r32) * A_KSTR + (ks * 16 + hi * 8) * 2);
                s = MFMA32(kf, qf[ks], s);
            }
            float tmax = -INFINITY;
#pragma unroll
            for (int r = 0; r < 16; ++r) { const int jj = kb + crow(r, hi); const bool vis = (jj > iq) && (jj <= iq + 128) && (jj >= jmin); s[r] = vis ? s[r] : -INFINITY; tmax = fmaxf(tmax, s[r]); }
            tmax = fmaxf(tmax, shx(tmax, 32, lane));
            const float mnew = fmaxf(mrun, tmax), scl = fast_exp2(mrun - mnew);
            mrun = mnew;
            float psum = 0.f;
#pragma unroll
            for (int r = 0; r < 16; ++r) { s[r] = fast_exp2(s[r] - mnew); psum += s[r]; }
            lrun = lrun * scl + psum;
#pragma unroll
            for (int r = 0; r < 16; ++r) { o[0][r] *= scl; o[1][r] *= scl; }
#pragma unroll
            for (int gk = 0; gk < 2; ++gk) {
                u32x4 pw; pw.x = cvtpk(s[8 * gk], s[8 * gk + 1]); pw.y = cvtpk(s[8 * gk + 2], s[8 * gk + 3]); pw.z = cvtpk(s[8 * gk + 4], s[8 * gk + 5]); pw.w = cvtpk(s[8 * gk + 6], s[8 * gk + 7]);
                const bf16x8 pf = __builtin_bit_cast(bf16x8, pw);
#pragma unroll
                for (int db = 0; db < 2; ++db) {
                    const lds_u8* vp = lds + A_VT + (db * 32 + r32) * A_VSTR + (kb + 16 * gk + 4 * hi) * 2;
                    const s16x4 lo = *(const LAS s16x4*)vp, hi4 = *(const LAS s16x4*)(vp + 16);
                    const bf16x8 vf = __builtin_shufflevector(lo, hi4, 0, 1, 2, 3, 4, 5, 6, 7);
                    o[db] = MFMA32(vf, pf, o[db]);
                }
            }
        }
        const float ltot = lrun + shx(lrun, 32, lane), inv = 1.0f / ltot;
#pragma unroll
        for (int r = 0; r < 16; ++r) { o[0][r] *= inv; o[1][r] *= inv; }
        stage_out_store(stg, o, r32, hi);
        asm volatile("s_waitcnt lgkmcnt(0)" ::: "memory");
        bf16* yw = YM + ((long)b * SEQ + n * 128 + i0) * D + hq * 64;
#pragma unroll
        for (int it = 0; it < 4; ++it) { const int row = it * 8 + (lane >> 3), ch = lane & 7;
            const u32x4 v = *(const LAS u32x4*)(stg + row * STG_STR + ch * 16); *(u32x4*)(yw + (long)row * D + ch * 8) = v; }
        asm volatile("s_waitcnt lgkmcnt(0)" ::: "memory");
    }
    __syncthreads();
}

constexpr int R_QS = 0, R_KS = 128 * 144, R_VT = 2 * 128 * 144, R_TSTR = 136 * 2, R_KT = R_VT + 64 * R_TSTR, R_ST = R_KT + 64 * R_TSTR, R_STG = R_ST + 64 * 144;
static_assert(R_STG + 4 * STG_BYTES <= 131072, "retention LDS");

DI void ret_unit(lds_u8* lds, const bf16* HM, bf16* YM, int b, int h, int seg) {
    const int tid = opaque_tid(), lane = tid & 63, r32 = lane & 31, hi = lane >> 5, wid = __builtin_amdgcn_readfirstlane(tid >> 6);
    float lg2;
    { int hh_ = h; asm volatile("" : "+s"(hh_)); const double x = __builtin_ldexp(1.0, -5 - hh_); double t = x, s = 0.0;
#pragma unroll 1
      for (int k = 1; k <= 10; ++k) { s -= t / (double)k; t *= x; }
      lg2 = (float)(s * 1.4426950408889634); }
    const float gchunk = fast_exp2(128.f * lg2);
    const int token = tid & 127, dc0 = tid >> 7;
    const float wk = fast_exp2((float)(127 - token) * lg2);
    const long row0 = (long)b * SEQ;
    const int nfull0 = 8 * seg, nend = nfull0 + 8;
    for (int i = tid; i < 64 * 144 / 4; i += NTHREADS) *(LAS unsigned*)(lds + R_ST + i * 4) = 0u;
    f32x16 st;
#pragma unroll
    for (int r = 0; r < 16; ++r) st[r] = 0.f;
    u32x4 pq[2], pk[2], pv[2];
#pragma unroll
    for (int i = 0; i < 2; ++i) pq[i] = (u32x4){0u, 0u, 0u, 0u};
    { const bf16* src = HM + (row0 + token) * INW + h * 64;
#pragma unroll
      for (int i = 0; i < 2; ++i) { const int dc = dc0 + 4 * i; if (nfull0 == 0) pq[i] = *(const u32x4*)(src + 768 + dc * 8); pk[i] = *(const u32x4*)(src + 1280 + dc * 8); pv[i] = *(const u32x4*)(src + 1792 + dc * 8); } }
#pragma unroll 1
    for (int n = 0; n < nend; ++n) {
        const bool full = (n >= nfull0);
#pragma unroll
        for (int i = 0; i < 2; ++i) {
            const int dc = dc0 + 4 * i;
            if (full) { *(LAS u32x4*)(lds + R_QS + token * 144 + dc * 16) = pq[i]; *(LAS u32x4*)(lds + R_KS + token * 144 + dc * 16) = pk[i]; }
            const bf16x8 k8 = __builtin_bit_cast(bf16x8, pk[i]), v8 = __builtin_bit_cast(bf16x8, pv[i]);
#pragma unroll
            for (int ii = 0; ii < 8; ii += 2) {
                const unsigned kk = cvtpk(bf2f((unsigned short)k8[ii]) * wk, bf2f((unsigned short)k8[ii + 1]) * wk);
                *(LAS short*)(lds + R_KT + (dc * 8 + ii) * R_TSTR + token * 2) = (short)(kk & 0xffffu);
                *(LAS short*)(lds + R_KT + (dc * 8 + ii + 1) * R_TSTR + token * 2) = (short)(kk >> 16);
                *(LAS short*)(lds + R_VT + (dc * 8 + ii) * R_TSTR + token * 2) = v8[ii];
                *(LAS short*)(lds + R_VT + (dc * 8 + ii + 1) * R_TSTR + token * 2) = v8[ii + 1];
            }
        }
        __syncthreads();
        if (n + 1 < nend) { const bf16* src = HM + (row0 + (n + 1) * 128 + token) * INW + h * 64; const bool nq = (n + 1 >= nfull0);
#pragma unroll
            for (int i = 0; i < 2; ++i) { const int dc = dc0 + 4 * i; if (nq) pq[i] = *(const u32x4*)(src + 768 + dc * 8); pk[i] = *(const u32x4*)(src + 1280 + dc * 8); pv[i] = *(const u32x4*)(src + 1792 + dc * 8); } }
        if (wid < 4) {
          if (full) {
            const int ib = wid, iq = 32 * ib + r32;
            const long trow = row0 + n * 128 + 32 * ib;
            u32x4 gv[4];
#pragma unroll
            for (int it = 0; it < 4; ++it) gv[it] = *(const u32x4*)(HM + (trow + it * 8 + (lane >> 3)) * INW + 2304 + h * 64 + (lane & 7) * 8);
            bf16x8 qf[4];
#pragma unroll
            for (int ks = 0; ks < 4; ++ks) qf[ks] = *(const LAS bf16x8*)(lds + R_QS + iq * 144 + (ks * 16 + hi * 8) * 2);
            f32x16 o[2];
#pragma unroll
            for (int r = 0; r < 16; ++r) { o[0][r] = 0.f; o[1][r] = 0.f; }
#pragma unroll
            for (int eb = 0; eb < 2; ++eb)
#pragma unroll
                for (int ks = 0; ks < 4; ++ks) {
                    const bf16x8 sf = *(const LAS bf16x8*)(lds + R_ST + (eb * 32 + r32) * 144 + (ks * 16 + hi * 8) * 2);
                    o[eb] = MFMA32(sf, qf[ks], o[eb]);
                }
            const float wq = fast_exp2((float)(iq + 1) * lg2);
#pragma unroll
            for (int r = 0; r < 16; ++r) { o[0][r] *= wq; o[1][r] *= wq; }
#pragma unroll 1
            for (int jb = 0; jb <= ib; ++jb) {
                f32x16 s;
#pragma unroll
                for (int r = 0; r < 16; ++r) s[r] = 0.f;
#pragma unroll
                for (int ks = 0; ks < 4; ++ks) {
                    const bf16x8 kf = *(const LAS bf16x8*)(lds + R_KS + (jb * 32 + r32) * 144 + (ks * 16 + hi * 8) * 2);
                    s = MFMA32(kf, qf[ks], s);
                }
#pragma unroll
                for (int r = 0; r < 16; ++r) { const int dj = iq - (jb * 32 + crow(r, hi)); s[r] = (dj >= 0) ? s[r] * fast_exp2((float)dj * lg2) : 0.f; }
#pragma unroll
                for (int gk = 0; gk < 2; ++gk) {
                    u32x4 pw; pw.x = cvtpk(s[8 * gk], s[8 * gk + 1]); pw.y = cvtpk(s[8 * gk + 2], s[8 * gk + 3]); pw.z = cvtpk(s[8 * gk + 4], s[8 * gk + 5]); pw.w = cvtpk(s[8 * gk + 6], s[8 * gk + 7]);
                    const bf16x8 pf = __builtin_bit_cast(bf16x8, pw);
#pragma unroll
                    for (int eb = 0; eb < 2; ++eb) {
                        const lds_u8* vp = lds + R_VT + (eb * 32 + r32) * R_TSTR + (jb * 32 + 16 * gk + 4 * hi) * 2;
                        const s16x4 lo = *(const LAS s16x4*)vp, hi4 = *(const LAS s16x4*)(vp + 16);
                        const bf16x8 vf = __builtin_shufflevector(lo, hi4, 0, 1, 2, 3, 4, 5, 6, 7);
                        o[eb] = MFMA32(vf, pf, o[eb]);
                    }
                }
            }
            float sm = 0.f;
#pragma unroll
            for (int r = 0; r < 16; ++r) sm += o[0][r] + o[1][r];
            sm += shx(sm, 32, lane);
            const float mu = sm * (1.f / 64.f);
            float sq = 0.f;
#pragma unroll
            for (int r = 0; r < 16; ++r) { o[0][r] -= mu; o[1][r] -= mu; sq += o[0][r] * o[0][r] + o[1][r] * o[1][r]; }
            sq += shx(sq, 32, lane);
            const float rstd = 1.f / sqrtf(sq * (1.f / 64.f) + GN_EPS);
#pragma unroll
            for (int r = 0; r < 16; ++r) { o[0][r] *= rstd; o[1][r] *= rstd; }
            lds_u8* stg = lds + R_STG + wid * STG_BYTES;
            stage_out_store(stg, o, r32, hi);
            asm volatile("s_waitcnt lgkmcnt(0)" ::: "memory");
#pragma unroll
            for (int it = 0; it < 4; ++it) { const int row = it * 8 + (lane >> 3), ch = lane & 7;
                const u32x4 ov = *(const LAS u32x4*)(stg + row * STG_STR + ch * 16);
                const bf16x8 o8 = __builtin_bit_cast(bf16x8, ov), g8 = __builtin_bit_cast(bf16x8, gv[it]);
                u32x4 w;
                w.x = cvtpk(bf2f((unsigned short)o8[0]) * bf2f((unsigned short)g8[0]), bf2f((unsigned short)o8[1]) * bf2f((unsigned short)g8[1]));
                w.y = cvtpk(bf2f((unsigned short)o8[2]) * bf2f((unsigned short)g8[2]), bf2f((unsigned short)o8[3]) * bf2f((unsigned short)g8[3]));
                w.z = cvtpk(bf2f((unsigned short)o8[4]) * bf2f((unsigned short)g8[4]), bf2f((unsigned short)o8[5]) * bf2f((unsigned short)g8[5]));
                w.w = cvtpk(bf2f((unsigned short)o8[6]) * bf2f((unsigned short)g8[6]), bf2f((unsigned short)o8[7]) * bf2f((unsigned short)g8[7]));
                *(u32x4*)(YM + (trow + row) * D + 512 + h * 64 + ch * 8) = w; }
          }
        } else {
            const int eb = (wid - 4) >> 1, dk = (wid - 4) & 1;
#pragma unroll
            for (int r = 0; r < 16; ++r) st[r] *= gchunk;
#pragma unroll
            for (int ks = 0; ks < 8; ++ks) {
                const bf16x8 vf = *(const LAS bf16x8*)(lds + R_VT + (eb * 32 + r32) * R_TSTR + (ks * 16 + hi * 8) * 2);
                const bf16x8 kf = *(const LAS bf16x8*)(lds + R_KT + (dk * 32 + r32) * R_TSTR + (ks * 16 + hi * 8) * 2);
                st = MFMA32(vf, kf, st);
            }
        }
        __syncthreads();
        if (wid >= 4 && n + 1 >= nfull0) {
            const int eb = (wid - 4) >> 1, dk = (wid - 4) & 1;
#pragma unroll
            for (int r = 0; r < 16; ++r) *(LAS short*)(lds + R_ST + (eb * 32 + crow(r, hi)) * 144 + (dk * 32 + r32) * 2) = (short)(cvtpk(st[r], 0.f) & 0xffffu);
        }
    }
    __syncthreads();
}

#define XB_TMO      128
#define XB_XCNT(j)  (256  + 64 * (j))
#define XB_XSUB(j)  (1280 + 64 * (j))
#define XB_XGEN(j)  (2304 + 64 * (j))
#define XB_TOP      3328
#define XB_TOPGEN   3392
#define XCD_BAR_WORDS 3456
#define XB_SPIN_CAP (1u << 18)

__device__ __forceinline__ unsigned xb_ld(unsigned* p)              { return __hip_atomic_load(p, __ATOMIC_RELAXED, __HIP_MEMORY_SCOPE_AGENT); }
__device__ __forceinline__ unsigned xb_add(unsigned* p, unsigned v) { return __hip_atomic_fetch_add(p, v, __ATOMIC_RELAXED, __HIP_MEMORY_SCOPE_AGENT); }
__device__ __forceinline__ unsigned xb_xcc_id() { return (unsigned)__builtin_amdgcn_s_getreg((3 << 11) | 20) & 0xFu; }
#define XB_SPIN(cond, bar) do { unsigned _sp = 0; while (cond) { __builtin_amdgcn_s_sleep(1); \
    if ((++_sp & 255u) == 0u) { if (xb_ld(&(bar)[XB_TMO])) break; if (_sp > XB_SPIN_CAP) { atomicAdd(&(bar)[XB_TMO], 1u); break; } } } } while (0)

struct XcdBarrier {
    unsigned* bar; unsigned x;
    volatile LAS unsigned* st;
};

__device__ __forceinline__ XcdBarrier xcd_barrier_post(unsigned* bar, volatile LAS unsigned* st) {
    XcdBarrier b; b.bar = bar; b.x = xb_xcc_id(); b.st = st;
    if (opaque_tid() == 0) (void)xb_add(&bar[XB_XCNT(b.x)], 1u);
    return b;
}
__device__ __forceinline__ void xcd_barrier_complete(unsigned* bar, unsigned x, unsigned& nloc, unsigned& nx) {
    const unsigned G = gridDim.x * gridDim.y * gridDim.z;
    unsigned sum, cnt, mine, sp = 0u;
    for (;;) {
        sum = 0u; cnt = 0u; mine = 0u;
#pragma unroll
        for (unsigned j = 0; j < 16; ++j) { const unsigned c = xb_ld(&bar[XB_XCNT(j)]); sum += c; cnt += (c > 0u) ? 1u : 0u; mine = (j == x) ? c : mine; }
        if (sum == G) break;
        __builtin_amdgcn_s_sleep(1);
        if ((++sp & 255u) == 0u) { if (xb_ld(&bar[XB_TMO])) break; if (sp > XB_SPIN_CAP) { atomicAdd(&bar[XB_TMO], 1u); break; } }
    }
    nloc = mine > 0u ? mine : 1u; nx = cnt > 0u ? cnt : 1u;
}

__device__ __forceinline__ void xcd_barrier(const XcdBarrier& b) {
    asm volatile("s_waitcnt vmcnt(0)" ::: "memory");
    __syncthreads();
    if (opaque_tid() == 0) {
        unsigned* bar = b.bar;
        __builtin_amdgcn_s_waitcnt(0);
        unsigned nloc = b.st[0], nx = b.st[1];
        if (nloc == 0u) { xcd_barrier_complete(bar, b.x, nloc, nx); b.st[0] = nloc; b.st[1] = nx; }
        const unsigned old = xb_add(&bar[XB_XSUB(b.x)], 1u);
        const unsigned gen = old / nloc;
        if (old + 1u == (gen + 1u) * nloc) {
            __builtin_amdgcn_fence(__ATOMIC_RELEASE, "agent");
            asm volatile("s_waitcnt vmcnt(0)" ::: "memory");
            const unsigned og = xb_add(&bar[XB_TOP], 1u);
            const unsigned tg = og / nx;
            if (og + 1u == (tg + 1u) * nx) xb_add(&bar[XB_TOPGEN], 1u);
            else XB_SPIN(xb_ld(&bar[XB_TOPGEN]) == tg, bar);
            __builtin_amdgcn_fence(__ATOMIC_ACQUIRE, "agent");
            xb_add(&bar[XB_XGEN(b.x)], 1u);
            asm volatile("s_waitcnt vmcnt(0)" ::: "memory");
        } else {
            XB_SPIN(xb_ld(&bar[XB_XGEN(b.x)]) == gen, bar);
            __builtin_amdgcn_fence(__ATOMIC_ACQUIRE, "agent");
            asm volatile("s_waitcnt vmcnt(0)" ::: "memory");
        }
    }
    __syncthreads();
}
#ifdef SKIP_RET
#define RET_UNIT(bb, hh, ss)
#else
#define RET_UNIT(bb, hh, ss) ret_unit(lds, HB, YM, (bb), (hh), (ss))
#endif
#ifdef SKIP_ATT
#define ATT_UNIT(bb, gg, nn)
#else
#define ATT_UNIT(bb, gg, nn) attn_unit(lds, HB, YM, a.sinks + l * 8, (bb), (gg), (nn))
#endif
__global__ void __launch_bounds__(NTHREADS, 2) mk_fwd(Args a_) {
    extern __shared__ __attribute__((aligned(16))) unsigned char lds_raw[];
    {
        volatile LAS unsigned* MISC0 = (volatile LAS unsigned*)((LAS unsigned char*)lds_raw + 131072 + 320);
        if (opaque_tid() < 64) MISC0[opaque_tid()] = 0u;
        __syncthreads();
    }
    bool bar_ready = false;
    const int ph_lo = a_.ph_lo, ph_hi = a_.ph_hi;
#pragma unroll 1
    for (int ph = ph_lo; ph < ph_hi; ++ph) {
        int z_ = 0; asm volatile("" : "+s"(z_));
        const CArgs* ap_ = (const CArgs*)__builtin_amdgcn_kernarg_segment_ptr(); asm volatile("" : "+s"(ap_)); const CArgs& a = *ap_;
        LAS unsigned char* lds = (LAS unsigned char*)lds_raw + z_;
        const int G = gridDim.x + z_, bx = blockIdx.x + z_;
        const int vcu = (G % 8 == 0) ? (bx % 8) * (G / 8) + bx / 8 : bx;
        const int NGW = G * NWAVES;
        unsigned char* ws = a.ws + z_;
        float* tab = (float*)(ws + WS_TAB);
        bf16* XB = (bf16*)(ws + WS_XB); bf16* HB = (bf16*)(ws + WS_HB); bf16* YM = (bf16*)(ws + WS_YM);
        float* X = a.out + z_;
        _Float16* YH = (_Float16*)(ws + WS_Y);
        if (ph == 0) {
            const int tid = opaque_tid(), lane = tid & 63, wave = __builtin_amdgcn_readfirstlane(tid >> 6), gw = vcu * NWAVES + wave;
            if (bx == 0) for (int i = tid; i < XCD_BAR_WORDS; i += NTHREADS) ((unsigned*)ws)[i] = 0u;
            build_tables(tab, vcu * NTHREADS + tid, G * NTHREADS);
            for (int i = vcu * NTHREADS + tid; i < M; i += G * NTHREADS) ((f32x2*)(ws + WS_STAT0))[i] = (f32x2){__int_as_float(z_), __int_as_float(0x3f800000 + z_)};
            for (int i = vcu * NTHREADS + tid; i < 2 * D; i += G * NTHREADS) ((float*)(ws + WS_ONES))[i] = (i < D) ? __int_as_float(0x3f800000 + z_) : __int_as_float(z_);
            convert_layer_weights(a, 0, ws, lds, wave, lane, gw, NGW);
            for (int m = gw; m < M; m += NGW) row_to_fp8_f16(a.x + (size_t)m * D, (unsigned char*)XB + (size_t)m * D, YH + (size_t)m * D, lane);
        } else {
#ifdef PROBE_DUP
            const int l = (ph - 1) / 11, q_ = (ph - 1) % 11, s = (q_ <= PROBE_DUP) ? q_ : q_ - 1;
#else
            const int l = (ph - 1) / 10, s = (ph - 1) % 10;
#endif
            if (s == 0 || s == 7) {
                pg8::Gemm g{XB, (const bf16*)(ws + (s == 0 ? WS_WGU1 : WS_WGU2)), M, GUW, D / 2}; pg8::StaticOrder S; S.init(M, GUW, G, bx);
                pg8::EpiSwiGLU8 E{(unsigned char*)HB};
                pg8::gemm_phase<pg8::EpiSwiGLU8, pg8::StaticOrder, true, true, true>(lds, g, S, E);
            } else if (s == 1 || s == 8) {
                pg8::Gemm g{HB, (const bf16*)(ws + (s == 1 ? WS_WD1 : WS_WD2)), M, D, FF / 2}; pg8::StaticOrder S; S.init(M, D, G, bx);
                const bool raw = (l == 0 && s == 1);
                const float* xg = raw ? (const float*)(ws + WS_ONES) : (s == 1 ? a.ln_g2 + (l - 1) * D : a.ln_g1 + l * D);
                const float* xb = raw ? (const float*)(ws + WS_ONES) + D : (s == 1 ? a.ln_b2 + (l - 1) * D : a.ln_b1 + l * D);
                pg8::EpiResid E{YH, 0.5f / (WD_SCALE * H_SCALE), (const f32x2*)(ws + (raw ? WS_STAT0 : WS_STAT)), xg, xb};
                pg8::gemm_phase<pg8::EpiResid, pg8::StaticOrder, true, true, true>(lds, g, S, E);
            } else if (s == 5) {
                pg8::Gemm g{YM, (const bf16*)(ws + WS_WOUT), M, D, D}; pg8::StaticOrder S; S.init(M, D, G, bx);
                pg8::EpiResid E{YH, 1.0f, (const f32x2*)(ws + WS_STAT), a.ln_g0 + l * D, a.ln_b0 + l * D};
                pg8::gemm_phase<pg8::EpiResid, pg8::StaticOrder, true, true, false>(lds, g, S, E);
            } else if (s == 3) {
                pg8::Gemm g{XB, (const bf16*)(ws + WS_WIN), M, INW, D}; pg8::StaticOrder S; S.init(M, INW, G, bx);
                pg8::EpiInProj E{HB, tab};
                pg8::gemm_phase<pg8::EpiInProj, pg8::StaticOrder, true, true, false>(lds, g, S, E);
            } else if (s == 4) {
                if (G == 256) {
                    const int seg = vcu & 3, a0 = (vcu >> 2) * 8 + (seg == 0 ? 0 : (seg == 1 ? 3 : (seg == 2 ? 5 : 7))), an = (seg == 0 ? 3 : (seg == 3 ? 1 : 2));
                    RET_UNIT(vcu >> 5, (vcu >> 2) & 7, seg);
                    for (int u = a0; u < a0 + an; ++u) { ATT_UNIT(u >> 6, (u >> 5) & 1, u & 31); }
                } else {
                    for (int u = vcu; u < 256; u += G) { RET_UNIT(u >> 5, (u >> 2) & 7, u & 3); }
                    for (int u = vcu; u < BATCH * 2 * 32; u += G) { ATT_UNIT(u >> 6, (u >> 5) & 1, u & 31); }
                }
            } else {
                const int tid = opaque_tid(), lane = tid & 63, wave = __builtin_amdgcn_readfirstlane(tid >> 6), gw = vcu * NWAVES + wave;
                const int k = (s == 2) ? 0 : (s == 6 ? 1 : 2);
                const float* gp = (k == 0 ? a.ln_g0 : (k == 1 ? a.ln_g1 : a.ln_g2)) + l * D; const float* bp = (k == 0 ? a.ln_b0 : (k == 1 ? a.ln_b1 : a.ln_b2)) + l * D;
                const bool fin = (s == 9 && l + 1 == DEPTH);
                if (M % (4 * NGW) == 0) { for (int m = gw; m < M; m += 4 * NGW) ln_rows<4>(YH, X, XB, (f32x2*)(ws + WS_STAT), gp, bp, lane, s != 2, fin, m, NGW); }
                else { for (int m = gw; m < M; m += NGW) ln_rows<1>(YH, X, XB, (f32x2*)(ws + WS_STAT), gp, bp, lane, s != 2, fin, m, NGW); }
                if (s == 9 && l + 1 < DEPTH) convert_layer_weights(a, l + 1, ws, lds, wave, lane, gw, NGW);
            }
        }
        if (ph + 1 < ph_hi) {
            unsigned* bw_ = (unsigned*)ws; volatile LAS unsigned* st_ = (volatile LAS unsigned*)(lds + 131072 + 320) + 8;
            if (!bar_ready) { __syncthreads(); cg::this_grid().sync(); (void)xcd_barrier_post(bw_, st_); bar_ready = true; }
            else { XcdBarrier bar; bar.bar = bw_; bar.x = xb_xcc_id(); bar.st = st_; xcd_barrier(bar); }
        }
    }
}

extern "C" void kernel_launch(void* const* d_in, const int* in_sizes, int n_in, void* d_out, int out_size, void* d_ws, size_t ws_size, hipStream_t stream) {
    static int grid = 0;
    if (grid == 0) {
        if (n_in != 14 || in_sizes[0] != M * D || out_size != M * D || ws_size < WS_END) { fprintf(stderr, "kernel_launch: unexpected shapes: n_in %d in0 %d out %d ws %zu\n", n_in, n_in > 0 ? in_sizes[0] : -1, out_size, ws_size); grid = -1; return; }
        int dev = 0, cus = 0, per_cu = 0;
        if (hipGetDevice(&dev) != hipSuccess || hipDeviceGetAttribute(&cus, hipDeviceAttributeMultiprocessorCount, dev) != hipSuccess) { grid = -1; return; }
        if (hipFuncSetAttribute((const void*)mk_fwd, hipFuncAttributeMaxDynamicSharedMemorySize, LDS_BYTES) != hipSuccess) { fprintf(stderr, "kernel_launch: hipFuncSetAttribute failed\n"); grid = -1; return; }
        if (hipOccupancyMaxActiveBlocksPerMultiprocessor(&per_cu, (const void*)mk_fwd, NTHREADS, LDS_BYTES) != hipSuccess || per_cu < 1) { fprintf(stderr, "kernel_launch: occupancy query gave %d\n", per_cu); per_cu = 1; }
        (void)hipGetLastError();
        grid = cus * per_cu;
        fprintf(stderr, "kernel_launch: grid %d (cus %d x %d)\n", grid, cus, per_cu);
    }
    if (grid < 0) return;
    Args a{};
    a.x = (const float*)d_in[0]; a.w_in = (const float*)d_in[1]; a.w_out = (const float*)d_in[2]; a.sinks = (const float*)d_in[3];
    a.w_gu1 = (const float*)d_in[4]; a.w_d1 = (const float*)d_in[5]; a.w_gu2 = (const float*)d_in[6]; a.w_d2 = (const float*)d_in[7];
    a.ln_g0 = (const float*)d_in[8]; a.ln_b0 = (const float*)d_in[9]; a.ln_g1 = (const float*)d_in[10]; a.ln_b1 = (const float*)d_in[11];
    a.ln_g2 = (const float*)d_in[12]; a.ln_b2 = (const float*)d_in[13];
    a.out = (float*)d_out; a.ws = (unsigned char*)d_ws;
#ifdef PROBE_DUP
    constexpr int NPH = 1 + 11 * DEPTH;
#else
    constexpr int NPH = 1 + 10 * DEPTH;
#endif
#if MK_ONE_LAUNCH
    a.ph_lo = 0; a.ph_hi = NPH;
    void* params[] = {&a};
    hipError_t e = hipLaunchCooperativeKernel((const void*)mk_fwd, dim3(grid), dim3(NTHREADS), params, LDS_BYTES, stream);
    if (e != hipSuccess) fprintf(stderr, "kernel_launch: cooperative launch failed: %s (grid %d)\n", hipGetErrorString(e), grid);
#else
    for (int p = 0; p < NPH; ++p) { a.ph_lo = p; a.ph_hi = p + 1; hipLaunchKernelGGL(mk_fwd, dim3(grid), dim3(NTHREADS), LDS_BYTES, stream, a); }
#endif
}
```

```cpp
#include <hip/hip_runtime.h>
#include <hip/hip_cooperative_groups.h>
#include <cstdio>
#include <cstdint>
namespace cg = cooperative_groups;
#ifndef MK_ONE_LAUNCH
#define MK_ONE_LAUNCH 1
#endif
namespace pg8 {
#define PG8_LAS __attribute__((address_space(3)))
typedef unsigned short bf16_t;
typedef short bf16x8 __attribute__((ext_vector_type(8)));
typedef float f32x4 __attribute__((ext_vector_type(4)));
typedef unsigned u32x4 __attribute__((ext_vector_type(4)));
constexpr int BM = 256, BK = 64, HALF = 128, HTB = HALF * BK * 2  , STAGE_BYTES = 8 * HTB, NXCD = 8, WGM = 8;

__host__ __device__ __forceinline__ int lds_byte(int r, int c) { const int st = (r >> 4) * 2 + (c >> 5), rr = r & 15, cc = c & 31, ob = rr * 64 + cc * 2; return st * 1024 + (ob ^ (((ob >> 9) & 1) << 5)); }
__host__ __device__ __forceinline__ void stage_rc(int b, int& R, int& C) { const int st = b / 1024, sb = b % 1024, swz = sb ^ (((sb >> 9) & 1) << 5); R = (st >> 1) * 16 + swz / 64; C = (st & 1) * 32 + (swz % 64) / 2; }
__host__ __device__ __forceinline__ int perm32(int rho) { const int n = rho >> 4, i = rho & 15; return 8 * (i >> 2) + 4 * n + (i & 3); }

struct Unit { int pm, pn; };
struct Gemm { const bf16_t* A; const bf16_t* Bt; int M, N, K; };

struct StaticOrder {
    int nM, nN, nwg, G, c;
    __host__ __device__ void init(int M, int N, int G_, int c_) { nM = M / BM; nN = N / BM; nwg = nM * nN; G = G_; c = c_; }
    __host__ __device__ bool next(int i, Unit& u) const {
        const long L = (long)i * G + c; if (L >= nwg) return false;
        int wgid = (int)L; { const int q = nwg / NXCD, r = nwg % NXCD, xcd = wgid % NXCD, off = wgid / NXCD; wgid = (xcd < r ? xcd * (q + 1) : r * (q + 1) + (xcd - r) * q) + off; }
        const int nig = WGM * nN, gid = wgid / nig, fm = gid * WGM, gsz = (nM - fm) < WGM ? (nM - fm) : WGM;
        u.pm = fm + ((wgid % nig) % gsz); u.pn = (wgid % nig) / gsz; return true;
    }
    __device__ __forceinline__ void a_ready(const Unit&) const {}
    __device__ __forceinline__ void done(const Unit&) const {}
};

__device__ __forceinline__ unsigned cvt_pk_bf16(float lo, float hi) { unsigned r; asm volatile("v_cvt_pk_bf16_f32 %0, %1, %2" : "=v"(r) : "v"(lo), "v"(hi)); return r; }
typedef float f32x2 __attribute__((ext_vector_type(2)));
__device__ __forceinline__ f32x2 gelu_pk(f32x2 v) {
    const f32x2 av = __builtin_elementwise_abs(v), d = av * 0.2316418882f + 1.0f;
    f32x2 t; t.x = __builtin_amdgcn_rcpf(d.x); t.y = __builtin_amdgcn_rcpf(d.y);
    f32x2 q = t * 0.5307027145f + (-0.7265760135f); q = q * t + 0.7107068705f; q = q * t + (-0.142248368f); q = q * t + 0.127414796f; q = q * t;
    const f32x2 s = (v * v) * (-0.72134752044f);
    f32x2 e; e.x = __builtin_amdgcn_exp2f(s.x); e.y = __builtin_amdgcn_exp2f(s.y);
    const f32x2 m = v * (q * e), r = v - m;
    f32x2 o; o.x = v.x < 0.f ? m.x : r.x; o.y = v.y < 0.f ? m.y : r.y; return o;
}

template <int ACT  > struct EpiBf16 {
    static constexpr bool PERM = true, AFTER_DRAIN = false; static_assert(ACT == 0 || ACT == 1, "EpiBf16: ACT is 0 (none) or 1 (gelu_pk)");
    bf16_t* O; int ldc; const float* bias; int split_cols; size_t split_stride; float scale0;
    __device__ __forceinline__ void operator()(const f32x4 (&acc)[2][2][4][2], const Unit& u, int wr, int wc, int fr, int fq) const {
        const int row0 = u.pm * BM + wr * 64 + fr; int colt = u.pn * BM; bf16_t* base = O;
        float sc = 1.f; if (split_cols) { const int t = colt / split_cols; base += (size_t)t * split_stride; colt -= t * split_cols; if (t == 0) sc = scale0; }
        const int col0 = colt + wc * 32 + 8 * fq, bcol0 = u.pn * BM + wc * 32 + 8 * fq;
        f32x4 bv[2][2];
#pragma unroll
        for (int bj = 0; bj < 2; ++bj)
#pragma unroll
            for (int n = 0; n < 2; ++n) bv[bj][n] = bias ? *(const f32x4*)(bias + bcol0 + bj * HALF + 4 * n) : (f32x4){0.f, 0.f, 0.f, 0.f};
#pragma unroll
        for (int ai = 0; ai < 2; ++ai)
#pragma unroll
            for (int m = 0; m < 4; ++m) { bf16_t* rowp = base + (size_t)(row0 + ai * HALF + m * 16) * ldc + col0;
#pragma unroll
                for (int bj = 0; bj < 2; ++bj) { f32x4 v0 = acc[ai][bj][m][0] + bv[bj][0], v1 = acc[ai][bj][m][1] + bv[bj][1];
                    if (ACT == 1) { f32x2 a = gelu_pk((f32x2){v0[0], v0[1]}), b = gelu_pk((f32x2){v0[2], v0[3]}), c = gelu_pk((f32x2){v1[0], v1[1]}), d = gelu_pk((f32x2){v1[2], v1[3]});
                        v0 = (f32x4){a.x, a.y, b.x, b.y}; v1 = (f32x4){c.x, c.y, d.x, d.y}; }
                    v0 = v0 * sc; v1 = v1 * sc; u32x4 w; w.x = cvt_pk_bf16(v0[0], v0[1]); w.y = cvt_pk_bf16(v0[2], v0[3]); w.z = cvt_pk_bf16(v1[0], v1[1]); w.w = cvt_pk_bf16(v1[2], v1[3]);
                    *(u32x4*)(rowp + bj * HALF) = w; } }
    }
};
typedef int i32x4_t __attribute__((ext_vector_type(4))); typedef int i32x8_t __attribute__((ext_vector_type(8)));
__device__ __forceinline__ i32x8_t cat8(bf16x8 lo, bf16x8 hi) { return __builtin_shufflevector(__builtin_bit_cast(i32x4_t, lo), __builtin_bit_cast(i32x4_t, hi), 0, 1, 2, 3, 4, 5, 6, 7); }
template <class Epi, class Sched, bool ALIGN_EPI = false, bool SP2 = false, bool F8 = false>
__device__ __forceinline__ void gemm_phase(PG8_LAS unsigned char* lds, const Gemm g, const Sched& S, const Epi& E) {
    int tid_ = threadIdx.x; asm volatile("" : "+v"(tid_)); const int tid = tid_, wid = __builtin_amdgcn_readfirstlane(tid >> 6), lane = tid & 63, wr = wid >> 2, wc = wid & 3, fr = lane & 15, fq = lane >> 4;
    const int K = g.K, nt = K / BK;
    unsigned voffA, voffB;
    { int R, C; stage_rc(tid * 16, R, C); const int Rb = Epi::PERM ? ((R & ~31) + perm32(R & 31)) : R;
        voffA = (unsigned)(R * K + C) * 2u; voffB = (unsigned)(Rb * K + C) * 2u; }
    const size_t rstep = (size_t)64 * K * 2;
    const size_t kstep = (size_t)(BK * 2);
    const size_t hstep = (size_t)HALF * K * 2;
    const size_t tstep = 2 * hstep;
    const unsigned ldsw = (unsigned)wid * 1024u;
    const int aoff = lds_byte(wr * 64 + fr, fq * 8), boff = lds_byte(wc * 32 + fr, fq * 8);
#define PG8_SA(b, h) (((b) * 2 + (h)) * HTB)
#define PG8_SB(b, h) ((4 + (b) * 2 + (h)) * HTB)
#define PG8_STAGE(bufoff, gbase, voff) do { _Pragma("unroll") for (int _i = 0; _i < 2; ++_i) \
        __builtin_amdgcn_global_load_lds((const unsigned*)((const char*)(gbase) + _i * rstep + (voff)), (PG8_LAS unsigned*)(lds + (bufoff) + ldsw + _i * 8192), 16, 0, 0); } while (0)
#define PG8_LDA(dst, b, h) do { _Pragma("unroll") for (int m = 0; m < 4; ++m) _Pragma("unroll") for (int k = 0; k < 2; ++k) dst[m][k] = *(const PG8_LAS bf16x8*)(lds + PG8_SA(b, h) + aoff + m * 2048 + k * 1024); } while (0)
#define PG8_LDB(dst, b, h) do { _Pragma("unroll") for (int n = 0; n < 2; ++n) _Pragma("unroll") for (int k = 0; k < 2; ++k) dst[n][k] = *(const PG8_LAS bf16x8*)(lds + PG8_SB(b, h) + boff + n * 2048 + k * 1024); } while (0)
#define PG8_MMA(ai, bj, At, Bt) do { __builtin_amdgcn_s_setprio(1); _Pragma("unroll") for (int m = 0; m < 4; ++m) _Pragma("unroll") for (int n = 0; n < 2; ++n) { \
        if constexpr (F8) { acc[ai][bj][m][n] = __builtin_amdgcn_mfma_scale_f32_16x16x128_f8f6f4(cat8(Bt[n][0], Bt[n][1]), cat8(At[m][0], At[m][1]), acc[ai][bj][m][n], 0, 0, 0, 0, 0, 0); } \
        else { _Pragma("unroll") for (int k = 0; k < 2; ++k) acc[ai][bj][m][n] = __builtin_amdgcn_mfma_f32_16x16x32_bf16(Bt[n][k], At[m][k], acc[ai][bj][m][n], 0, 0, 0); } } __builtin_amdgcn_s_setprio(0); } while (0)
#define PG8_WAIT_V(n) asm volatile("s_waitcnt vmcnt(" #n ")" ::: "memory")
#define PG8_WAIT_L(n) asm volatile("s_waitcnt lgkmcnt(" #n ")" ::: "memory")
#define PG8_BAR __builtin_amdgcn_s_barrier()
#define PG8_SCHED __builtin_amdgcn_sched_barrier(0)
    Unit cur, nxt; int ui = 0;
    if (!S.next(0, cur)) return;
    f32x4 acc[2][2][4][2];
#pragma unroll
    for (int a = 0; a < 2; ++a)
#pragma unroll
        for (int b = 0; b < 2; ++b)
#pragma unroll
            for (int m = 0; m < 4; ++m)
#pragma unroll
                for (int n = 0; n < 2; ++n) acc[a][b][m][n] = (f32x4){0.f, 0.f, 0.f, 0.f};
    bf16x8 At[4][2], B0[2][2], B1[2][2];
    const char* cA = (const char*)g.A + (size_t)cur.pm * tstep; const char* cB = (const char*)g.Bt + (size_t)cur.pn * tstep;
    S.a_ready(cur);
    if constexpr (SP2) {
        PG8_STAGE(PG8_SB(0, 0), cB, voffB); PG8_STAGE(PG8_SB(0, 1), cB + hstep, voffB); PG8_STAGE(PG8_SA(0, 0), cA, voffA); PG8_STAGE(PG8_SA(0, 1), cA + hstep, voffA);
        if (wr == 1) PG8_BAR;
        PG8_WAIT_V(2); PG8_BAR;
        PG8_STAGE(PG8_SB(1, 0), cB + kstep, voffB); PG8_STAGE(PG8_SA(1, 0), cA + kstep, voffA); PG8_STAGE(PG8_SB(1, 1), cB + hstep + kstep, voffB);
        PG8_WAIT_V(6); PG8_BAR;
    } else {
        PG8_STAGE(PG8_SB(0, 0), cB, voffB); PG8_STAGE(PG8_SA(0, 0), cA, voffA); PG8_STAGE(PG8_SB(0, 1), cB + hstep, voffB); PG8_STAGE(PG8_SA(0, 1), cA + hstep, voffA);
        if (wr == 1) PG8_BAR;
        PG8_WAIT_V(4); PG8_BAR;
        PG8_STAGE(PG8_SB(1, 0), cB + kstep, voffB); PG8_STAGE(PG8_SA(1, 0), cA + kstep, voffA); PG8_STAGE(PG8_SB(1, 1), cB + hstep + kstep, voffB);
        PG8_WAIT_V(6); PG8_BAR;
    }
    for (;;) {
        const bool has_next = S.next(ui + 1, nxt);
        const char* nA = has_next ? (const char*)g.A + (size_t)nxt.pm * tstep : cA; const char* nB = has_next ? (const char*)g.Bt + (size_t)nxt.pn * tstep : cB;
#pragma unroll 1
        for (int t = 0; t < nt; t += 2) {
            const bool last = (t == nt - 2);
            const char* a1 = cA + (size_t)(t + 1) * kstep;
            const char* a2 = last ? nA : cA + (size_t)(t + 2) * kstep; const char* b2 = last ? nB : cB + (size_t)(t + 2) * kstep;
            const char* a3 = a2 + kstep; const char* b3 = b2 + kstep;
            if (last && has_next) S.a_ready(nxt);
            if constexpr (SP2) {
            PG8_LDB(B0, 0, 0); PG8_LDB(B1, 0, 1); PG8_SCHED; PG8_LDA(At, 0, 0); PG8_STAGE(PG8_SA(1, 1), a1 + hstep, voffA);
            PG8_WAIT_V(8); PG8_WAIT_L(0); PG8_BAR; PG8_MMA(0, 0, At, B0); PG8_MMA(0, 1, At, B1); PG8_BAR; PG8_SCHED;
            PG8_LDA(At, 0, 1); PG8_STAGE(PG8_SB(0, 0), b2, voffB); PG8_STAGE(PG8_SB(0, 1), b2 + hstep, voffB); PG8_STAGE(PG8_SA(0, 0), a2, voffA);
            PG8_WAIT_V(8); PG8_WAIT_L(0); PG8_BAR; PG8_MMA(1, 0, At, B0); PG8_MMA(1, 1, At, B1); PG8_BAR; PG8_SCHED;
            PG8_LDB(B0, 1, 0); PG8_LDB(B1, 1, 1); PG8_SCHED; PG8_LDA(At, 1, 0); PG8_STAGE(PG8_SA(0, 1), a2 + hstep, voffA);
            PG8_WAIT_V(8); PG8_WAIT_L(0); PG8_BAR; PG8_MMA(0, 0, At, B0); PG8_MMA(0, 1, At, B1); PG8_BAR; PG8_SCHED;
            PG8_LDA(At, 1, 1); PG8_STAGE(PG8_SB(1, 0), b3, voffB); PG8_STAGE(PG8_SB(1, 1), b3 + hstep, voffB); PG8_STAGE(PG8_SA(1, 0), a3, voffA);
            PG8_WAIT_V(8); PG8_WAIT_L(0); PG8_BAR; PG8_MMA(1, 0, At, B0); PG8_MMA(1, 1, At, B1); PG8_BAR; PG8_SCHED;
            } else {
            PG8_LDB(B0, 0, 0); PG8_SCHED; PG8_LDA(At, 0, 0); PG8_STAGE(PG8_SA(1, 1), a1 + hstep, voffA);
            PG8_WAIT_L(8); PG8_BAR; PG8_WAIT_L(0); PG8_MMA(0, 0, At, B0); PG8_BAR; PG8_SCHED;
            PG8_LDB(B1, 0, 1); PG8_STAGE(PG8_SB(0, 0), b2, voffB);
            PG8_BAR; PG8_WAIT_L(0); PG8_MMA(0, 1, At, B1); PG8_BAR;
            PG8_LDA(At, 0, 1); PG8_STAGE(PG8_SA(0, 0), a2, voffA);
            PG8_BAR; PG8_WAIT_L(0); PG8_MMA(1, 0, At, B0); PG8_BAR; PG8_SCHED;
            PG8_STAGE(PG8_SB(0, 1), b2 + hstep, voffB);
            PG8_WAIT_V(6); PG8_BAR; PG8_MMA(1, 1, At, B1); PG8_BAR;
            PG8_LDB(B0, 1, 0); PG8_SCHED; PG8_LDA(At, 1, 0); PG8_STAGE(PG8_SA(0, 1), a2 + hstep, voffA);
            PG8_WAIT_L(8); PG8_BAR; PG8_WAIT_L(0); PG8_MMA(0, 0, At, B0); PG8_BAR; PG8_SCHED;
            PG8_LDB(B1, 1, 1); PG8_STAGE(PG8_SB(1, 0), b3, voffB);
            PG8_BAR; PG8_WAIT_L(0); PG8_MMA(0, 1, At, B1); PG8_BAR;
            PG8_LDA(At, 1, 1); PG8_STAGE(PG8_SA(1, 0), a3, voffA);
            PG8_BAR; PG8_WAIT_L(0); PG8_MMA(1, 0, At, B0); PG8_BAR; PG8_SCHED;
            PG8_STAGE(PG8_SB(1, 1), b3 + hstep, voffB);
            PG8_WAIT_V(6); PG8_BAR; PG8_MMA(1, 1, At, B1); PG8_BAR;
            }
        }
        if constexpr (ALIGN_EPI) { if (wr == 0) PG8_BAR; }
        if constexpr (!Epi::AFTER_DRAIN) { int t2_ = threadIdx.x; asm volatile("" : "+v"(t2_)); E(acc, cur, wr, wc, t2_ & 15, (t2_ & 63) >> 4); S.done(cur); }
        if (!has_next) break;
#pragma unroll
        for (int a = 0; a < 2; ++a)
#pragma unroll
            for (int b = 0; b < 2; ++b)
#pragma unroll
                for (int m = 0; m < 4; ++m)
#pragma unroll
                    for (int n = 0; n < 2; ++n) acc[a][b][m][n] = (f32x4){0.f, 0.f, 0.f, 0.f};
        cur = nxt; cA = nA; cB = nB; ++ui;
        if constexpr (ALIGN_EPI) { if (wr == 1) PG8_BAR; }
    }
    PG8_WAIT_V(0);
    if constexpr (!ALIGN_EPI) { if (wr == 0) PG8_BAR; }
    PG8_BAR;
    if constexpr (Epi::AFTER_DRAIN) { E.fused(acc, cur, wr, wc, fr, fq, lds, wid, lane); S.done(cur); }
#undef PG8_SA
#undef PG8_SB
#undef PG8_STAGE
#undef PG8_LDA
#undef PG8_LDB
#undef PG8_MMA
#undef PG8_WAIT_V
#undef PG8_WAIT_L
#undef PG8_BAR
#undef PG8_SCHED
}
}

#define DI __device__ __forceinline__
#define LAS __attribute__((address_space(3)))
typedef unsigned short bf16;
typedef short bf16x8 __attribute__((ext_vector_type(8)));
typedef short s16x4 __attribute__((ext_vector_type(4)));
typedef float f32x4 __attribute__((ext_vector_type(4)));
typedef float f32x2 __attribute__((ext_vector_type(2)));
typedef float f32x16 __attribute__((ext_vector_type(16)));
typedef unsigned u32x4 __attribute__((ext_vector_type(4)));
typedef unsigned u32x2 __attribute__((ext_vector_type(2)));
typedef __bf16 bf16x2_t __attribute__((ext_vector_type(2)));
typedef _Float16 f16x4 __attribute__((ext_vector_type(4)));
typedef _Float16 f16x8 __attribute__((ext_vector_type(8)));
typedef LAS unsigned char lds_u8;

constexpr int NWAVES = 8, NTHREADS = 512;
constexpr int BATCH = 8, SEQ = 4096, D = 1024, DEPTH = 4, M = BATCH * SEQ;
constexpr int HD = 64, FF = 2816, INW = 2816, GUW = 2 * FF;
constexpr float ALPHA = 1.681792830507429f;
constexpr float LN_EPS = 1e-5f, GN_EPS = 1e-6f;
constexpr float LOG2E = 1.4426950408889634f;
constexpr float QSCALE = 0.125f * LOG2E;

constexpr size_t MiB = 1u << 20;
constexpr size_t WS_STAT0 = 3 * MiB + 256 * 1024, WS_ONES = 3 * MiB + 512 * 1024;
constexpr size_t WS_STAT = 3 * MiB;
constexpr size_t WS_TAB = 1 * MiB;
constexpr size_t WS_WGU1 = 4 * MiB, WS_WD1 = 16 * MiB, WS_WGU2 = 22 * MiB, WS_WD2 = 34 * MiB, WS_WIN = 40 * MiB, WS_WOUT = 46 * MiB;
constexpr size_t WS_XB = 48 * MiB;
constexpr size_t WS_HB = 112 * MiB;
constexpr size_t WS_YM = 288 * MiB;
constexpr size_t WS_Y = 352 * MiB;
constexpr size_t WS_WSET = 412 * MiB;
constexpr size_t WS_END = 460 * MiB;
constexpr int LDS_BYTES = 147456;

DI unsigned cvtpk(float lo, float hi) { f32x2 v = {lo, hi}; bf16x2_t b = __builtin_convertvector(v, bf16x2_t); return __builtin_bit_cast(unsigned, b); }
DI float bf2f(unsigned short b) { return __uint_as_float((unsigned)b << 16); }
DI float fast_exp2(float x) { return __builtin_amdgcn_exp2f(x); }
DI float fast_rcp(float x) { return __builtin_amdgcn_rcpf(x); }
DI unsigned pk4_fp8(float a, float b, float c, float d) {
    a = __builtin_amdgcn_fmed3f(a, -448.f, 448.f); b = __builtin_amdgcn_fmed3f(b, -448.f, 448.f); c = __builtin_amdgcn_fmed3f(c, -448.f, 448.f); d = __builtin_amdgcn_fmed3f(d, -448.f, 448.f);
    const unsigned lo = (unsigned)__builtin_amdgcn_cvt_pk_fp8_f32(a, b, 0, false), hi = (unsigned)__builtin_amdgcn_cvt_pk_fp8_f32(c, d, 0, false);
    return (lo & 0xffffu) | (hi << 16);
}
constexpr float WGU_SCALE = 64.f, WD_SCALE = 128.f, H_SCALE = 8.f;
DI float q8(float v) {
    const float a = fabsf(v);
    if (a >= 448.f) return copysignf(448.f, v);
    if (a < 0.015625f) return rintf(v * 512.f) * (1.f / 512.f);
    unsigned u = __float_as_uint(v); u += 0x7FFFFu + ((u >> 20) & 1u); u &= 0xFFF00000u; return __uint_as_float(u);
}
#ifdef EMU_FP8
#define Q8S(v, s) (q8((v) * (s)) * (1.0f / (s)))
#else
#define Q8S(v, s) (v)
#endif
DI float silu_f(float a) { return a * fast_rcp(1.0f + fast_exp2(-a * LOG2E)); }
DI float shx(float v, int mask, int lane) { return __builtin_bit_cast(float, __builtin_amdgcn_ds_bpermute(((lane ^ mask) & 63) << 2, __builtin_bit_cast(int, v))); }
DI float wave_sum(float v, int lane) {
#pragma unroll
    for (int o = 1; o < 64; o <<= 1) v += shx(v, o, lane);
    return v;
}
DI int opaque_tid() { int t = threadIdx.x; asm volatile("" : "+v"(t)); return t; }
DI int crow(int r, int hi) { return (r & 3) + 8 * (r >> 2) + 4 * hi; }
#define MFMA32(a, b, c) __builtin_amdgcn_mfma_f32_32x32x16_bf16((a), (b), (c), 0, 0, 0)

namespace pg8 {
struct EpiSwiGLU {
    static constexpr bool PERM = true, AFTER_DRAIN = false;
    bf16_t* H;
    __device__ __forceinline__ void operator()(const f32x4 (&acc)[2][2][4][2], const Unit& u, int wr, int wc, int fr, int fq) const {
        const int row0 = u.pm * BM + wr * 64 + fr, col0 = u.pn * 128 + wc * 32 + 8 * fq;
#pragma unroll
        for (int ai = 0; ai < 2; ++ai)
#pragma unroll
            for (int m = 0; m < 4; ++m) {
                bf16_t* rowp = H + (size_t)(row0 + ai * HALF + m * 16) * FF + col0;
                float h[8];
#pragma unroll
                for (int n = 0; n < 2; ++n)
#pragma unroll
                    for (int j = 0; j < 4; ++j) h[n * 4 + j] = Q8S(silu_f(acc[ai][0][m][n][j]) * acc[ai][1][m][n][j], 8.0f);
                u32x4 w; w.x = cvtpk(h[0], h[1]); w.y = cvtpk(h[2], h[3]); w.z = cvtpk(h[4], h[5]); w.w = cvtpk(h[6], h[7]);
                *(u32x4*)rowp = w;
            }
    }
};
struct EpiSwiGLU8 {
    static constexpr bool PERM = true, AFTER_DRAIN = false;
    unsigned char* H;
    __device__ __forceinline__ void operator()(const f32x4 (&acc)[2][2][4][2], const Unit& u, int wr, int wc, int fr, int fq) const {
        const int row0 = u.pm * BM + wr * 64 + fr, col0 = u.pn * 128 + wc * 32 + 8 * fq;
        constexpr float c1 = -LOG2E / WGU_SCALE, c2 = H_SCALE / (WGU_SCALE * WGU_SCALE);
#pragma unroll
        for (int ai = 0; ai < 2; ++ai)
#pragma unroll
            for (int m = 0; m < 4; ++m) {
                unsigned char* rowp = H + (size_t)(row0 + ai * HALF + m * 16) * FF + col0;
                u32x2 w;
#pragma unroll
                for (int n = 0; n < 2; ++n) {
                    const f32x4 g = acc[ai][0][m][n], uu = acc[ai][1][m][n];
                    const f32x4 t = g * c1;
                    f32x4 d = {fast_exp2(t[0]), fast_exp2(t[1]), fast_exp2(t[2]), fast_exp2(t[3])};
                    d = d + 1.0f;
                    const f32x4 r = {fast_rcp(d[0]), fast_rcp(d[1]), fast_rcp(d[2]), fast_rcp(d[3])};
                    const f32x4 h = ((g * c2) * uu) * r;
                    const unsigned pk = pk4_fp8(h[0], h[1], h[2], h[3]);
                    if (n == 0) w.x = pk; else w.y = pk;
                }
                *(u32x2*)rowp = w;
            }
    }
};
struct EpiResid {
    static constexpr bool PERM = true, AFTER_DRAIN = false;
    _Float16* Y; float s; const f32x2* stats; const float* g; const float* b;
    __device__ __forceinline__ void operator()(const f32x4 (&acc)[2][2][4][2], const Unit& u, int wr, int wc, int fr, int fq) const {
        const int col0 = u.pn * BM + wc * 32 + 8 * fq, row0 = u.pm * BM + wr * 64 + fr;
        f32x2 st[2][4];
#pragma unroll
        for (int ai = 0; ai < 2; ++ai)
#pragma unroll
            for (int m = 0; m < 4; ++m) st[ai][m] = stats[row0 + ai * HALF + m * 16];
#pragma unroll
        for (int bj = 0; bj < 2; ++bj) {
            f32x4 ga[2], ab[2];
#pragma unroll
            for (int n = 0; n < 2; ++n) { ga[n] = *(const f32x4*)(g + col0 + bj * HALF + 4 * n) * ALPHA; ab[n] = *(const f32x4*)(b + col0 + bj * HALF + 4 * n) * ALPHA; }
#pragma unroll
            for (int ai = 0; ai < 2; ++ai)
#pragma unroll
                for (int m = 0; m < 4; ++m) {
                    _Float16* p = Y + (size_t)(row0 + ai * HALF + m * 16) * D + col0 + bj * HALF;
                    const f16x8 xh = *(const f16x8*)p;
                    f16x8 oh;
#pragma unroll
                    for (int n = 0; n < 2; ++n) {
                        const f32x4 xv = {(float)xh[4 * n], (float)xh[4 * n + 1], (float)xh[4 * n + 2], (float)xh[4 * n + 3]};
                        const f32x4 y = (xv - st[ai][m].x) * (ga[n] * st[ai][m].y) + (ab[n] + acc[ai][bj][m][n] * s);
                        oh[4 * n] = (_Float16)y[0]; oh[4 * n + 1] = (_Float16)y[1]; oh[4 * n + 2] = (_Float16)y[2]; oh[4 * n + 3] = (_Float16)y[3];
                    }
                    *(f16x8*)p = oh;
                }
        }
    }
};
struct EpiInProj {
    static constexpr bool PERM = true, AFTER_DRAIN = false;
    bf16_t* O; const float* tab;
    __device__ __forceinline__ void operator()(const f32x4 (&acc)[2][2][4][2], const Unit& u, int wr, int wc, int fr, int fq) const {
        const int pn = u.pn;
        int mode;
        float sc = 1.f;
        if (pn < 2) { mode = 1; sc = QSCALE; } else if (pn == 2) { mode = (wc < 2) ? 1 : 0; } else if (pn < 5) { mode = 2; } else if (pn < 7) { mode = 2; sc = 0.125f; } else if (pn < 9) { mode = 0; } else { mode = 3; }
        const int row0 = u.pm * BM + wr * 64 + fr, col0 = pn * 256 + wc * 64 + 8 * fq;
        const float* rc = tab; const float* rs = tab + SEQ * 32; const float* tc = tab + 2 * SEQ * 32; const float* ts = tab + 3 * SEQ * 32;
#pragma unroll
        for (int ai = 0; ai < 2; ++ai)
#pragma unroll
            for (int m = 0; m < 4; ++m) {
                const int row = row0 + ai * HALF + m * 16, pos = row & (SEQ - 1);
                bf16_t* rowp = O + (size_t)row * INW + col0;
                float o[2][8];
                if (mode == 1) {
#pragma unroll
                    for (int n = 0; n < 2; ++n) {
                        const f32x4 c = *(const f32x4*)(rc + pos * 32 + 8 * fq + 4 * n), s = *(const f32x4*)(rs + pos * 32 + 8 * fq + 4 * n);
#pragma unroll
                        for (int j = 0; j < 4; ++j) { const float x1 = acc[ai][0][m][n][j], x2 = acc[ai][1][m][n][j];
                            o[0][n * 4 + j] = (x1 * c[j] - x2 * s[j]) * sc; o[1][n * 4 + j] = (x2 * c[j] + x1 * s[j]) * sc; }
                    }
                } else if (mode == 2) {
#pragma unroll
                    for (int bj = 0; bj < 2; ++bj)
#pragma unroll
                        for (int n = 0; n < 2; ++n) {
                            const f32x2 c = *(const f32x2*)(tc + pos * 32 + bj * 16 + 4 * fq + 2 * n), s = *(const f32x2*)(ts + pos * 32 + bj * 16 + 4 * fq + 2 * n);
#pragma unroll
                            for (int p = 0; p < 2; ++p) { const float xe = acc[ai][bj][m][n][2 * p], xo = acc[ai][bj][m][n][2 * p + 1];
                                o[bj][n * 4 + 2 * p] = (xe * c[p] - xo * s[p]) * sc; o[bj][n * 4 + 2 * p + 1] = (xo * c[p] + xe * s[p]) * sc; }
                        }
                } else {
#pragma unroll
                    for (int bj = 0; bj < 2; ++bj)
#pragma unroll
                        for (int n = 0; n < 2; ++n)
#pragma unroll
                            for (int j = 0; j < 4; ++j) { const float v = acc[ai][bj][m][n][j]; o[bj][n * 4 + j] = (mode == 3) ? silu_f(v) : v; }
                }
#pragma unroll
                for (int bj = 0; bj < 2; ++bj) {
                    u32x4 w; w.x = cvtpk(o[bj][0], o[bj][1]); w.y = cvtpk(o[bj][2], o[bj][3]); w.z = cvtpk(o[bj][4], o[bj][5]); w.w = cvtpk(o[bj][6], o[bj][7]);
                    *(u32x4*)(rowp + bj * 32) = w;
                }
            }
    }
};
}

struct Args {
    const float* x; const float* w_in; const float* w_out; const float* sinks;
    const float* w_gu1; const float* w_d1; const float* w_gu2; const float* w_d2;
    const float* ln_g0; const float* ln_g1; const float* ln_g2; const float* ln_b0; const float* ln_b1; const float* ln_b2;
    float* out; unsigned char* ws; int ph_lo, ph_hi;
};

DI void transpose_item(const float* W, int K, int Nsrc, int srcbase, void* WT, int n0, int k0, LAS float* scr, int lane, float f8s) {
    float wv[32];
#pragma unroll
    for (int i = 0; i < 32; ++i) wv[i] = W[(size_t)(k0 + 2 * i + (lane >> 5)) * Nsrc + srcbase + (lane & 31)];
#pragma unroll
    for (int i = 0; i < 32; ++i) scr[(2 * i + (lane >> 5)) * 33 + (lane & 31)] = wv[i];
    asm volatile("s_waitcnt lgkmcnt(0)" ::: "memory");
    const int c = lane & 7;
#pragma unroll
    for (int j = 0; j < 4; ++j) { const int n = (lane >> 3) + 8 * j; const LAS float* s = scr + (8 * c) * 33 + n;
        if (f8s == 0.f) {
            u32x4 o; o.x = cvtpk(s[0 * 33], s[1 * 33]); o.y = cvtpk(s[2 * 33], s[3 * 33]); o.z = cvtpk(s[4 * 33], s[5 * 33]); o.w = cvtpk(s[6 * 33], s[7 * 33]);
            *(u32x4*)((bf16*)WT + (size_t)(n0 + n) * K + k0 + 8 * c) = o;
        } else {
            u32x2 o; o.x = pk4_fp8(s[0 * 33] * f8s, s[1 * 33] * f8s, s[2 * 33] * f8s, s[3 * 33] * f8s); o.y = pk4_fp8(s[4 * 33] * f8s, s[5 * 33] * f8s, s[6 * 33] * f8s, s[7 * 33] * f8s);
            *(u32x2*)((unsigned char*)WT + (size_t)(n0 + n) * K + k0 + 8 * c) = o;
        } }
    asm volatile("s_waitcnt lgkmcnt(0)" ::: "memory");
}
DI int src_col(int which, int n0) {
    if (which == 0) { const int pn = n0 >> 8, c = n0 & 255; return (c >> 7) * FF + pn * 128 + (c & 127); }
    if (which == 2) { const int pn = n0 >> 8, c = n0 & 255; return pn * 256 + ((c & 127) >> 5) * 64 + (c >> 7) * 32 + (c & 31); }
    return n0;
}
DI void convert_matrix_items(const float* W, int K, int N, int which, void* WT, LAS float* scr, int lane, int first, int gw, int NGW) {
    const int nblk = N / 32, nitems = (K / 64) * nblk;
    int it = gw - (first % NGW); if (it < 0) it += NGW;
    for (; it < nitems; it += NGW) { const int kb = it / nblk, nb = it % nblk; transpose_item(W, K, N, src_col(which, nb * 32), WT, nb * 32, kb * 64, scr, lane, which == 0 ? WGU_SCALE : (which == 3 ? WD_SCALE : 0.f)); }
}
typedef const Args __attribute__((address_space(4))) CArgs;
DI void convert_layer_weights(const CArgs& a, int l, unsigned char* ws0, LAS unsigned char* lds, int wave, int lane, int gw, int NGW, int mask) {
    LAS float* scr = (LAS float*)(lds + wave * 16384);
    unsigned char* ws = ws0 + ((l & 1) ? WS_WSET : 0);
    constexpr int I_GU = (D / 64) * (GUW / 32), I_D = (FF / 64) * (D / 32), I_IN = (D / 64) * (INW / 32), I_OUT = (D / 64) * (D / 32);
    int first = 0;
    if (mask & 1) convert_matrix_items(a.w_gu1 + (size_t)l * D * GUW, D, GUW, 0, (bf16*)(ws + WS_WGU1), scr, lane, first, gw, NGW); first += I_GU;
    if (mask & 2) convert_matrix_items(a.w_d1 + (size_t)l * FF * D, FF, D, 3, (bf16*)(ws + WS_WD1), scr, lane, first, gw, NGW); first += I_D;
    if (mask & 4) convert_matrix_items(a.w_in + (size_t)l * D * INW, D, INW, 2, (bf16*)(ws + WS_WIN), scr, lane, first, gw, NGW); first += I_IN;
    if (mask & 8) convert_matrix_items(a.w_out + (size_t)l * D * D, D, D, 1, (bf16*)(ws + WS_WOUT), scr, lane, first, gw, NGW); first += I_OUT;
    if (mask & 16) convert_matrix_items(a.w_gu2 + (size_t)l * D * GUW, D, GUW, 0, (bf16*)(ws + WS_WGU2), scr, lane, first, gw, NGW); first += I_GU;
    if (mask & 32) convert_matrix_items(a.w_d2 + (size_t)l * FF * D, FF, D, 3, (bf16*)(ws + WS_WD2), scr, lane, first, gw, NGW);
}
DI void sincos_d(double x, float& c, float& s) {
    const double TWO_PI = 6.283185307179586476925;
    const double k = __builtin_rint(x / TWO_PI), r = x - k * TWO_PI, r2 = r * r;
    double sn = r, cs = 1.0, tsn = r, tcs = 1.0;
#pragma unroll 1
    for (int i = 1; i <= 15; ++i) { tcs *= -r2 / (double)((2 * i - 1) * (2 * i)); cs += tcs; tsn *= -r2 / (double)((2 * i) * (2 * i + 1)); sn += tsn; }
    c = (float)cs; s = (float)sn;
}
DI void build_tables(float* tab, int gtid, int nthreads) {
    for (int e = gtid; e < 2 * SEQ * 32; e += nthreads) {
        const int which = e / (SEQ * 32), r = e % (SEQ * 32), pos = r >> 5, i = r & 31;
        const double base = which == 0 ? 0.7498942093324558 : 0.7429639507594947;
        double f = 1.0;
#pragma unroll 1
        for (int k = 0; k < i; ++k) f *= base;
        float c, s; sincos_d((double)pos * f, c, s);
        tab[(size_t)(2 * which) * SEQ * 32 + r] = c; tab[(size_t)(2 * which + 1) * SEQ * 32 + r] = s;
    }
}
DI void row_to_fp8_f16(const float* xrow, unsigned char* orow, _Float16* hrow, int lane) {
    const f32x4* xr = (const f32x4*)xrow + lane; unsigned* o4 = (unsigned*)orow + lane; f16x4* h4 = (f16x4*)hrow + lane;
#pragma unroll
    for (int j = 0; j < 4; ++j) { const f32x4 v = xr[64 * j]; o4[64 * j] = pk4_fp8(v[0], v[1], v[2], v[3]); h4[64 * j] = (f16x4){(_Float16)v[0], (_Float16)v[1], (_Float16)v[2], (_Float16)v[3]}; }
}
template <int NR> DI void ln_rows(const _Float16* Y, float* Xo, void* XBv, f32x2* stat, const float* g, const float* b, int lane, bool quant, bool write_x, int m0, int mstep) {
    f32x4 v[NR][4]; float s[NR], s2[NR];
    {   f16x8 h[NR][2];
#pragma unroll
        for (int r = 0; r < NR; ++r) { const f16x8* yr = (const f16x8*)(Y + (size_t)(m0 + r * mstep) * D) + lane; h[r][0] = yr[0]; h[r][1] = yr[64]; }
#pragma unroll
        for (int r = 0; r < NR; ++r)
#pragma unroll
            for (int c = 0; c < 2; ++c)
#pragma unroll
                for (int q = 0; q < 2; ++q) v[r][2 * c + q] = (f32x4){(float)h[r][c][4 * q], (float)h[r][c][4 * q + 1], (float)h[r][c][4 * q + 2], (float)h[r][c][4 * q + 3]};
    }
#pragma unroll
    for (int r = 0; r < NR; ++r) { s[r] = 0.f;
#pragma unroll
        for (int j = 0; j < 4; ++j) s[r] += (v[r][j][0] + v[r][j][1]) + (v[r][j][2] + v[r][j][3]); }
#pragma unroll
    for (int o = 1; o < 64; o <<= 1)
#pragma unroll
        for (int r = 0; r < NR; ++r) s[r] += shx(s[r], o, lane);
#pragma unroll
    for (int r = 0; r < NR; ++r) { const float mean = s[r] * (1.f / D); s[r] = mean; s2[r] = 0.f;
#pragma unroll
        for (int j = 0; j < 4; ++j) { v[r][j] = v[r][j] - mean; s2[r] += (v[r][j][0] * v[r][j][0] + v[r][j][1] * v[r][j][1]) + (v[r][j][2] * v[r][j][2] + v[r][j][3] * v[r][j][3]); } }
#pragma unroll
    for (int o = 1; o < 64; o <<= 1)
#pragma unroll
        for (int r = 0; r < NR; ++r) s2[r] += shx(s2[r], o, lane);
#pragma unroll
    for (int c = 0; c < 2; ++c) {
        const int e0 = c * 512 + 8 * lane;
        const f32x4 g0 = *(const f32x4*)(g + e0), g1 = *(const f32x4*)(g + e0 + 4), b0 = *(const f32x4*)(b + e0), b1 = *(const f32x4*)(b + e0 + 4);
#pragma unroll
        for (int r = 0; r < NR; ++r) {
            const int m = m0 + r * mstep;
            const float rstd = 1.f / sqrtf(s2[r] * (1.f / D) + LN_EPS);
            if (c == 0 && lane == 0) stat[m] = (f32x2){s[r], rstd};
            const f32x4 o0 = v[r][2 * c] * rstd * g0 + b0, o1 = v[r][2 * c + 1] * rstd * g1 + b1;
            if (write_x) { float* xo = Xo + (size_t)m * D + e0; *(f32x4*)xo = o0; *(f32x4*)(xo + 4) = o1; }
            if (quant) { u32x2 w; w.x = pk4_fp8(o0[0], o0[1], o0[2], o0[3]); w.y = pk4_fp8(o1[0], o1[1], o1[2], o1[3]); *(u32x2*)((unsigned char*)XBv + (size_t)m * D + e0) = w; }
            else { u32x4 w; w.x = cvtpk(o0[0], o0[1]); w.y = cvtpk(o0[2], o0[3]); w.z = cvtpk(o1[0], o1[1]); w.w = cvtpk(o1[2], o1[3]); *(u32x4*)((bf16*)XBv + (size_t)m * D + e0) = w; }
        }
    }
}

constexpr int A_KS = 0, A_KSTR = 72 * 2;
constexpr int A_VT = 256 * A_KSTR, A_VSTR = 264 * 2;
constexpr int A_STG = A_VT + 64 * A_VSTR, STG_STR = 72 * 2, STG_BYTES = 32 * STG_STR;
static_assert(A_STG + 8 * STG_BYTES <= 131072, "attention LDS");

DI void stage_out_store(lds_u8* stg, const f32x16 (&o)[2], int r32, int hi) {
#pragma unroll
    for (int db = 0; db < 2; ++db)
#pragma unroll
        for (int rg = 0; rg < 4; ++rg) {
            u32x2 w; w.x = cvtpk(o[db][4 * rg], o[db][4 * rg + 1]); w.y = cvtpk(o[db][4 * rg + 2], o[db][4 * rg + 3]);
            *(LAS u32x2*)(stg + r32 * STG_STR + (db * 32 + 8 * rg + 4 * hi) * 2) = w;
        }
}

DI void attn_unit(lds_u8* lds, const bf16* HM, bf16* YM, const float* sinks, int b, int g, int n) {
    const int tid = opaque_tid(), lane = tid & 63, r32 = lane & 31, hi = lane >> 5, wid = __builtin_amdgcn_readfirstlane(tid >> 6);
    const long keyrow0 = (long)b * SEQ + n * 128 - 128;
    {
        const int token = tid & 255; const bool valid = (n > 0) || (token >= 128);
        const bf16* src = HM + (keyrow0 + token) * INW + 512 + g * 64;
        u32x4 kv[4];
#pragma unroll
        for (int i = 0; i < 4; ++i) { kv[i] = (u32x4){0u, 0u, 0u, 0u}; if (valid) kv[i] = *(const u32x4*)(src + ((tid >> 8) + 2 * i) * 8); }
        const int q4 = (tid & 63) * 4, dcv = tid >> 6; const bool vvalid = (n > 0) || (q4 >= 128);
        u32x4 vr[4];
#pragma unroll
        for (int t = 0; t < 4; ++t) { vr[t] = (u32x4){0u, 0u, 0u, 0u}; if (vvalid) vr[t] = *(const u32x4*)(HM + (keyrow0 + q4 + t) * INW + 640 + g * 64 + dcv * 8); }
#pragma unroll
        for (int i = 0; i < 4; ++i) *(LAS u32x4*)(lds + A_KS + token * A_KSTR + ((tid >> 8) + 2 * i) * 16) = kv[i];
        const bf16x8 v0 = __builtin_bit_cast(bf16x8, vr[0]), v1 = __builtin_bit_cast(bf16x8, vr[1]), v2 = __builtin_bit_cast(bf16x8, vr[2]), v3 = __builtin_bit_cast(bf16x8, vr[3]);
#pragma unroll
        for (int ii = 0; ii < 8; ++ii) *(LAS s16x4*)(lds + A_VT + (dcv * 8 + ii) * A_VSTR + q4 * 2) = (s16x4){v0[ii], v1[ii], v2[ii], v3[ii]};
    }
    __syncthreads();
    const int hq = g * 4 + (wid >> 1);
    const float sink2 = sinks[hq] * LOG2E;
    lds_u8* stg = lds + A_STG + wid * STG_BYTES;
    const int jmin = (n == 0) ? 128 : 0;
#pragma unroll 1
    for (int qb = 0; qb < 2; ++qb) {
        const int i0 = (wid & 1) * 64 + qb * 32, iq = i0 + r32;
        const long qrow = (long)b * SEQ + n * 128 + iq;
        bf16x8 qf[4];
#pragma unroll
        for (int ks = 0; ks < 4; ++ks) qf[ks] = *(const bf16x8*)(HM + qrow * INW + hq * 64 + ks * 16 + hi * 8);
        float mrun = sink2, lrun = (hi == 0) ? 1.f : 0.f;
        f32x16 o[2];
#pragma unroll
        for (int r = 0; r < 16; ++r) { o[0][r] = 0.f; o[1][r] = 0.f; }
#pragma unroll 1
        for (int t = 0; t < 5; ++t) {
            const int kb = i0 + 32 * t;
            f32x16 s;
#pragma unroll
            for (int r = 0; r < 16; ++r) s[r] = 0.f;
#pragma unroll
            for (int ks = 0; ks < 4; ++ks) {
                const bf16x8 kf = *(const LAS bf16x8*)(lds + A_KS + (kb + r32) * A_KSTR + (ks * 16 + hi * 8) * 2);
                s = MFMA32(kf, qf[ks], s);
            }
            float tmax = -INFINITY;
#pragma unroll
            for (int r = 0; r < 16; ++r) { const int jj = kb + crow(r, hi); const bool vis = (jj > iq) && (jj <= iq + 128) && (jj >= jmin); s[r] = vis ? s[r] : -INFINITY; tmax = fmaxf(tmax, s[r]); }
            tmax = fmaxf(tmax, shx(tmax, 32, lane));
            const float mnew = fmaxf(mrun, tmax), scl = fast_exp2(mrun - mnew);
            mrun = mnew;
            float psum = 0.f;
#pragma unroll
            for (int r = 0; r < 16; ++r) { s[r] = fast_exp2(s[r] - mnew); psum += s[r]; }
            lrun = lrun * scl + psum;
#pragma unroll
            for (int r = 0; r < 16; ++r) { o[0][r] *= scl; o[1][r] *= scl; }
#pragma unroll
            for (int gk = 0; gk < 2; ++gk) {
                u32x4 pw; pw.x = cvtpk(s[8 * gk], s[8 * gk + 1]); pw.y = cvtpk(s[8 * gk + 2], s[8 * gk + 3]); pw.z = cvtpk(s[8 * gk + 4], s[8 * gk + 5]); pw.w = cvtpk(s[8 * gk + 6], s[8 * gk + 7]);
                const bf16x8 pf = __builtin_bit_cast(bf16x8, pw);
#pragma unroll
                for (int db = 0; db < 2; ++db) {
                    const lds_u8* vp = lds + A_VT + (db * 32 + r32) * A_VSTR + (kb + 16 * gk + 4 * hi) * 2;
                    const s16x4 lo = *(const LAS s16x4*)vp, hi4 = *(const LAS s16x4*)(vp + 16);
                    const bf16x8 vf = __builtin_shufflevector(lo, hi4, 0, 1, 2, 3, 4, 5, 6, 7);
                    o[db] = MFMA32(vf, pf, o[db]);
                }
            }
        }
        const float ltot = lrun + shx(lrun, 32, lane), inv = 1.0f / ltot;
#pragma unroll
        for (int r = 0; r < 16; ++r) { o[0][r] *= inv; o[1][r] *= inv; }
        stage_out_store(stg, o, r32, hi);
        asm volatile("s_waitcnt lgkmcnt(0)" ::: "memory");
        bf16* yw = YM + ((long)b * SEQ + n * 128 + i0) * D + hq * 64;
#pragma unroll
        for (int it = 0; it < 4; ++it) { const int row = it * 8 + (lane >> 3), ch = lane & 7;
            const u32x4 v = *(const LAS u32x4*)(stg + row * STG_STR + ch * 16); *(u32x4*)(yw + (long)row * D + ch * 8) = v; }
        asm volatile("s_waitcnt lgkmcnt(0)" ::: "memory");
    }
    __syncthreads();
}

constexpr int R_QS = 0, R_KS = 128 * 144, R_VT = 2 * 128 * 144, R_TSTR = 136 * 2, R_KT = R_VT + 64 * R_TSTR, R_ST = R_KT + 64 * R_TSTR, R_STG = R_ST + 64 * 144;
static_assert(R_STG + 4 * STG_BYTES <= 131072, "retention LDS");

DI void ret_unit(lds_u8* lds, const bf16* HM, bf16* YM, int b, int h, int seg) {
    const int tid = opaque_tid(), lane = tid & 63, r32 = lane & 31, hi = lane >> 5, wid = __builtin_amdgcn_readfirstlane(tid >> 6);
    float lg2;
    { int hh_ = h; asm volatile("" : "+s"(hh_)); const double x = __builtin_ldexp(1.0, -5 - hh_); double t = x, s = 0.0;
#pragma unroll 1
      for (int k = 1; k <= 10; ++k) { s -= t / (double)k; t *= x; }
      lg2 = (float)(s * 1.4426950408889634); }
    const float gchunk = fast_exp2(128.f * lg2);
    const int q4 = (tid & 31) * 4, dcs = (tid >> 5) & 7; const bool grpA = (wid < 4);
    float wk[4];
#pragma unroll
    for (int t = 0; t < 4; ++t) wk[t] = fast_exp2((float)(127 - (q4 + t)) * lg2);
    const long row0 = (long)b * SEQ;
    const int nfull0 = 8 * seg, nend = nfull0 + 8;
    for (int i = tid; i < 64 * 144 / 4; i += NTHREADS) *(LAS unsigned*)(lds + R_ST + i * 4) = 0u;
    f32x16 st;
#pragma unroll
    for (int r = 0; r < 16; ++r) st[r] = 0.f;
    u32x4 pa[4], pb[4];
#pragma unroll
    for (int t = 0; t < 4; ++t) pb[t] = (u32x4){0u, 0u, 0u, 0u};
    { const bf16* src = HM + (row0 + q4) * INW + h * 64 + dcs * 8;
#pragma unroll
      for (int t = 0; t < 4; ++t) { pa[t] = *(const u32x4*)(src + (size_t)t * INW + (grpA ? 1280 : 1792)); if (!grpA && nfull0 == 0) pb[t] = *(const u32x4*)(src + (size_t)t * INW + 768); } }
#pragma unroll 1
    for (int n = 0; n < nend; ++n) {
        const bool full = (n >= nfull0);
        {
            const bf16x8 a0 = __builtin_bit_cast(bf16x8, pa[0]), a1 = __builtin_bit_cast(bf16x8, pa[1]), a2 = __builtin_bit_cast(bf16x8, pa[2]), a3 = __builtin_bit_cast(bf16x8, pa[3]);
            if (grpA) {
                if (full) {
#pragma unroll
                    for (int t = 0; t < 4; ++t) *(LAS u32x4*)(lds + R_KS + (q4 + t) * 144 + dcs * 16) = pa[t];
                }
#pragma unroll
                for (int ii = 0; ii < 8; ++ii) {
                    u32x2 w; w.x = cvtpk(bf2f((unsigned short)a0[ii]) * wk[0], bf2f((unsigned short)a1[ii]) * wk[1]); w.y = cvtpk(bf2f((unsigned short)a2[ii]) * wk[2], bf2f((unsigned short)a3[ii]) * wk[3]);
                    *(LAS u32x2*)(lds + R_KT + (dcs * 8 + ii) * R_TSTR + q4 * 2) = w;
                }
            } else {
                if (full) {
#pragma unroll
                    for (int t = 0; t < 4; ++t) *(LAS u32x4*)(lds + R_QS + (q4 + t) * 144 + dcs * 16) = pb[t];
                }
#pragma unroll
                for (int ii = 0; ii < 8; ++ii) *(LAS s16x4*)(lds + R_VT + (dcs * 8 + ii) * R_TSTR + q4 * 2) = (s16x4){a0[ii], a1[ii], a2[ii], a3[ii]};
            }
        }
        __syncthreads();
        if (n + 1 < nend) { const bf16* src = HM + (row0 + (n + 1) * 128 + q4) * INW + h * 64 + dcs * 8; const bool nq = (n + 1 >= nfull0);
#pragma unroll
            for (int t = 0; t < 4; ++t) { pa[t] = *(const u32x4*)(src + (size_t)t * INW + (grpA ? 1280 : 1792)); if (!grpA && nq) pb[t] = *(const u32x4*)(src + (size_t)t * INW + 768); } }
        if (wid < 4) {
          if (full) {
            const int ib = wid, iq = 32 * ib + r32;
            const long trow = row0 + n * 128 + 32 * ib;
            u32x4 gv[4];
#pragma unroll
            for (int it = 0; it < 4; ++it) gv[it] = *(const u32x4*)(HM + (trow + it * 8 + (lane >> 3)) * INW + 2304 + h * 64 + (lane & 7) * 8);
            bf16x8 qf[4];
#pragma unroll
            for (int ks = 0; ks < 4; ++ks) qf[ks] = *(const LAS bf16x8*)(lds + R_QS + iq * 144 + (ks * 16 + hi * 8) * 2);
            f32x16 o[2];
#pragma unroll
            for (int r = 0; r < 16; ++r) { o[0][r] = 0.f; o[1][r] = 0.f; }
#pragma unroll
            for (int eb = 0; eb < 2; ++eb)
#pragma unroll
                for (int ks = 0; ks < 4; ++ks) {
                    const bf16x8 sf = *(const LAS bf16x8*)(lds + R_ST + (eb * 32 + r32) * 144 + (ks * 16 + hi * 8) * 2);
                    o[eb] = MFMA32(sf, qf[ks], o[eb]);
                }
            const float wq = fast_exp2((float)(iq + 1) * lg2);
#pragma unroll
            for (int r = 0; r < 16; ++r) { o[0][r] *= wq; o[1][r] *= wq; }
#pragma unroll 1
            for (int jb = 0; jb <= ib; ++jb) {
                f32x16 s;
#pragma unroll
                for (int r = 0; r < 16; ++r) s[r] = 0.f;
#pragma unroll
                for (int ks = 0; ks < 4; ++ks) {
                    const bf16x8 kf = *(const LAS bf16x8*)(lds + R_KS + (jb * 32 + r32) * 144 + (ks * 16 + hi * 8) * 2);
                    s = MFMA32(kf, qf[ks], s);
                }
#pragma unroll
                for (int r = 0; r < 16; ++r) { const int dj = iq - (jb * 32 + crow(r, hi)); s[r] = (dj >= 0) ? s[r] * fast_exp2((float)dj * lg2) : 0.f; }
#pragma unroll
                for (int gk = 0; gk < 2; ++gk) {
                    u32x4 pw; pw.x = cvtpk(s[8 * gk], s[8 * gk + 1]); pw.y = cvtpk(s[8 * gk + 2], s[8 * gk + 3]); pw.z = cvtpk(s[8 * gk + 4], s[8 * gk + 5]); pw.w = cvtpk(s[8 * gk + 6], s[8 * gk + 7]);
                    const bf16x8 pf = __builtin_bit_cast(bf16x8, pw);
#pragma unroll
                    for (int eb = 0; eb < 2; ++eb) {
                        const lds_u8* vp = lds + R_VT + (eb * 32 + r32) * R_TSTR + (jb * 32 + 16 * gk + 4 * hi) * 2;
                        const s16x4 lo = *(const LAS s16x4*)vp, hi4 = *(const LAS s16x4*)(vp + 16);
                        const bf16x8 vf = __builtin_shufflevector(lo, hi4, 0, 1, 2, 3, 4, 5, 6, 7);
                        o[eb] = MFMA32(vf, pf, o[eb]);
                    }
                }
            }
            float sm = 0.f;
#pragma unroll
            for (int r = 0; r < 16; ++r) sm += o[0][r] + o[1][r];
            sm += shx(sm, 32, lane);
            const float mu = sm * (1.f / 64.f);
            float sq = 0.f;
#pragma unroll
            for (int r = 0; r < 16; ++r) { o[0][r] -= mu; o[1][r] -= mu; sq += o[0][r] * o[0][r] + o[1][r] * o[1][r]; }
            sq += shx(sq, 32, lane);
            const float rstd = 1.f / sqrtf(sq * (1.f / 64.f) + GN_EPS);
#pragma unroll
            for (int r = 0; r < 16; ++r) { o[0][r] *= rstd; o[1][r] *= rstd; }
            lds_u8* stg = lds + R_STG + wid * STG_BYTES;
            stage_out_store(stg, o, r32, hi);
            asm volatile("s_waitcnt lgkmcnt(0)" ::: "memory");
#pragma unroll
            for (int it = 0; it < 4; ++it) { const int row = it * 8 + (lane >> 3), ch = lane & 7;
                const u32x4 ov = *(const LAS u32x4*)(stg + row * STG_STR + ch * 16);
                const bf16x8 o8 = __builtin_bit_cast(bf16x8, ov), g8 = __builtin_bit_cast(bf16x8, gv[it]);
                u32x4 w;
                w.x = cvtpk(bf2f((unsigned short)o8[0]) * bf2f((unsigned short)g8[0]), bf2f((unsigned short)o8[1]) * bf2f((unsigned short)g8[1]));
                w.y = cvtpk(bf2f((unsigned short)o8[2]) * bf2f((unsigned short)g8[2]), bf2f((unsigned short)o8[3]) * bf2f((unsigned short)g8[3]));
                w.z = cvtpk(bf2f((unsigned short)o8[4]) * bf2f((unsigned short)g8[4]), bf2f((unsigned short)o8[5]) * bf2f((unsigned short)g8[5]));
                w.w = cvtpk(bf2f((unsigned short)o8[6]) * bf2f((unsigned short)g8[6]), bf2f((unsigned short)o8[7]) * bf2f((unsigned short)g8[7]));
                *(u32x4*)(YM + (trow + row) * D + 512 + h * 64 + ch * 8) = w; }
          }
        } else {
            const int eb = (wid - 4) >> 1, dk = (wid - 4) & 1;
#pragma unroll
            for (int r = 0; r < 16; ++r) st[r] *= gchunk;
#pragma unroll
            for (int ks = 0; ks < 8; ++ks) {
                const bf16x8 vf = *(const LAS bf16x8*)(lds + R_VT + (eb * 32 + r32) * R_TSTR + (ks * 16 + hi * 8) * 2);
                const bf16x8 kf = *(const LAS bf16x8*)(lds + R_KT + (dk * 32 + r32) * R_TSTR + (ks * 16 + hi * 8) * 2);
                st = MFMA32(vf, kf, st);
            }
        }
        __syncthreads();
        if (wid >= 4 && n + 1 >= nfull0) {
            const int eb = (wid - 4) >> 1, dk = (wid - 4) & 1;
#pragma unroll
            for (int r = 0; r < 16; ++r) *(LAS short*)(lds + R_ST + (eb * 32 + crow(r, hi)) * 144 + (dk * 32 + r32) * 2) = (short)(cvtpk(st[r], 0.f) & 0xffffu);
        }
    }
    __syncthreads();
}

#define XB_TMO      128
#define XB_XCNT(j)  (256  + 64 * (j))
#define XB_XSUB(j)  (1280 + 64 * (j))
#define XB_XGEN(j)  (2304 + 64 * (j))
#define XB_TOP      3328
#define XB_TOPGEN   3392
#define XCD_BAR_WORDS 3456
#define XB_SPIN_CAP (1u << 18)

__device__ __forceinline__ unsigned xb_ld(unsigned* p)              { return __hip_atomic_load(p, __ATOMIC_RELAXED, __HIP_MEMORY_SCOPE_AGENT); }
__device__ __forceinline__ unsigned xb_add(unsigned* p, unsigned v) { return __hip_atomic_fetch_add(p, v, __ATOMIC_RELAXED, __HIP_MEMORY_SCOPE_AGENT); }
__device__ __forceinline__ unsigned xb_xcc_id() { return (unsigned)__builtin_amdgcn_s_getreg((3 << 11) | 20) & 0xFu; }
#define XB_SPIN(cond, bar) do { unsigned _sp = 0; while (cond) { __builtin_amdgcn_s_sleep(1); \
    if ((++_sp & 255u) == 0u) { if (xb_ld(&(bar)[XB_TMO])) break; if (_sp > XB_SPIN_CAP) { atomicAdd(&(bar)[XB_TMO], 1u); break; } } } } while (0)

struct XcdBarrier {
    unsigned* bar; unsigned x;
    volatile LAS unsigned* st;
};

__device__ __forceinline__ XcdBarrier xcd_barrier_post(unsigned* bar, volatile LAS unsigned* st) {
    XcdBarrier b; b.bar = bar; b.x = xb_xcc_id(); b.st = st;
    if (opaque_tid() == 0) (void)xb_add(&bar[XB_XCNT(b.x)], 1u);
    return b;
}
__device__ __forceinline__ void xcd_barrier_complete(unsigned* bar, unsigned x, unsigned& nloc, unsigned& nx) {
    const unsigned G = gridDim.x * gridDim.y * gridDim.z;
    unsigned sum, cnt, mine, sp = 0u;
    for (;;) {
        sum = 0u; cnt = 0u; mine = 0u;
#pragma unroll
        for (unsigned j = 0; j < 16; ++j) { const unsigned c = xb_ld(&bar[XB_XCNT(j)]); sum += c; cnt += (c > 0u) ? 1u : 0u; mine = (j == x) ? c : mine; }
        if (sum == G) break;
        __builtin_amdgcn_s_sleep(1);
        if ((++sp & 255u) == 0u) { if (xb_ld(&bar[XB_TMO])) break; if (sp > XB_SPIN_CAP) { atomicAdd(&bar[XB_TMO], 1u); break; } }
    }
    nloc = mine > 0u ? mine : 1u; nx = cnt > 0u ? cnt : 1u;
}

__device__ __forceinline__ void xcd_barrier(const XcdBarrier& b) {
    asm volatile("s_waitcnt vmcnt(0)" ::: "memory");
    __syncthreads();
    if (opaque_tid() == 0) {
        unsigned* bar = b.bar;
        __builtin_amdgcn_s_waitcnt(0);
        unsigned nloc = b.st[0], nx = b.st[1];
        if (nloc == 0u) { xcd_barrier_complete(bar, b.x, nloc, nx); b.st[0] = nloc; b.st[1] = nx; }
        const unsigned old = xb_add(&bar[XB_XSUB(b.x)], 1u);
        const unsigned gen = old / nloc;
        if (old + 1u == (gen + 1u) * nloc) {
            __builtin_amdgcn_fence(__ATOMIC_RELEASE, "agent");
            asm volatile("s_waitcnt vmcnt(0)" ::: "memory");
            const unsigned og = xb_add(&bar[XB_TOP], 1u);
            const unsigned tg = og / nx;
            if (og + 1u == (tg + 1u) * nx) xb_add(&bar[XB_TOPGEN], 1u);
            else XB_SPIN(xb_ld(&bar[XB_TOPGEN]) == tg, bar);
            __builtin_amdgcn_fence(__ATOMIC_ACQUIRE, "agent");
            xb_add(&bar[XB_XGEN(b.x)], 1u);
            asm volatile("s_waitcnt vmcnt(0)" ::: "memory");
        } else {
            XB_SPIN(xb_ld(&bar[XB_XGEN(b.x)]) == gen, bar);
            __builtin_amdgcn_fence(__ATOMIC_ACQUIRE, "agent");
            asm volatile("s_waitcnt vmcnt(0)" ::: "memory");
        }
    }
    __syncthreads();
}
#ifdef SKIP_RET
#define RET_UNIT(bb, hh, ss)
#else
#define RET_UNIT(bb, hh, ss) ret_unit(lds, HB, YM, (bb), (hh), (ss))
#endif
#ifdef SKIP_ATT
#define ATT_UNIT(bb, gg, nn)
#else
#define ATT_UNIT(bb, gg, nn) attn_unit(lds, HB, YM, a.sinks + l * 8, (bb), (gg), (nn))
#endif
__global__ void __launch_bounds__(NTHREADS, 2) mk_fwd(Args a_) {
    extern __shared__ __attribute__((aligned(16))) unsigned char lds_raw[];
    {
        volatile LAS unsigned* MISC0 = (volatile LAS unsigned*)((LAS unsigned char*)lds_raw + 131072 + 320);
        if (opaque_tid() < 64) MISC0[opaque_tid()] = 0u;
        __syncthreads();
    }
    bool bar_ready = false;
    const int ph_lo = a_.ph_lo, ph_hi = a_.ph_hi;
#pragma unroll 1
    for (int ph = ph_lo; ph < ph_hi; ++ph) {
        int z_ = 0; asm volatile("" : "+s"(z_));
        const CArgs* ap_ = (const CArgs*)__builtin_amdgcn_kernarg_segment_ptr(); asm volatile("" : "+s"(ap_)); const CArgs& a = *ap_;
        LAS unsigned char* lds = (LAS unsigned char*)lds_raw + z_;
        const int G = gridDim.x + z_, bx = blockIdx.x + z_;
        const int vcu = (G % 8 == 0) ? (bx % 8) * (G / 8) + bx / 8 : bx;
        const int NGW = G * NWAVES;
        unsigned char* ws = a.ws + z_;
        float* tab = (float*)(ws + WS_TAB);
        bf16* XB = (bf16*)(ws + WS_XB); bf16* HB = (bf16*)(ws + WS_HB); bf16* YM = (bf16*)(ws + WS_YM);
        float* X = a.out + z_;
        _Float16* YH = (_Float16*)(ws + WS_Y);
        if (ph == 0) {
            const int tid = opaque_tid(), lane = tid & 63, wave = __builtin_amdgcn_readfirstlane(tid >> 6), gw = vcu * NWAVES + wave;
            if (bx == 0) for (int i = tid; i < XCD_BAR_WORDS; i += NTHREADS) ((unsigned*)ws)[i] = 0u;
            build_tables(tab, vcu * NTHREADS + tid, G * NTHREADS);
            for (int i = vcu * NTHREADS + tid; i < M; i += G * NTHREADS) ((f32x2*)(ws + WS_STAT0))[i] = (f32x2){__int_as_float(z_), __int_as_float(0x3f800000 + z_)};
            for (int i = vcu * NTHREADS + tid; i < 2 * D; i += G * NTHREADS) ((float*)(ws + WS_ONES))[i] = (i < D) ? __int_as_float(0x3f800000 + z_) : __int_as_float(z_);
            convert_layer_weights(a, 0, ws, lds, wave, lane, gw, NGW, 63);
            for (int m = gw; m < M; m += NGW) row_to_fp8_f16(a.x + (size_t)m * D, (unsigned char*)XB + (size_t)m * D, YH + (size_t)m * D, lane);
        } else {
#ifdef PROBE_DUP
            const int l = (ph - 1) / 11, q_ = (ph - 1) % 11, s = (q_ <= PROBE_DUP) ? q_ : q_ - 1;
#else
            const int l = (ph - 1) / 10, s = (ph - 1) % 10;
#endif
            unsigned char* wsw = ws + ((l & 1) ? WS_WSET : 0);
            if (s == 0 || s == 7) {
                pg8::Gemm g{XB, (const bf16*)(wsw + (s == 0 ? WS_WGU1 : WS_WGU2)), M, GUW, D / 2}; pg8::StaticOrder S; S.init(M, GUW, G, bx);
                pg8::EpiSwiGLU8 E{(unsigned char*)HB};
                pg8::gemm_phase<pg8::EpiSwiGLU8, pg8::StaticOrder, true, true, true>(lds, g, S, E);
            } else if (s == 1 || s == 8) {
                pg8::Gemm g{HB, (const bf16*)(wsw + (s == 1 ? WS_WD1 : WS_WD2)), M, D, FF / 2}; pg8::StaticOrder S; S.init(M, D, G, bx);
                const bool raw = (l == 0 && s == 1);
                const float* xg = raw ? (const float*)(ws + WS_ONES) : (s == 1 ? a.ln_g2 + (l - 1) * D : a.ln_g1 + l * D);
                const float* xb = raw ? (const float*)(ws + WS_ONES) + D : (s == 1 ? a.ln_b2 + (l - 1) * D : a.ln_b1 + l * D);
                pg8::EpiResid E{YH, 0.5f / (WD_SCALE * H_SCALE), (const f32x2*)(ws + (raw ? WS_STAT0 : WS_STAT)), xg, xb};
                pg8::gemm_phase<pg8::EpiResid, pg8::StaticOrder, true, true, true>(lds, g, S, E);
            } else if (s == 5) {
                pg8::Gemm g{YM, (const bf16*)(wsw + WS_WOUT), M, D, D}; pg8::StaticOrder S; S.init(M, D, G, bx);
                pg8::EpiResid E{YH, 1.0f, (const f32x2*)(ws + WS_STAT), a.ln_g0 + l * D, a.ln_b0 + l * D};
                pg8::gemm_phase<pg8::EpiResid, pg8::StaticOrder, true, true, false>(lds, g, S, E);
            } else if (s == 3) {
                pg8::Gemm g{XB, (const bf16*)(wsw + WS_WIN), M, INW, D}; pg8::StaticOrder S; S.init(M, INW, G, bx);
                pg8::EpiInProj E{HB, tab};
                pg8::gemm_phase<pg8::EpiInProj, pg8::StaticOrder, true, true, false>(lds, g, S, E);
                if (G == 256 && bx >= 128 && l + 1 < DEPTH) {
                    const int tid = opaque_tid(), lane = tid & 63, wave = __builtin_amdgcn_readfirstlane(tid >> 6);
                    convert_layer_weights(a, l + 1, ws, lds, wave, lane, (bx - 128) * NWAVES + wave, 128 * NWAVES, 7);
                }
            } else if (s == 4) {
                if (G == 256) {
                    const int seg = vcu & 3, a0 = (vcu >> 2) * 8 + (seg == 0 ? 0 : (seg == 1 ? 3 : (seg == 2 ? 5 : 7))), an = (seg == 0 ? 3 : (seg == 3 ? 1 : 2));
                    RET_UNIT(vcu >> 5, (vcu >> 2) & 7, seg);
                    for (int u = a0; u < a0 + an; ++u) { ATT_UNIT(u >> 6, (u >> 5) & 1, u & 31); }
                } else {
                    for (int u = vcu; u < 256; u += G) { RET_UNIT(u >> 5, (u >> 2) & 7, u & 3); }
                    for (int u = vcu; u < BATCH * 2 * 32; u += G) { ATT_UNIT(u >> 6, (u >> 5) & 1, u & 31); }
                }
            } else {
                const int tid = opaque_tid(), lane = tid & 63, wave = __builtin_amdgcn_readfirstlane(tid >> 6), gw = vcu * NWAVES + wave;
                const int k = (s == 2) ? 0 : (s == 6 ? 1 : 2);
                const float* gp = (k == 0 ? a.ln_g0 : (k == 1 ? a.ln_g1 : a.ln_g2)) + l * D; const float* bp = (k == 0 ? a.ln_b0 : (k == 1 ? a.ln_b1 : a.ln_b2)) + l * D;
                const bool fin = (s == 9 && l + 1 == DEPTH);
                if (M % (4 * NGW) == 0) { for (int m = gw; m < M; m += 4 * NGW) ln_rows<4>(YH, X, XB, (f32x2*)(ws + WS_STAT), gp, bp, lane, s != 2, fin, m, NGW); }
                else { for (int m = gw; m < M; m += NGW) ln_rows<1>(YH, X, XB, (f32x2*)(ws + WS_STAT), gp, bp, lane, s != 2, fin, m, NGW); }
                if (s == 9 && l + 1 < DEPTH) convert_layer_weights(a, l + 1, ws, lds, wave, lane, gw, NGW, G == 256 ? 56 : 63);
            }
        }
        if (ph + 1 < ph_hi) {
            unsigned* bw_ = (unsigned*)ws; volatile LAS unsigned* st_ = (volatile LAS unsigned*)(lds + 131072 + 320) + 8;
            if (!bar_ready) { __syncthreads(); cg::this_grid().sync(); (void)xcd_barrier_post(bw_, st_); bar_ready = true; }
            else { XcdBarrier bar; bar.bar = bw_; bar.x = xb_xcc_id(); bar.st = st_; xcd_barrier(bar); }
        }
    }
}

extern "C" void kernel_launch(void* const* d_in, const int* in_sizes, int n_in, void* d_out, int out_size, void* d_ws, size_t ws_size, hipStream_t stream) {
    static int grid = 0;
    if (grid == 0) {
        if (n_in != 14 || in_sizes[0] != M * D || out_size != M * D || ws_size < WS_END) { fprintf(stderr, "kernel_launch: unexpected shapes: n_in %d in0 %d out %d ws %zu\n", n_in, n_in > 0 ? in_sizes[0] : -1, out_size, ws_size); grid = -1; return; }
        int dev = 0, cus = 0, per_cu = 0;
        if (hipGetDevice(&dev) != hipSuccess || hipDeviceGetAttribute(&cus, hipDeviceAttributeMultiprocessorCount, dev) != hipSuccess) { grid = -1; return; }
        if (hipFuncSetAttribute((const void*)mk_fwd, hipFuncAttributeMaxDynamicSharedMemorySize, LDS_BYTES) != hipSuccess) { fprintf(stderr, "kernel_launch: hipFuncSetAttribute failed\n"); grid = -1; return; }
        if (hipOccupancyMaxActiveBlocksPerMultiprocessor(&per_cu, (const void*)mk_fwd, NTHREADS, LDS_BYTES) != hipSuccess || per_cu < 1) { fprintf(stderr, "kernel_launch: occupancy query gave %d\n", per_cu); per_cu = 1; }
        (void)hipGetLastError();
        grid = cus * per_cu;
        fprintf(stderr, "kernel_launch: grid %d (cus %d x %d)\n", grid, cus, per_cu);
    }
    if (grid < 0) return;
    Args a{};
    a.x = (const float*)d_in[0]; a.w_in = (const float*)d_in[1]; a.w_out = (const float*)d_in[2]; a.sinks = (const float*)d_in[3];
    a.w_gu1 = (const float*)d_in[4]; a.w_d1 = (const float*)d_in[5]; a.w_gu2 = (const float*)d_in[6]; a.w_d2 = (const float*)d_in[7];
    a.ln_g0 = (const float*)d_in[8]; a.ln_b0 = (const float*)d_in[9]; a.ln_g1 = (const float*)d_in[10]; a.ln_b1 = (const float*)d_in[11];
    a.ln_g2 = (const float*)d_in[12]; a.ln_b2 = (const float*)d_in[13];
    a.out = (float*)d_out; a.ws = (unsigned char*)d_ws;
#ifdef PROBE_DUP
    constexpr int NPH = 1 + 11 * DEPTH;
#else
    constexpr int NPH = 1 + 10 * DEPTH;
#endif
#if MK_ONE_LAUNCH
    a.ph_lo = 0; a.ph_hi = NPH;
    void* params[] = {&a};
    hipError_t e = hipLaunchCooperativeKernel((const void*)mk_fwd, dim3(grid), dim3(NTHREADS), params, LDS_BYTES, stream);
    if (e != hipSuccess) fprintf(stderr, "kernel_launch: cooperative launch failed: %s (grid %d)\n", hipGetErrorString(e), grid);
#else
    for (int p = 0; p < NPH; ++p) { a.ph_lo = p; a.ph_hi = p + 1; hipLaunchKernelGGL(mk_fwd, dim3(grid), dim3(NTHREADS), LDS_BYTES, stream, a); }
#endif
}
```

```cpp
#include <hip/hip_runtime.h>
#include <hip/hip_cooperative_groups.h>
#include <cstdio>
#include <cstdint>
namespace cg = cooperative_groups;
#ifndef MK_ONE_LAUNCH
#define MK_ONE_LAUNCH 1
#endif
namespace pg8 {
#define PG8_LAS __attribute__((address_space(3)))
typedef unsigned short bf16_t;
typedef short bf16x8 __attribute__((ext_vector_type(8)));
typedef float f32x4 __attribute__((ext_vector_type(4)));
typedef unsigned u32x4 __attribute__((ext_vector_type(4)));
constexpr int BM = 256, BK = 64, HALF = 128, HTB = HALF * BK * 2  , STAGE_BYTES = 8 * HTB, NXCD = 8, WGM = 8;

__host__ __device__ __forceinline__ int lds_byte(int r, int c) { const int st = (r >> 4) * 2 + (c >> 5), rr = r & 15, cc = c & 31, ob = rr * 64 + cc * 2; return st * 1024 + (ob ^ (((ob >> 9) & 1) << 5)); }
__host__ __device__ __forceinline__ void stage_rc(int b, int& R, int& C) { const int st = b / 1024, sb = b % 1024, swz = sb ^ (((sb >> 9) & 1) << 5); R = (st >> 1) * 16 + swz / 64; C = (st & 1) * 32 + (swz % 64) / 2; }
__host__ __device__ __forceinline__ int perm32(int rho) { const int n = rho >> 4, i = rho & 15; return 8 * (i >> 2) + 4 * n + (i & 3); }

struct Unit { int pm, pn; };
struct Gemm { const bf16_t* A; const bf16_t* Bt; int M, N, K; };

struct StaticOrder {
    int nM, nN, nwg, G, c;
    __host__ __device__ void init(int M, int N, int G_, int c_) { nM = M / BM; nN = N / BM; nwg = nM * nN; G = G_; c = c_; }
    __host__ __device__ bool next(int i, Unit& u) const {
        const long L = (long)i * G + c; if (L >= nwg) return false;
        int wgid = (int)L; { const int q = nwg / NXCD, r = nwg % NXCD, xcd = wgid % NXCD, off = wgid / NXCD; wgid = (xcd < r ? xcd * (q + 1) : r * (q + 1) + (xcd - r) * q) + off; }
        const int nig = WGM * nN, gid = wgid / nig, fm = gid * WGM, gsz = (nM - fm) < WGM ? (nM - fm) : WGM;
        u.pm = fm + ((wgid % nig) % gsz); u.pn = (wgid % nig) / gsz; return true;
    }
    __device__ __forceinline__ void a_ready(const Unit&) const {}
    __device__ __forceinline__ void done(const Unit&) const {}
};

__device__ __forceinline__ unsigned cvt_pk_bf16(float lo, float hi) { unsigned r; asm volatile("v_cvt_pk_bf16_f32 %0, %1, %2" : "=v"(r) : "v"(lo), "v"(hi)); return r; }
typedef float f32x2 __attribute__((ext_vector_type(2)));
__device__ __forceinline__ f32x2 gelu_pk(f32x2 v) {
    const f32x2 av = __builtin_elementwise_abs(v), d = av * 0.2316418882f + 1.0f;
    f32x2 t; t.x = __builtin_amdgcn_rcpf(d.x); t.y = __builtin_amdgcn_rcpf(d.y);
    f32x2 q = t * 0.5307027145f + (-0.7265760135f); q = q * t + 0.7107068705f; q = q * t + (-0.142248368f); q = q * t + 0.127414796f; q = q * t;
    const f32x2 s = (v * v) * (-0.72134752044f);
    f32x2 e; e.x = __builtin_amdgcn_exp2f(s.x); e.y = __builtin_amdgcn_exp2f(s.y);
    const f32x2 m = v * (q * e), r = v - m;
    f32x2 o; o.x = v.x < 0.f ? m.x : r.x; o.y = v.y < 0.f ? m.y : r.y; return o;
}

template <int ACT  > struct EpiBf16 {
    static constexpr bool PERM = true, AFTER_DRAIN = false; static_assert(ACT == 0 || ACT == 1, "EpiBf16: ACT is 0 (none) or 1 (gelu_pk)");
    bf16_t* O; int ldc; const float* bias; int split_cols; size_t split_stride; float scale0;
    __device__ __forceinline__ void operator()(const f32x4 (&acc)[2][2][4][2], const Unit& u, int wr, int wc, int fr, int fq) const {
        const int row0 = u.pm * BM + wr * 64 + fr; int colt = u.pn * BM; bf16_t* base = O;
        float sc = 1.f; if (split_cols) { const int t = colt / split_cols; base += (size_t)t * split_stride; colt -= t * split_cols; if (t == 0) sc = scale0; }
        const int col0 = colt + wc * 32 + 8 * fq, bcol0 = u.pn * BM + wc * 32 + 8 * fq;
        f32x4 bv[2][2];
#pragma unroll
        for (int bj = 0; bj < 2; ++bj)
#pragma unroll
            for (int n = 0; n < 2; ++n) bv[bj][n] = bias ? *(const f32x4*)(bias + bcol0 + bj * HALF + 4 * n) : (f32x4){0.f, 0.f, 0.f, 0.f};
#pragma unroll
        for (int ai = 0; ai < 2; ++ai)
#pragma unroll
            for (int m = 0; m < 4; ++m) { bf16_t* rowp = base + (size_t)(row0 + ai * HALF + m * 16) * ldc + col0;
#pragma unroll
                for (int bj = 0; bj < 2; ++bj) { f32x4 v0 = acc[ai][bj][m][0] + bv[bj][0], v1 = acc[ai][bj][m][1] + bv[bj][1];
                    if (ACT == 1) { f32x2 a = gelu_pk((f32x2){v0[0], v0[1]}), b = gelu_pk((f32x2){v0[2], v0[3]}), c = gelu_pk((f32x2){v1[0], v1[1]}), d = gelu_pk((f32x2){v1[2], v1[3]});
                        v0 = (f32x4){a.x, a.y, b.x, b.y}; v1 = (f32x4){c.x, c.y, d.x, d.y}; }
                    v0 = v0 * sc; v1 = v1 * sc; u32x4 w; w.x = cvt_pk_bf16(v0[0], v0[1]); w.y = cvt_pk_bf16(v0[2], v0[3]); w.z = cvt_pk_bf16(v1[0], v1[1]); w.w = cvt_pk_bf16(v1[2], v1[3]);
                    *(u32x4*)(rowp + bj * HALF) = w; } }
    }
};
typedef int i32x4_t __attribute__((ext_vector_type(4))); typedef int i32x8_t __attribute__((ext_vector_type(8)));
__device__ __forceinline__ i32x8_t cat8(bf16x8 lo, bf16x8 hi) { return __builtin_shufflevector(__builtin_bit_cast(i32x4_t, lo), __builtin_bit_cast(i32x4_t, hi), 0, 1, 2, 3, 4, 5, 6, 7); }
template <class Epi, class Sched, bool ALIGN_EPI = false, bool SP2 = false, bool F8 = false>
__device__ __forceinline__ void gemm_phase(PG8_LAS unsigned char* lds, const Gemm g, const Sched& S, const Epi& E) {
    int tid_ = threadIdx.x; asm volatile("" : "+v"(tid_)); const int tid = tid_, wid = __builtin_amdgcn_readfirstlane(tid >> 6), lane = tid & 63, wr = wid >> 2, wc = wid & 3, fr = lane & 15, fq = lane >> 4;
    const int K = g.K, nt = K / BK;
    unsigned voffA, voffB;
    { int R, C; stage_rc(tid * 16, R, C); const int Rb = Epi::PERM ? ((R & ~31) + perm32(R & 31)) : R;
        voffA = (unsigned)(R * K + C) * 2u; voffB = (unsigned)(Rb * K + C) * 2u; }
    const size_t rstep = (size_t)64 * K * 2;
    const size_t kstep = (size_t)(BK * 2);
    const size_t hstep = (size_t)HALF * K * 2;
    const size_t tstep = 2 * hstep;
    const unsigned ldsw = (unsigned)wid * 1024u;
    const int aoff = lds_byte(wr * 64 + fr, fq * 8), boff = lds_byte(wc * 32 + fr, fq * 8);
#define PG8_SA(b, h) (((b) * 2 + (h)) * HTB)
#define PG8_SB(b, h) ((4 + (b) * 2 + (h)) * HTB)
#define PG8_STAGE(bufoff, gbase, voff) do { _Pragma("unroll") for (int _i = 0; _i < 2; ++_i) \
        __builtin_amdgcn_global_load_lds((const unsigned*)((const char*)(gbase) + _i * rstep + (voff)), (PG8_LAS unsigned*)(lds + (bufoff) + ldsw + _i * 8192), 16, 0, 0); } while (0)
#define PG8_LDA(dst, b, h) do { _Pragma("unroll") for (int m = 0; m < 4; ++m) _Pragma("unroll") for (int k = 0; k < 2; ++k) dst[m][k] = *(const PG8_LAS bf16x8*)(lds + PG8_SA(b, h) + aoff + m * 2048 + k * 1024); } while (0)
#define PG8_LDB(dst, b, h) do { _Pragma("unroll") for (int n = 0; n < 2; ++n) _Pragma("unroll") for (int k = 0; k < 2; ++k) dst[n][k] = *(const PG8_LAS bf16x8*)(lds + PG8_SB(b, h) + boff + n * 2048 + k * 1024); } while (0)
#define PG8_MMA(ai, bj, At, Bt) do { __builtin_amdgcn_s_setprio(1); _Pragma("unroll") for (int m = 0; m < 4; ++m) _Pragma("unroll") for (int n = 0; n < 2; ++n) { \
        if constexpr (F8) { acc[ai][bj][m][n] = __builtin_amdgcn_mfma_scale_f32_16x16x128_f8f6f4(cat8(Bt[n][0], Bt[n][1]), cat8(At[m][0], At[m][1]), acc[ai][bj][m][n], 0, 0, 0, 0, 0, 0); } \
        else { _Pragma("unroll") for (int k = 0; k < 2; ++k) acc[ai][bj][m][n] = __builtin_amdgcn_mfma_f32_16x16x32_bf16(Bt[n][k], At[m][k], acc[ai][bj][m][n], 0, 0, 0); } } __builtin_amdgcn_s_setprio(0); } while (0)
#define PG8_WAIT_V(n) asm volatile("s_waitcnt vmcnt(" #n ")" ::: "memory")
#define PG8_WAIT_L(n) asm volatile("s_waitcnt lgkmcnt(" #n ")" ::: "memory")
#define PG8_BAR __builtin_amdgcn_s_barrier()
#define PG8_SCHED __builtin_amdgcn_sched_barrier(0)
    Unit cur, nxt; int ui = 0;
    if (!S.next(0, cur)) return;
    f32x4 acc[2][2][4][2];
#pragma unroll
    for (int a = 0; a < 2; ++a)
#pragma unroll
        for (int b = 0; b < 2; ++b)
#pragma unroll
            for (int m = 0; m < 4; ++m)
#pragma unroll
                for (int n = 0; n < 2; ++n) acc[a][b][m][n] = (f32x4){0.f, 0.f, 0.f, 0.f};
    bf16x8 At[4][2], B0[2][2], B1[2][2];
    const char* cA = (const char*)g.A + (size_t)cur.pm * tstep; const char* cB = (const char*)g.Bt + (size_t)cur.pn * tstep;
    S.a_ready(cur);
    if constexpr (SP2) {
        PG8_STAGE(PG8_SB(0, 0), cB, voffB); PG8_STAGE(PG8_SB(0, 1), cB + hstep, voffB); PG8_STAGE(PG8_SA(0, 0), cA, voffA); PG8_STAGE(PG8_SA(0, 1), cA + hstep, voffA);
        if (wr == 1) PG8_BAR;
        PG8_WAIT_V(2); PG8_BAR;
        PG8_STAGE(PG8_SB(1, 0), cB + kstep, voffB); PG8_STAGE(PG8_SA(1, 0), cA + kstep, voffA); PG8_STAGE(PG8_SB(1, 1), cB + hstep + kstep, voffB);
        PG8_WAIT_V(6); PG8_BAR;
    } else {
        PG8_STAGE(PG8_SB(0, 0), cB, voffB); PG8_STAGE(PG8_SA(0, 0), cA, voffA); PG8_STAGE(PG8_SB(0, 1), cB + hstep, voffB); PG8_STAGE(PG8_SA(0, 1), cA + hstep, voffA);
        if (wr == 1) PG8_BAR;
        PG8_WAIT_V(4); PG8_BAR;
        PG8_STAGE(PG8_SB(1, 0), cB + kstep, voffB); PG8_STAGE(PG8_SA(1, 0), cA + kstep, voffA); PG8_STAGE(PG8_SB(1, 1), cB + hstep + kstep, voffB);
        PG8_WAIT_V(6); PG8_BAR;
    }
    for (;;) {
        const bool has_next = S.next(ui + 1, nxt);
        const char* nA = has_next ? (const char*)g.A + (size_t)nxt.pm * tstep : cA; const char* nB = has_next ? (const char*)g.Bt + (size_t)nxt.pn * tstep : cB;
#pragma unroll 1
        for (int t = 0; t < nt; t += 2) {
            const bool last = (t == nt - 2);
            const char* a1 = cA + (size_t)(t + 1) * kstep;
            const char* a2 = last ? nA : cA + (size_t)(t + 2) * kstep; const char* b2 = last ? nB : cB + (size_t)(t + 2) * kstep;
            const char* a3 = a2 + kstep; const char* b3 = b2 + kstep;
            if (last && has_next) S.a_ready(nxt);
            if constexpr (SP2) {
            PG8_LDB(B0, 0, 0); PG8_LDB(B1, 0, 1); PG8_SCHED; PG8_LDA(At, 0, 0); PG8_STAGE(PG8_SA(1, 1), a1 + hstep, voffA);
            PG8_WAIT_V(8); PG8_WAIT_L(0); PG8_BAR; PG8_MMA(0, 0, At, B0); PG8_MMA(0, 1, At, B1); PG8_BAR; PG8_SCHED;
            PG8_LDA(At, 0, 1); PG8_STAGE(PG8_SB(0, 0), b2, voffB); PG8_STAGE(PG8_SB(0, 1), b2 + hstep, voffB); PG8_STAGE(PG8_SA(0, 0), a2, voffA);
            PG8_WAIT_V(8); PG8_WAIT_L(0); PG8_BAR; PG8_MMA(1, 0, At, B0); PG8_MMA(1, 1, At, B1); PG8_BAR; PG8_SCHED;
            PG8_LDB(B0, 1, 0); PG8_LDB(B1, 1, 1); PG8_SCHED; PG8_LDA(At, 1, 0); PG8_STAGE(PG8_SA(0, 1), a2 + hstep, voffA);
            PG8_WAIT_V(8); PG8_WAIT_L(0); PG8_BAR; PG8_MMA(0, 0, At, B0); PG8_MMA(0, 1, At, B1); PG8_BAR; PG8_SCHED;
            PG8_LDA(At, 1, 1); PG8_STAGE(PG8_SB(1, 0), b3, voffB); PG8_STAGE(PG8_SB(1, 1), b3 + hstep, voffB); PG8_STAGE(PG8_SA(1, 0), a3, voffA);
            PG8_WAIT_V(8); PG8_WAIT_L(0); PG8_BAR; PG8_MMA(1, 0, At, B0); PG8_MMA(1, 1, At, B1); PG8_BAR; PG8_SCHED;
            } else {
            PG8_LDB(B0, 0, 0); PG8_SCHED; PG8_LDA(At, 0, 0); PG8_STAGE(PG8_SA(1, 1), a1 + hstep, voffA);
            PG8_WAIT_L(8); PG8_BAR; PG8_WAIT_L(0); PG8_MMA(0, 0, At, B0); PG8_BAR; PG8_SCHED;
            PG8_LDB(B1, 0, 1); PG8_STAGE(PG8_SB(0, 0), b2, voffB);
            PG8_BAR; PG8_WAIT_L(0); PG8_MMA(0, 1, At, B1); PG8_BAR;
            PG8_LDA(At, 0, 1); PG8_STAGE(PG8_SA(0, 0), a2, voffA);
            PG8_BAR; PG8_WAIT_L(0); PG8_MMA(1, 0, At, B0); PG8_BAR; PG8_SCHED;
            PG8_STAGE(PG8_SB(0, 1), b2 + hstep, voffB);
            PG8_WAIT_V(6); PG8_BAR; PG8_MMA(1, 1, At, B1); PG8_BAR;
            PG8_LDB(B0, 1, 0); PG8_SCHED; PG8_LDA(At, 1, 0); PG8_STAGE(PG8_SA(0, 1), a2 + hstep, voffA);
            PG8_WAIT_L(8); PG8_BAR; PG8_WAIT_L(0); PG8_MMA(0, 0, At, B0); PG8_BAR; PG8_SCHED;
            PG8_LDB(B1, 1, 1); PG8_STAGE(PG8_SB(1, 0), b3, voffB);
            PG8_BAR; PG8_WAIT_L(0); PG8_MMA(0, 1, At, B1); PG8_BAR;
            PG8_LDA(At, 1, 1); PG8_STAGE(PG8_SA(1, 0), a3, voffA);
            PG8_BAR; PG8_WAIT_L(0); PG8_MMA(1, 0, At, B0); PG8_BAR; PG8_SCHED;
            PG8_STAGE(PG8_SB(1, 1), b3 + hstep, voffB);
            PG8_WAIT_V(6); PG8_BAR; PG8_MMA(1, 1, At, B1); PG8_BAR;
            }
        }
        if constexpr (ALIGN_EPI) { if (wr == 0) PG8_BAR; }
        if constexpr (!Epi::AFTER_DRAIN) { int t2_ = threadIdx.x; asm volatile("" : "+v"(t2_)); E(acc, cur, wr, wc, t2_ & 15, (t2_ & 63) >> 4); S.done(cur); }
        if (!has_next) break;
#pragma unroll
        for (int a = 0; a < 2; ++a)
#pragma unroll
            for (int b = 0; b < 2; ++b)
#pragma unroll
                for (int m = 0; m < 4; ++m)
#pragma unroll
                    for (int n = 0; n < 2; ++n) acc[a][b][m][n] = (f32x4){0.f, 0.f, 0.f, 0.f};
        cur = nxt; cA = nA; cB = nB; ++ui;
        if constexpr (ALIGN_EPI) { if (wr == 1) PG8_BAR; }
    }
    PG8_WAIT_V(0);
    if constexpr (!ALIGN_EPI) { if (wr == 0) PG8_BAR; }
    PG8_BAR;
    if constexpr (Epi::AFTER_DRAIN) { E.fused(acc, cur, wr, wc, fr, fq, lds, wid, lane); S.done(cur); }
#undef PG8_SA
#undef PG8_SB
#undef PG8_STAGE
#undef PG8_LDA
#undef PG8_LDB
#undef PG8_MMA
#undef PG8_WAIT_V
#undef PG8_WAIT_L
#undef PG8_BAR
#undef PG8_SCHED
}
}

#define DI __device__ __forceinline__
#define LAS __attribute__((address_space(3)))
typedef unsigned short bf16;
typedef short bf16x8 __attribute__((ext_vector_type(8)));
typedef short s16x4 __attribute__((ext_vector_type(4)));
typedef float f32x4 __attribute__((ext_vector_type(4)));
typedef float f32x2 __attribute__((ext_vector_type(2)));
typedef float f32x16 __attribute__((ext_vector_type(16)));
typedef unsigned u32x4 __attribute__((ext_vector_type(4)));
typedef unsigned u32x2 __attribute__((ext_vector_type(2)));
typedef __bf16 bf16x2_t __attribute__((ext_vector_type(2)));
typedef _Float16 f16x4 __attribute__((ext_vector_type(4)));
typedef _Float16 f16x8 __attribute__((ext_vector_type(8)));
typedef LAS unsigned char lds_u8;

constexpr int NWAVES = 8, NTHREADS = 512;
constexpr int BATCH = 8, SEQ = 4096, D = 1024, DEPTH = 4, M = BATCH * SEQ;
constexpr int HD = 64, FF = 2816, INW = 2816, GUW = 2 * FF;
constexpr float ALPHA = 1.681792830507429f;
constexpr float LN_EPS = 1e-5f, GN_EPS = 1e-6f;
constexpr float LOG2E = 1.4426950408889634f;
constexpr float QSCALE = 0.125f * LOG2E;

constexpr size_t MiB = 1u << 20;
constexpr size_t WS_STAT0 = 3 * MiB + 256 * 1024, WS_ONES = 3 * MiB + 512 * 1024;
constexpr size_t WS_STAT = 3 * MiB;
constexpr size_t WS_TAB = 1 * MiB;
constexpr size_t WS_WGU1 = 4 * MiB, WS_WD1 = 16 * MiB, WS_WGU2 = 22 * MiB, WS_WD2 = 34 * MiB, WS_WIN = 40 * MiB, WS_WOUT = 46 * MiB;
constexpr size_t WS_XB = 48 * MiB;
constexpr size_t WS_HB = 112 * MiB;
constexpr size_t WS_YM = 288 * MiB;
constexpr size_t WS_Y = 352 * MiB;
constexpr size_t WS_WSET = 412 * MiB;
constexpr size_t WS_END = 460 * MiB;
constexpr int LDS_BYTES = 147456;

DI unsigned cvtpk(float lo, float hi) { f32x2 v = {lo, hi}; bf16x2_t b = __builtin_convertvector(v, bf16x2_t); return __builtin_bit_cast(unsigned, b); }
DI float bf2f(unsigned short b) { return __uint_as_float((unsigned)b << 16); }
DI float fast_exp2(float x) { return __builtin_amdgcn_exp2f(x); }
DI float fast_rcp(float x) { return __builtin_amdgcn_rcpf(x); }
DI unsigned pk4_fp8(float a, float b, float c, float d) {
    a = __builtin_amdgcn_fmed3f(a, -448.f, 448.f); b = __builtin_amdgcn_fmed3f(b, -448.f, 448.f); c = __builtin_amdgcn_fmed3f(c, -448.f, 448.f); d = __builtin_amdgcn_fmed3f(d, -448.f, 448.f);
    const unsigned lo = (unsigned)__builtin_amdgcn_cvt_pk_fp8_f32(a, b, 0, false), hi = (unsigned)__builtin_amdgcn_cvt_pk_fp8_f32(c, d, 0, false);
    return (lo & 0xffffu) | (hi << 16);
}
constexpr float WGU_SCALE = 64.f, WD_SCALE = 128.f, H_SCALE = 8.f;
DI float q8(float v) {
    const float a = fabsf(v);
    if (a >= 448.f) return copysignf(448.f, v);
    if (a < 0.015625f) return rintf(v * 512.f) * (1.f / 512.f);
    unsigned u = __float_as_uint(v); u += 0x7FFFFu + ((u >> 20) & 1u); u &= 0xFFF00000u; return __uint_as_float(u);
}
#ifdef EMU_FP8
#define Q8S(v, s) (q8((v) * (s)) * (1.0f / (s)))
#else
#define Q8S(v, s) (v)
#endif
DI float silu_f(float a) { return a * fast_rcp(1.0f + fast_exp2(-a * LOG2E)); }
DI float shx(float v, int mask, int lane) { return __builtin_bit_cast(float, __builtin_amdgcn_ds_bpermute(((lane ^ mask) & 63) << 2, __builtin_bit_cast(int, v))); }
DI float wave_sum(float v, int lane) {
#pragma unroll
    for (int o = 1; o < 64; o <<= 1) v += shx(v, o, lane);
    return v;
}
DI int opaque_tid() { int t = threadIdx.x; asm volatile("" : "+v"(t)); return t; }
DI int crow(int r, int hi) { return (r & 3) + 8 * (r >> 2) + 4 * hi; }
#define MFMA32(a, b, c) __builtin_amdgcn_mfma_f32_32x32x16_bf16((a), (b), (c), 0, 0, 0)

namespace pg8 {
struct EpiSwiGLU {
    static constexpr bool PERM = true, AFTER_DRAIN = false;
    bf16_t* H;
    __device__ __forceinline__ void operator()(const f32x4 (&acc)[2][2][4][2], const Unit& u, int wr, int wc, int fr, int fq) const {
        const int row0 = u.pm * BM + wr * 64 + fr, col0 = u.pn * 128 + wc * 32 + 8 * fq;
#pragma unroll
        for (int ai = 0; ai < 2; ++ai)
#pragma unroll
            for (int m = 0; m < 4; ++m) {
                bf16_t* rowp = H + (size_t)(row0 + ai * HALF + m * 16) * FF + col0;
                float h[8];
#pragma unroll
                for (int n = 0; n < 2; ++n)
#pragma unroll
                    for (int j = 0; j < 4; ++j) h[n * 4 + j] = Q8S(silu_f(acc[ai][0][m][n][j]) * acc[ai][1][m][n][j], 8.0f);
                u32x4 w; w.x = cvtpk(h[0], h[1]); w.y = cvtpk(h[2], h[3]); w.z = cvtpk(h[4], h[5]); w.w = cvtpk(h[6], h[7]);
                *(u32x4*)rowp = w;
            }
    }
};
struct EpiSwiGLU8 {
    static constexpr bool PERM = true, AFTER_DRAIN = false;
    unsigned char* H;
    __device__ __forceinline__ void operator()(const f32x4 (&acc)[2][2][4][2], const Unit& u, int wr, int wc, int fr, int fq) const {
        const int row0 = u.pm * BM + wr * 64 + fr, col0 = u.pn * 128 + wc * 32 + 8 * fq;
        constexpr float c1 = -LOG2E / WGU_SCALE, c2 = H_SCALE / (WGU_SCALE * WGU_SCALE);
#pragma unroll
        for (int ai = 0; ai < 2; ++ai)
#pragma unroll
            for (int m = 0; m < 4; ++m) {
                unsigned char* rowp = H + (size_t)(row0 + ai * HALF + m * 16) * FF + col0;
                u32x2 w;
#pragma unroll
                for (int n = 0; n < 2; ++n) {
                    const f32x4 g = acc[ai][0][m][n], uu = acc[ai][1][m][n];
                    const f32x4 t = g * c1;
                    f32x4 d = {fast_exp2(t[0]), fast_exp2(t[1]), fast_exp2(t[2]), fast_exp2(t[3])};
                    d = d + 1.0f;
                    const f32x4 r = {fast_rcp(d[0]), fast_rcp(d[1]), fast_rcp(d[2]), fast_rcp(d[3])};
                    const f32x4 h = ((g * c2) * uu) * r;
                    const unsigned pk = pk4_fp8(h[0], h[1], h[2], h[3]);
                    if (n == 0) w.x = pk; else w.y = pk;
                }
                *(u32x2*)rowp = w;
            }
    }
};
struct EpiResid {
    static constexpr bool PERM = true, AFTER_DRAIN = false;
    _Float16* Y; float s; const f32x2* stats; const float* g; const float* b;
    __device__ __forceinline__ void operator()(const f32x4 (&acc)[2][2][4][2], const Unit& u, int wr, int wc, int fr, int fq) const {
        const int col0 = u.pn * BM + wc * 32 + 8 * fq, row0 = u.pm * BM + wr * 64 + fr;
        f32x2 st[2][4];
#pragma unroll
        for (int ai = 0; ai < 2; ++ai)
#pragma unroll
            for (int m = 0; m < 4; ++m) st[ai][m] = stats[row0 + ai * HALF + m * 16];
#pragma unroll
        for (int bj = 0; bj < 2; ++bj) {
            f32x4 ga[2], ab[2];
#pragma unroll
            for (int n = 0; n < 2; ++n) { ga[n] = *(const f32x4*)(g + col0 + bj * HALF + 4 * n) * ALPHA; ab[n] = *(const f32x4*)(b + col0 + bj * HALF + 4 * n) * ALPHA; }
#pragma unroll
            for (int ai = 0; ai < 2; ++ai)
#pragma unroll
                for (int m = 0; m < 4; ++m) {
                    _Float16* p = Y + (size_t)(row0 + ai * HALF + m * 16) * D + col0 + bj * HALF;
                    const f16x8 xh = *(const f16x8*)p;
                    f16x8 oh;
#pragma unroll
                    for (int n = 0; n < 2; ++n) {
                        const f32x4 xv = {(float)xh[4 * n], (float)xh[4 * n + 1], (float)xh[4 * n + 2], (float)xh[4 * n + 3]};
                        const f32x4 y = (xv - st[ai][m].x) * (ga[n] * st[ai][m].y) + (ab[n] + acc[ai][bj][m][n] * s);
                        oh[4 * n] = (_Float16)y[0]; oh[4 * n + 1] = (_Float16)y[1]; oh[4 * n + 2] = (_Float16)y[2]; oh[4 * n + 3] = (_Float16)y[3];
                    }
                    *(f16x8*)p = oh;
                }
        }
    }
};
struct EpiInProj {
    static constexpr bool PERM = true, AFTER_DRAIN = false;
    bf16_t* O; const float* tab;
    __device__ __forceinline__ void operator()(const f32x4 (&acc)[2][2][4][2], const Unit& u, int wr, int wc, int fr, int fq) const {
        const int pn = u.pn;
        int mode;
        float sc = 1.f;
        if (pn < 2) { mode = 1; sc = QSCALE; } else if (pn == 2) { mode = (wc < 2) ? 1 : 0; } else if (pn < 5) { mode = 2; } else if (pn < 7) { mode = 2; sc = 0.125f; } else if (pn < 9) { mode = 0; } else { mode = 3; }
        const int row0 = u.pm * BM + wr * 64 + fr, col0 = pn * 256 + wc * 64 + 8 * fq;
        const float* rc = tab; const float* rs = tab + SEQ * 32; const float* tc = tab + 2 * SEQ * 32; const float* ts = tab + 3 * SEQ * 32;
#pragma unroll
        for (int ai = 0; ai < 2; ++ai)
#pragma unroll
            for (int m = 0; m < 4; ++m) {
                const int row = row0 + ai * HALF + m * 16, pos = row & (SEQ - 1);
                bf16_t* rowp = O + (size_t)row * INW + col0;
                float o[2][8];
                if (mode == 1) {
#pragma unroll
                    for (int n = 0; n < 2; ++n) {
                        const f32x4 c = *(const f32x4*)(rc + pos * 32 + 8 * fq + 4 * n), s = *(const f32x4*)(rs + pos * 32 + 8 * fq + 4 * n);
#pragma unroll
                        for (int j = 0; j < 4; ++j) { const float x1 = acc[ai][0][m][n][j], x2 = acc[ai][1][m][n][j];
                            o[0][n * 4 + j] = (x1 * c[j] - x2 * s[j]) * sc; o[1][n * 4 + j] = (x2 * c[j] + x1 * s[j]) * sc; }
                    }
                } else if (mode == 2) {
#pragma unroll
                    for (int bj = 0; bj < 2; ++bj)
#pragma unroll
                        for (int n = 0; n < 2; ++n) {
                            const f32x2 c = *(const f32x2*)(tc + pos * 32 + bj * 16 + 4 * fq + 2 * n), s = *(const f32x2*)(ts + pos * 32 + bj * 16 + 4 * fq + 2 * n);
#pragma unroll
                            for (int p = 0; p < 2; ++p) { const float xe = acc[ai][bj][m][n][2 * p], xo = acc[ai][bj][m][n][2 * p + 1];
                                o[bj][n * 4 + 2 * p] = (xe * c[p] - xo * s[p]) * sc; o[bj][n * 4 + 2 * p + 1] = (xo * c[p] + xe * s[p]) * sc; }
                        }
                } else {
#pragma unroll
                    for (int bj = 0; bj < 2; ++bj)
#pragma unroll
                        for (int n = 0; n < 2; ++n)
#pragma unroll
                            for (int j = 0; j < 4; ++j) { const float v = acc[ai][bj][m][n][j]; o[bj][n * 4 + j] = (mode == 3) ? silu_f(v) : v; }
                }
#pragma unroll
                for (int bj = 0; bj < 2; ++bj) {
                    u32x4 w; w.x = cvtpk(o[bj][0], o[bj][1]); w.y = cvtpk(o[bj][2], o[bj][3]); w.z = cvtpk(o[bj][4], o[bj][5]); w.w = cvtpk(o[bj][6], o[bj][7]);
                    *(u32x4*)(rowp + bj * 32) = w;
                }
            }
    }
};
}

struct Args {
    const float* x; const float* w_in; const float* w_out; const float* sinks;
    const float* w_gu1; const float* w_d1; const float* w_gu2; const float* w_d2;
    const float* ln_g0; const float* ln_g1; const float* ln_g2; const float* ln_b0; const float* ln_b1; const float* ln_b2;
    float* out; unsigned char* ws; int ph_lo, ph_hi;
};

DI void transpose_item(const float* W, int K, int Nsrc, int srcbase, void* WT, int n0, int k0, LAS float* scr, int lane, float f8s) {
    float wv[32];
#pragma unroll
    for (int i = 0; i < 32; ++i) wv[i] = W[(size_t)(k0 + 2 * i + (lane >> 5)) * Nsrc + srcbase + (lane & 31)];
#pragma unroll
    for (int i = 0; i < 32; ++i) scr[(2 * i + (lane >> 5)) * 33 + (lane & 31)] = wv[i];
    asm volatile("s_waitcnt lgkmcnt(0)" ::: "memory");
    const int c = lane & 7;
#pragma unroll
    for (int j = 0; j < 4; ++j) { const int n = (lane >> 3) + 8 * j; const LAS float* s = scr + (8 * c) * 33 + n;
        if (f8s == 0.f) {
            u32x4 o; o.x = cvtpk(s[0 * 33], s[1 * 33]); o.y = cvtpk(s[2 * 33], s[3 * 33]); o.z = cvtpk(s[4 * 33], s[5 * 33]); o.w = cvtpk(s[6 * 33], s[7 * 33]);
            *(u32x4*)((bf16*)WT + (size_t)(n0 + n) * K + k0 + 8 * c) = o;
        } else {
            u32x2 o; o.x = pk4_fp8(s[0 * 33] * f8s, s[1 * 33] * f8s, s[2 * 33] * f8s, s[3 * 33] * f8s); o.y = pk4_fp8(s[4 * 33] * f8s, s[5 * 33] * f8s, s[6 * 33] * f8s, s[7 * 33] * f8s);
            *(u32x2*)((unsigned char*)WT + (size_t)(n0 + n) * K + k0 + 8 * c) = o;
        } }
    asm volatile("s_waitcnt lgkmcnt(0)" ::: "memory");
}
DI int src_col(int which, int n0) {
    if (which == 0) { const int pn = n0 >> 8, c = n0 & 255; return (c >> 7) * FF + pn * 128 + (c & 127); }
    if (which == 2) { const int pn = n0 >> 8, c = n0 & 255; return pn * 256 + ((c & 127) >> 5) * 64 + (c >> 7) * 32 + (c & 31); }
    return n0;
}
DI void convert_matrix_items(const float* W, int K, int N, int which, void* WT, LAS float* scr, int lane, int first, int gw, int NGW) {
    const int nblk = N / 32, nitems = (K / 64) * nblk;
    int it = gw - (first % NGW); if (it < 0) it += NGW;
    for (; it < nitems; it += NGW) { const int kb = it / nblk, nb = it % nblk; transpose_item(W, K, N, src_col(which, nb * 32), WT, nb * 32, kb * 64, scr, lane, which == 0 ? WGU_SCALE : (which == 3 ? WD_SCALE : 0.f)); }
}
typedef const Args __attribute__((address_space(4))) CArgs;
DI void convert_layer_weights(const CArgs& a, int l, unsigned char* ws0, LAS unsigned char* lds, int wave, int lane, int gw, int NGW, int mask) {
    LAS float* scr = (LAS float*)(lds + wave * 16384);
    unsigned char* ws = ws0 + ((l & 1) ? WS_WSET : 0);
    constexpr int I_GU = (D / 64) * (GUW / 32), I_D = (FF / 64) * (D / 32), I_IN = (D / 64) * (INW / 32), I_OUT = (D / 64) * (D / 32);
    int first = 0;
    if (mask & 1) convert_matrix_items(a.w_gu1 + (size_t)l * D * GUW, D, GUW, 0, (bf16*)(ws + WS_WGU1), scr, lane, first, gw, NGW); first += I_GU;
    if (mask & 2) convert_matrix_items(a.w_d1 + (size_t)l * FF * D, FF, D, 3, (bf16*)(ws + WS_WD1), scr, lane, first, gw, NGW); first += I_D;
    if (mask & 4) convert_matrix_items(a.w_in + (size_t)l * D * INW, D, INW, 2, (bf16*)(ws + WS_WIN), scr, lane, first, gw, NGW); first += I_IN;
    if (mask & 8) convert_matrix_items(a.w_out + (size_t)l * D * D, D, D, 1, (bf16*)(ws + WS_WOUT), scr, lane, first, gw, NGW); first += I_OUT;
    if (mask & 16) convert_matrix_items(a.w_gu2 + (size_t)l * D * GUW, D, GUW, 0, (bf16*)(ws + WS_WGU2), scr, lane, first, gw, NGW); first += I_GU;
    if (mask & 32) convert_matrix_items(a.w_d2 + (size_t)l * FF * D, FF, D, 3, (bf16*)(ws + WS_WD2), scr, lane, first, gw, NGW);
}
DI void sincos_d(double x, float& c, float& s) {
    const double TWO_PI = 6.283185307179586476925;
    const double k = __builtin_rint(x / TWO_PI), r = x - k * TWO_PI, r2 = r * r;
    double sn = r, cs = 1.0, tsn = r, tcs = 1.0;
#pragma unroll 1
    for (int i = 1; i <= 15; ++i) { tcs *= -r2 / (double)((2 * i - 1) * (2 * i)); cs += tcs; tsn *= -r2 / (double)((2 * i) * (2 * i + 1)); sn += tsn; }
    c = (float)cs; s = (float)sn;
}
DI void build_tables(float* tab, int gtid, int nthreads) {
    for (int e = gtid; e < 2 * SEQ * 32; e += nthreads) {
        const int which = e / (SEQ * 32), r = e % (SEQ * 32), pos = r >> 5, i = r & 31;
        const double base = which == 0 ? 0.7498942093324558 : 0.7429639507594947;
        double f = 1.0;
#pragma unroll 1
        for (int k = 0; k < i; ++k) f *= base;
        float c, s; sincos_d((double)pos * f, c, s);
        tab[(size_t)(2 * which) * SEQ * 32 + r] = c; tab[(size_t)(2 * which + 1) * SEQ * 32 + r] = s;
    }
}
DI void row_to_fp8_f16(const float* xrow, unsigned char* orow, _Float16* hrow, int lane) {
    const f32x4* xr = (const f32x4*)xrow + lane; unsigned* o4 = (unsigned*)orow + lane; f16x4* h4 = (f16x4*)hrow + lane;
#pragma unroll
    for (int j = 0; j < 4; ++j) { const f32x4 v = xr[64 * j]; o4[64 * j] = pk4_fp8(v[0], v[1], v[2], v[3]); h4[64 * j] = (f16x4){(_Float16)v[0], (_Float16)v[1], (_Float16)v[2], (_Float16)v[3]}; }
}
template <int NR> DI void ln_rows(const _Float16* Y, float* Xo, void* XBv, f32x2* stat, const float* g, const float* b, int lane, bool quant, bool write_x, int m0, int mstep) {
    f32x4 v[NR][4]; float s[NR], s2[NR];
    {   f16x8 h[NR][2];
#pragma unroll
        for (int r = 0; r < NR; ++r) { const f16x8* yr = (const f16x8*)(Y + (size_t)(m0 + r * mstep) * D) + lane; h[r][0] = yr[0]; h[r][1] = yr[64]; }
#pragma unroll
        for (int r = 0; r < NR; ++r)
#pragma unroll
            for (int c = 0; c < 2; ++c)
#pragma unroll
                for (int q = 0; q < 2; ++q) v[r][2 * c + q] = (f32x4){(float)h[r][c][4 * q], (float)h[r][c][4 * q + 1], (float)h[r][c][4 * q + 2], (float)h[r][c][4 * q + 3]};
    }
#pragma unroll
    for (int r = 0; r < NR; ++r) { s[r] = 0.f;
#pragma unroll
        for (int j = 0; j < 4; ++j) s[r] += (v[r][j][0] + v[r][j][1]) + (v[r][j][2] + v[r][j][3]); }
#pragma unroll
    for (int o = 1; o < 64; o <<= 1)
#pragma unroll
        for (int r = 0; r < NR; ++r) s[r] += shx(s[r], o, lane);
#pragma unroll
    for (int r = 0; r < NR; ++r) { const float mean = s[r] * (1.f / D); s[r] = mean; s2[r] = 0.f;
#pragma unroll
        for (int j = 0; j < 4; ++j) { v[r][j] = v[r][j] - mean; s2[r] += (v[r][j][0] * v[r][j][0] + v[r][j][1] * v[r][j][1]) + (v[r][j][2] * v[r][j][2] + v[r][j][3] * v[r][j][3]); } }
#pragma unroll
    for (int o = 1; o < 64; o <<= 1)
#pragma unroll
        for (int r = 0; r < NR; ++r) s2[r] += shx(s2[r], o, lane);
#pragma unroll
    for (int c = 0; c < 2; ++c) {
        const int e0 = c * 512 + 8 * lane;
        const f32x4 g0 = *(const f32x4*)(g + e0), g1 = *(const f32x4*)(g + e0 + 4), b0 = *(const f32x4*)(b + e0), b1 = *(const f32x4*)(b + e0 + 4);
#pragma unroll
        for (int r = 0; r < NR; ++r) {
            const int m = m0 + r * mstep;
            const float rstd = 1.f / sqrtf(s2[r] * (1.f / D) + LN_EPS);
            if (c == 0 && lane == 0) stat[m] = (f32x2){s[r], rstd};
            const f32x4 o0 = v[r][2 * c] * rstd * g0 + b0, o1 = v[r][2 * c + 1] * rstd * g1 + b1;
            if (write_x) { float* xo = Xo + (size_t)m * D + e0; *(f32x4*)xo = o0; *(f32x4*)(xo + 4) = o1; }
            if (quant) { u32x2 w; w.x = pk4_fp8(o0[0], o0[1], o0[2], o0[3]); w.y = pk4_fp8(o1[0], o1[1], o1[2], o1[3]); *(u32x2*)((unsigned char*)XBv + (size_t)m * D + e0) = w; }
            else { u32x4 w; w.x = cvtpk(o0[0], o0[1]); w.y = cvtpk(o0[2], o0[3]); w.z = cvtpk(o1[0], o1[1]); w.w = cvtpk(o1[2], o1[3]); *(u32x4*)((bf16*)XBv + (size_t)m * D + e0) = w; }
        }
    }
}

constexpr int A_KS = 0, A_KSTR = 72 * 2;
constexpr int A_VT = 256 * A_KSTR, A_VSTR = 264 * 2;
constexpr int A_STG = A_VT + 64 * A_VSTR, STG_STR = 72 * 2, STG_BYTES = 32 * STG_STR;
static_assert(A_STG + 8 * STG_BYTES <= 131072, "attention LDS");

DI void stage_out_store(lds_u8* stg, const f32x16 (&o)[2], int r32, int hi) {
#pragma unroll
    for (int db = 0; db < 2; ++db)
#pragma unroll
        for (int rg = 0; rg < 4; ++rg) {
            u32x2 w; w.x = cvtpk(o[db][4 * rg], o[db][4 * rg + 1]); w.y = cvtpk(o[db][4 * rg + 2], o[db][4 * rg + 3]);
            *(LAS u32x2*)(stg + r32 * STG_STR + (db * 32 + 8 * rg + 4 * hi) * 2) = w;
        }
}

DI void attn_unit(lds_u8* lds, const bf16* HM, bf16* YM, const float* sinks, int b, int g, int n) {
    const int tid = opaque_tid(), lane = tid & 63, r32 = lane & 31, hi = lane >> 5, wid = __builtin_amdgcn_readfirstlane(tid >> 6);
    const long keyrow0 = (long)b * SEQ + n * 128 - 128;
    {
        const int token = tid & 255; const bool valid = (n > 0) || (token >= 128);
        const bf16* src = HM + (keyrow0 + token) * INW + 512 + g * 64;
        u32x4 kv[4];
#pragma unroll
        for (int i = 0; i < 4; ++i) { kv[i] = (u32x4){0u, 0u, 0u, 0u}; if (valid) kv[i] = *(const u32x4*)(src + ((tid >> 8) + 2 * i) * 8); }
        const int q4 = (tid & 63) * 4, dcv = tid >> 6; const bool vvalid = (n > 0) || (q4 >= 128);
        u32x4 vr[4];
#pragma unroll
        for (int t = 0; t < 4; ++t) { vr[t] = (u32x4){0u, 0u, 0u, 0u}; if (vvalid) vr[t] = *(const u32x4*)(HM + (keyrow0 + q4 + t) * INW + 640 + g * 64 + dcv * 8); }
#pragma unroll
        for (int i = 0; i < 4; ++i) *(LAS u32x4*)(lds + A_KS + token * A_KSTR + ((tid >> 8) + 2 * i) * 16) = kv[i];
        const bf16x8 v0 = __builtin_bit_cast(bf16x8, vr[0]), v1 = __builtin_bit_cast(bf16x8, vr[1]), v2 = __builtin_bit_cast(bf16x8, vr[2]), v3 = __builtin_bit_cast(bf16x8, vr[3]);
#pragma unroll
        for (int ii = 0; ii < 8; ++ii) *(LAS s16x4*)(lds + A_VT + (dcv * 8 + ii) * A_VSTR + q4 * 2) = (s16x4){v0[ii], v1[ii], v2[ii], v3[ii]};
    }
    __syncthreads();
    const int hq = g * 4 + (wid >> 1);
    const float sink2 = sinks[hq] * LOG2E;
    lds_u8* stg = lds + A_STG + wid * STG_BYTES;
    const int jmin = (n == 0) ? 128 : 0;
    bf16x8 qfa[2][4];
#pragma unroll
    for (int qb = 0; qb < 2; ++qb)
#pragma unroll
        for (int ks = 0; ks < 4; ++ks) qfa[qb][ks] = *(const bf16x8*)(HM + ((long)b * SEQ + n * 128 + (wid & 1) * 64 + qb * 32 + r32) * INW + hq * 64 + ks * 16 + hi * 8);
#pragma unroll
    for (int qb = 0; qb < 2; ++qb) {
        const int i0 = (wid & 1) * 64 + qb * 32, iq = i0 + r32;
        bf16x8 qf[4];
#pragma unroll
        for (int ks = 0; ks < 4; ++ks) qf[ks] = qfa[qb][ks];
        float mrun = sink2, lrun = (hi == 0) ? 1.f : 0.f;
        f32x16 o[2];
#pragma unroll
        for (int r = 0; r < 16; ++r) { o[0][r] = 0.f; o[1][r] = 0.f; }
#pragma unroll 1
        for (int t = 0; t < 5; ++t) {
            const int kb = i0 + 32 * t;
            f32x16 s;
#pragma unroll
            for (int r = 0; r < 16; ++r) s[r] = 0.f;
#pragma unroll
            for (int ks = 0; ks < 4; ++ks) {
                const bf16x8 kf = *(const LAS bf16x8*)(lds + A_KS + (kb + r32) * A_KSTR + (ks * 16 + hi * 8) * 2);
                s = MFMA32(kf, qf[ks], s);
            }
            float tmax = -INFINITY;
            if (t == 0 || t == 4 || n == 0) {
#pragma unroll
                for (int r = 0; r < 16; ++r) { const int jj = kb + crow(r, hi); const bool vis = (jj > iq) && (jj <= iq + 128) && (jj >= jmin); s[r] = vis ? s[r] : -INFINITY; tmax = fmaxf(tmax, s[r]); }
            } else {
#pragma unroll
                for (int r = 0; r < 16; ++r) tmax = fmaxf(tmax, s[r]);
            }
            tmax = fmaxf(tmax, shx(tmax, 32, lane));
            const float mnew = fmaxf(mrun, tmax), scl = fast_exp2(mrun - mnew);
            mrun = mnew;
            float psum = 0.f;
#pragma unroll
            for (int r = 0; r < 16; ++r) { s[r] = fast_exp2(s[r] - mnew); psum += s[r]; }
            lrun = lrun * scl + psum;
#pragma unroll
            for (int r = 0; r < 16; ++r) { o[0][r] *= scl; o[1][r] *= scl; }
#pragma unroll
            for (int gk = 0; gk < 2; ++gk) {
                u32x4 pw; pw.x = cvtpk(s[8 * gk], s[8 * gk + 1]); pw.y = cvtpk(s[8 * gk + 2], s[8 * gk + 3]); pw.z = cvtpk(s[8 * gk + 4], s[8 * gk + 5]); pw.w = cvtpk(s[8 * gk + 6], s[8 * gk + 7]);
                const bf16x8 pf = __builtin_bit_cast(bf16x8, pw);
#pragma unroll
                for (int db = 0; db < 2; ++db) {
                    const lds_u8* vp = lds + A_VT + (db * 32 + r32) * A_VSTR + (kb + 16 * gk + 4 * hi) * 2;
                    const s16x4 lo = *(const LAS s16x4*)vp, hi4 = *(const LAS s16x4*)(vp + 16);
                    const bf16x8 vf = __builtin_shufflevector(lo, hi4, 0, 1, 2, 3, 4, 5, 6, 7);
                    o[db] = MFMA32(vf, pf, o[db]);
                }
            }
        }
        const float ltot = lrun + shx(lrun, 32, lane), inv = 1.0f / ltot;
#pragma unroll
        for (int r = 0; r < 16; ++r) { o[0][r] *= inv; o[1][r] *= inv; }
        stage_out_store(stg, o, r32, hi);
        asm volatile("s_waitcnt lgkmcnt(0)" ::: "memory");
        bf16* yw = YM + ((long)b * SEQ + n * 128 + i0) * D + hq * 64;
#pragma unroll
        for (int it = 0; it < 4; ++it) { const int row = it * 8 + (lane >> 3), ch = lane & 7;
            const u32x4 v = *(const LAS u32x4*)(stg + row * STG_STR + ch * 16); *(u32x4*)(yw + (long)row * D + ch * 8) = v; }
        asm volatile("s_waitcnt lgkmcnt(0)" ::: "memory");
    }
    __syncthreads();
}

constexpr int R_QS = 0, R_KS = 128 * 144, R_VT = 2 * 128 * 144, R_TSTR = 136 * 2, R_KT = R_VT + 64 * R_TSTR, R_ST = R_KT + 64 * R_TSTR, R_STG = R_ST + 64 * 144;
static_assert(R_STG + 4 * STG_BYTES <= 131072, "retention LDS");

DI void ret_unit(lds_u8* lds, const bf16* HM, bf16* YM, int b, int h, int seg) {
    const int tid = opaque_tid(), lane = tid & 63, r32 = lane & 31, hi = lane >> 5, wid = __builtin_amdgcn_readfirstlane(tid >> 6);
    float lg2;
    { int hh_ = h; asm volatile("" : "+s"(hh_)); const double x = __builtin_ldexp(1.0, -5 - hh_); double t = x, s = 0.0;
#pragma unroll 1
      for (int k = 1; k <= 10; ++k) { s -= t / (double)k; t *= x; }
      lg2 = (float)(s * 1.4426950408889634); }
    const float gchunk = fast_exp2(128.f * lg2);
    const int q4 = (tid & 31) * 4, dcs = (tid >> 5) & 7; const bool grpA = (wid < 4);
    float wk[4];
#pragma unroll
    for (int t = 0; t < 4; ++t) wk[t] = fast_exp2((float)(127 - (q4 + t)) * lg2);
    const long row0 = (long)b * SEQ;
    const int nfull0 = 8 * seg, nend = nfull0 + 8;
    for (int i = tid; i < 64 * 144 / 4; i += NTHREADS) *(LAS unsigned*)(lds + R_ST + i * 4) = 0u;
    f32x16 st;
#pragma unroll
    for (int r = 0; r < 16; ++r) st[r] = 0.f;
    u32x4 pa[4], pb[4];
#pragma unroll
    for (int t = 0; t < 4; ++t) pb[t] = (u32x4){0u, 0u, 0u, 0u};
    { const bf16* src = HM + (row0 + q4) * INW + h * 64 + dcs * 8;
#pragma unroll
      for (int t = 0; t < 4; ++t) { pa[t] = *(const u32x4*)(src + (size_t)t * INW + (grpA ? 1280 : 1792)); if (!grpA && nfull0 == 0) pb[t] = *(const u32x4*)(src + (size_t)t * INW + 768); } }
#pragma unroll 1
    for (int n = 0; n < nend; ++n) {
        const bool full = (n >= nfull0);
        {
            const bf16x8 a0 = __builtin_bit_cast(bf16x8, pa[0]), a1 = __builtin_bit_cast(bf16x8, pa[1]), a2 = __builtin_bit_cast(bf16x8, pa[2]), a3 = __builtin_bit_cast(bf16x8, pa[3]);
            if (grpA) {
                if (full) {
#pragma unroll
                    for (int t = 0; t < 4; ++t) *(LAS u32x4*)(lds + R_KS + (q4 + t) * 144 + dcs * 16) = pa[t];
                }
#pragma unroll
                for (int ii = 0; ii < 8; ++ii) {
                    u32x2 w; w.x = cvtpk(bf2f((unsigned short)a0[ii]) * wk[0], bf2f((unsigned short)a1[ii]) * wk[1]); w.y = cvtpk(bf2f((unsigned short)a2[ii]) * wk[2], bf2f((unsigned short)a3[ii]) * wk[3]);
                    *(LAS u32x2*)(lds + R_KT + (dcs * 8 + ii) * R_TSTR + q4 * 2) = w;
                }
            } else {
                if (full) {
#pragma unroll
                    for (int t = 0; t < 4; ++t) *(LAS u32x4*)(lds + R_QS + (q4 + t) * 144 + dcs * 16) = pb[t];
                }
#pragma unroll
                for (int ii = 0; ii < 8; ++ii) *(LAS s16x4*)(lds + R_VT + (dcs * 8 + ii) * R_TSTR + q4 * 2) = (s16x4){a0[ii], a1[ii], a2[ii], a3[ii]};
            }
        }
        __syncthreads();
        if (n + 1 < nend) { const bf16* src = HM + (row0 + (n + 1) * 128 + q4) * INW + h * 64 + dcs * 8; const bool nq = (n + 1 >= nfull0);
#pragma unroll
            for (int t = 0; t < 4; ++t) { pa[t] = *(const u32x4*)(src + (size_t)t * INW + (grpA ? 1280 : 1792)); if (!grpA && nq) pb[t] = *(const u32x4*)(src + (size_t)t * INW + 768); } }
        if (wid < 4) {
          if (full) {
            const int ib = wid, iq = 32 * ib + r32;
            const long trow = row0 + n * 128 + 32 * ib;
            u32x4 gv[4];
#pragma unroll
            for (int it = 0; it < 4; ++it) gv[it] = *(const u32x4*)(HM + (trow + it * 8 + (lane >> 3)) * INW + 2304 + h * 64 + (lane & 7) * 8);
            bf16x8 qf[4];
#pragma unroll
            for (int ks = 0; ks < 4; ++ks) qf[ks] = *(const LAS bf16x8*)(lds + R_QS + iq * 144 + (ks * 16 + hi * 8) * 2);
            f32x16 o[2];
#pragma unroll
            for (int r = 0; r < 16; ++r) { o[0][r] = 0.f; o[1][r] = 0.f; }
#pragma unroll
            for (int eb = 0; eb < 2; ++eb)
#pragma unroll
                for (int ks = 0; ks < 4; ++ks) {
                    const bf16x8 sf = *(const LAS bf16x8*)(lds + R_ST + (eb * 32 + r32) * 144 + (ks * 16 + hi * 8) * 2);
                    o[eb] = MFMA32(sf, qf[ks], o[eb]);
                }
            const float wq = fast_exp2((float)(iq + 1) * lg2);
#pragma unroll
            for (int r = 0; r < 16; ++r) { o[0][r] *= wq; o[1][r] *= wq; }
#pragma unroll 1
            for (int jb = 0; jb <= ib; ++jb) {
                f32x16 s;
#pragma unroll
                for (int r = 0; r < 16; ++r) s[r] = 0.f;
#pragma unroll
                for (int ks = 0; ks < 4; ++ks) {
                    const bf16x8 kf = *(const LAS bf16x8*)(lds + R_KS + (jb * 32 + r32) * 144 + (ks * 16 + hi * 8) * 2);
                    s = MFMA32(kf, qf[ks], s);
                }
#pragma unroll
                for (int r = 0; r < 16; ++r) { const int dj = iq - (jb * 32 + crow(r, hi)); s[r] = (dj >= 0) ? s[r] * fast_exp2((float)dj * lg2) : 0.f; }
#pragma unroll
                for (int gk = 0; gk < 2; ++gk) {
                    u32x4 pw; pw.x = cvtpk(s[8 * gk], s[8 * gk + 1]); pw.y = cvtpk(s[8 * gk + 2], s[8 * gk + 3]); pw.z = cvtpk(s[8 * gk + 4], s[8 * gk + 5]); pw.w = cvtpk(s[8 * gk + 6], s[8 * gk + 7]);
                    const bf16x8 pf = __builtin_bit_cast(bf16x8, pw);
#pragma unroll
                    for (int eb = 0; eb < 2; ++eb) {
                        const lds_u8* vp = lds + R_VT + (eb * 32 + r32) * R_TSTR + (jb * 32 + 16 * gk + 4 * hi) * 2;
                        const s16x4 lo = *(const LAS s16x4*)vp, hi4 = *(const LAS s16x4*)(vp + 16);
                        const bf16x8 vf = __builtin_shufflevector(lo, hi4, 0, 1, 2, 3, 4, 5, 6, 7);
                        o[eb] = MFMA32(vf, pf, o[eb]);
                    }
                }
            }
            float sm = 0.f;
#pragma unroll
            for (int r = 0; r < 16; ++r) sm += o[0][r] + o[1][r];
            sm += shx(sm, 32, lane);
            const float mu = sm * (1.f / 64.f);
            float sq = 0.f;
#pragma unroll
            for (int r = 0; r < 16; ++r) { o[0][r] -= mu; o[1][r] -= mu; sq += o[0][r] * o[0][r] + o[1][r] * o[1][r]; }
            sq += shx(sq, 32, lane);
            const float rstd = 1.f / sqrtf(sq * (1.f / 64.f) + GN_EPS);
#pragma unroll
            for (int r = 0; r < 16; ++r) { o[0][r] *= rstd; o[1][r] *= rstd; }
            lds_u8* stg = lds + R_STG + wid * STG_BYTES;
            stage_out_store(stg, o, r32, hi);
            asm volatile("s_waitcnt lgkmcnt(0)" ::: "memory");
#pragma unroll
            for (int it = 0; it < 4; ++it) { const int row = it * 8 + (lane >> 3), ch = lane & 7;
                const u32x4 ov = *(const LAS u32x4*)(stg + row * STG_STR + ch * 16);
                const bf16x8 o8 = __builtin_bit_cast(bf16x8, ov), g8 = __builtin_bit_cast(bf16x8, gv[it]);
                u32x4 w;
                w.x = cvtpk(bf2f((unsigned short)o8[0]) * bf2f((unsigned short)g8[0]), bf2f((unsigned short)o8[1]) * bf2f((unsigned short)g8[1]));
                w.y = cvtpk(bf2f((unsigned short)o8[2]) * bf2f((unsigned short)g8[2]), bf2f((unsigned short)o8[3]) * bf2f((unsigned short)g8[3]));
                w.z = cvtpk(bf2f((unsigned short)o8[4]) * bf2f((unsigned short)g8[4]), bf2f((unsigned short)o8[5]) * bf2f((unsigned short)g8[5]));
                w.w = cvtpk(bf2f((unsigned short)o8[6]) * bf2f((unsigned short)g8[6]), bf2f((unsigned short)o8[7]) * bf2f((unsigned short)g8[7]));
                *(u32x4*)(YM + (trow + row) * D + 512 + h * 64 + ch * 8) = w; }
          }
        } else {
            const int eb = (wid - 4) >> 1, dk = (wid - 4) & 1;
#pragma unroll
            for (int r = 0; r < 16; ++r) st[r] *= gchunk;
#pragma unroll
            for (int ks = 0; ks < 8; ++ks) {
                const bf16x8 vf = *(const LAS bf16x8*)(lds + R_VT + (eb * 32 + r32) * R_TSTR + (ks * 16 + hi * 8) * 2);
                const bf16x8 kf = *(const LAS bf16x8*)(lds + R_KT + (dk * 32 + r32) * R_TSTR + (ks * 16 + hi * 8) * 2);
                st = MFMA32(vf, kf, st);
            }
        }
        __syncthreads();
        if (wid >= 4 && n + 1 >= nfull0) {
            const int eb = (wid - 4) >> 1, dk = (wid - 4) & 1;
#pragma unroll
            for (int r = 0; r < 16; ++r) *(LAS short*)(lds + R_ST + (eb * 32 + crow(r, hi)) * 144 + (dk * 32 + r32) * 2) = (short)(cvtpk(st[r], 0.f) & 0xffffu);
        }
    }
    __syncthreads();
}

#define XB_TMO      128
#define XB_XCNT(j)  (256  + 64 * (j))
#define XB_XSUB(j)  (1280 + 64 * (j))
#define XB_XGEN(j)  (2304 + 64 * (j))
#define XB_TOP      3328
#define XB_TOPGEN   3392
#define XCD_BAR_WORDS 3456
#define XB_SPIN_CAP (1u << 18)

__device__ __forceinline__ unsigned xb_ld(unsigned* p)              { return __hip_atomic_load(p, __ATOMIC_RELAXED, __HIP_MEMORY_SCOPE_AGENT); }
__device__ __forceinline__ unsigned xb_add(unsigned* p, unsigned v) { return __hip_atomic_fetch_add(p, v, __ATOMIC_RELAXED, __HIP_MEMORY_SCOPE_AGENT); }
__device__ __forceinline__ unsigned xb_xcc_id() { return (unsigned)__builtin_amdgcn_s_getreg((3 << 11) | 20) & 0xFu; }
#define XB_SPIN(cond, bar) do { unsigned _sp = 0; while (cond) { __builtin_amdgcn_s_sleep(1); \
    if ((++_sp & 255u) == 0u) { if (xb_ld(&(bar)[XB_TMO])) break; if (_sp > XB_SPIN_CAP) { atomicAdd(&(bar)[XB_TMO], 1u); break; } } } } while (0)

struct XcdBarrier {
    unsigned* bar; unsigned x;
    volatile LAS unsigned* st;
};

__device__ __forceinline__ XcdBarrier xcd_barrier_post(unsigned* bar, volatile LAS unsigned* st) {
    XcdBarrier b; b.bar = bar; b.x = xb_xcc_id(); b.st = st;
    if (opaque_tid() == 0) (void)xb_add(&bar[XB_XCNT(b.x)], 1u);
    return b;
}
__device__ __forceinline__ void xcd_barrier_complete(unsigned* bar, unsigned x, unsigned& nloc, unsigned& nx) {
    const unsigned G = gridDim.x * gridDim.y * gridDim.z;
    unsigned sum, cnt, mine, sp = 0u;
    for (;;) {
        sum = 0u; cnt = 0u; mine = 0u;
#pragma unroll
        for (unsigned j = 0; j < 16; ++j) { const unsigned c = xb_ld(&bar[XB_XCNT(j)]); sum += c; cnt += (c > 0u) ? 1u : 0u; mine = (j == x) ? c : mine; }
        if (sum == G) break;
        __builtin_amdgcn_s_sleep(1);
        if ((++sp & 255u) == 0u) { if (xb_ld(&bar[XB_TMO])) break; if (sp > XB_SPIN_CAP) { atomicAdd(&bar[XB_TMO], 1u); break; } }
    }
    nloc = mine > 0u ? mine : 1u; nx = cnt > 0u ? cnt : 1u;
}

__device__ __forceinline__ void xcd_barrier(const XcdBarrier& b) {
    asm volatile("s_waitcnt vmcnt(0)" ::: "memory");
    __syncthreads();
    if (opaque_tid() == 0) {
        unsigned* bar = b.bar;
        __builtin_amdgcn_s_waitcnt(0);
        unsigned nloc = b.st[0], nx = b.st[1];
        if (nloc == 0u) { xcd_barrier_complete(bar, b.x, nloc, nx); b.st[0] = nloc; b.st[1] = nx; }
        const unsigned old = xb_add(&bar[XB_XSUB(b.x)], 1u);
        const unsigned gen = old / nloc;
        if (old + 1u == (gen + 1u) * nloc) {
            __builtin_amdgcn_fence(__ATOMIC_RELEASE, "agent");
            asm volatile("s_waitcnt vmcnt(0)" ::: "memory");
            const unsigned og = xb_add(&bar[XB_TOP], 1u);
            const unsigned tg = og / nx;
            if (og + 1u == (tg + 1u) * nx) xb_add(&bar[XB_TOPGEN], 1u);
            else XB_SPIN(xb_ld(&bar[XB_TOPGEN]) == tg, bar);
            __builtin_amdgcn_fence(__ATOMIC_ACQUIRE, "agent");
            xb_add(&bar[XB_XGEN(b.x)], 1u);
            asm volatile("s_waitcnt vmcnt(0)" ::: "memory");
        } else {
            XB_SPIN(xb_ld(&bar[XB_XGEN(b.x)]) == gen, bar);
            __builtin_amdgcn_fence(__ATOMIC_ACQUIRE, "agent");
            asm volatile("s_waitcnt vmcnt(0)" ::: "memory");
        }
    }
    __syncthreads();
}
#ifdef SKIP_RET
#define RET_UNIT(bb, hh, ss)
#else
#define RET_UNIT(bb, hh, ss) ret_unit(lds, HB, YM, (bb), (hh), (ss))
#endif
#ifdef SKIP_ATT
#define ATT_UNIT(bb, gg, nn)
#else
#define ATT_UNIT(bb, gg, nn) attn_unit(lds, HB, YM, a.sinks + l * 8, (bb), (gg), (nn))
#endif
__global__ void __launch_bounds__(NTHREADS, 2) mk_fwd(Args a_) {
    extern __shared__ __attribute__((aligned(16))) unsigned char lds_raw[];
    {
        volatile LAS unsigned* MISC0 = (volatile LAS unsigned*)((LAS unsigned char*)lds_raw + 131072 + 320);
        if (opaque_tid() < 64) MISC0[opaque_tid()] = 0u;
        __syncthreads();
    }
    bool bar_ready = false;
    const int ph_lo = a_.ph_lo, ph_hi = a_.ph_hi;
#pragma unroll 1
    for (int ph = ph_lo; ph < ph_hi; ++ph) {
        int z_ = 0; asm volatile("" : "+s"(z_));
        const CArgs* ap_ = (const CArgs*)__builtin_amdgcn_kernarg_segment_ptr(); asm volatile("" : "+s"(ap_)); const CArgs& a = *ap_;
        LAS unsigned char* lds = (LAS unsigned char*)lds_raw + z_;
        const int G = gridDim.x + z_, bx = blockIdx.x + z_;
        const int vcu = (G % 8 == 0) ? (bx % 8) * (G / 8) + bx / 8 : bx;
        const int NGW = G * NWAVES;
        unsigned char* ws = a.ws + z_;
        float* tab = (float*)(ws + WS_TAB);
        bf16* XB = (bf16*)(ws + WS_XB); bf16* HB = (bf16*)(ws + WS_HB); bf16* YM = (bf16*)(ws + WS_YM);
        float* X = a.out + z_;
        _Float16* YH = (_Float16*)(ws + WS_Y);
        if (ph == 0) {
            const int tid = opaque_tid(), lane = tid & 63, wave = __builtin_amdgcn_readfirstlane(tid >> 6), gw = vcu * NWAVES + wave;
            if (bx == 0) for (int i = tid; i < XCD_BAR_WORDS; i += NTHREADS) ((unsigned*)ws)[i] = 0u;
            build_tables(tab, vcu * NTHREADS + tid, G * NTHREADS);
            for (int i = vcu * NTHREADS + tid; i < M; i += G * NTHREADS) ((f32x2*)(ws + WS_STAT0))[i] = (f32x2){__int_as_float(z_), __int_as_float(0x3f800000 + z_)};
            for (int i = vcu * NTHREADS + tid; i < 2 * D; i += G * NTHREADS) ((float*)(ws + WS_ONES))[i] = (i < D) ? __int_as_float(0x3f800000 + z_) : __int_as_float(z_);
            convert_layer_weights(a, 0, ws, lds, wave, lane, gw, NGW, 63);
            for (int m = gw; m < M; m += NGW) row_to_fp8_f16(a.x + (size_t)m * D, (unsigned char*)XB + (size_t)m * D, YH + (size_t)m * D, lane);
        } else {
#ifdef PROBE_DUP
            const int l = (ph - 1) / 11, q_ = (ph - 1) % 11, s = (q_ <= PROBE_DUP) ? q_ : q_ - 1;
#else
            const int l = (ph - 1) / 10, s = (ph - 1) % 10;
#endif
            unsigned char* wsw = ws + ((l & 1) ? WS_WSET : 0);
            if (s == 0 || s == 7) {
                pg8::Gemm g{XB, (const bf16*)(wsw + (s == 0 ? WS_WGU1 : WS_WGU2)), M, GUW, D / 2}; pg8::StaticOrder S; S.init(M, GUW, G, bx);
                pg8::EpiSwiGLU8 E{(unsigned char*)HB};
                pg8::gemm_phase<pg8::EpiSwiGLU8, pg8::StaticOrder, true, true, true>(lds, g, S, E);
            } else if (s == 1 || s == 8) {
                pg8::Gemm g{HB, (const bf16*)(wsw + (s == 1 ? WS_WD1 : WS_WD2)), M, D, FF / 2}; pg8::StaticOrder S; S.init(M, D, G, bx);
                const bool raw = (l == 0 && s == 1);
                const float* xg = raw ? (const float*)(ws + WS_ONES) : (s == 1 ? a.ln_g2 + (l - 1) * D : a.ln_g1 + l * D);
                const float* xb = raw ? (const float*)(ws + WS_ONES) + D : (s == 1 ? a.ln_b2 + (l - 1) * D : a.ln_b1 + l * D);
                pg8::EpiResid E{YH, 0.5f / (WD_SCALE * H_SCALE), (const f32x2*)(ws + (raw ? WS_STAT0 : WS_STAT)), xg, xb};
                pg8::gemm_phase<pg8::EpiResid, pg8::StaticOrder, true, true, true>(lds, g, S, E);
            } else if (s == 5) {
                pg8::Gemm g{YM, (const bf16*)(wsw + WS_WOUT), M, D, D}; pg8::StaticOrder S; S.init(M, D, G, bx);
                pg8::EpiResid E{YH, 1.0f, (const f32x2*)(ws + WS_STAT), a.ln_g0 + l * D, a.ln_b0 + l * D};
                pg8::gemm_phase<pg8::EpiResid, pg8::StaticOrder, true, true, false>(lds, g, S, E);
            } else if (s == 3) {
                pg8::Gemm g{XB, (const bf16*)(wsw + WS_WIN), M, INW, D}; pg8::StaticOrder S; S.init(M, INW, G, bx);
                pg8::EpiInProj E{HB, tab};
                pg8::gemm_phase<pg8::EpiInProj, pg8::StaticOrder, true, true, false>(lds, g, S, E);
                if (G == 256 && bx >= 128 && l + 1 < DEPTH) {
                    const int tid = opaque_tid(), lane = tid & 63, wave = __builtin_amdgcn_readfirstlane(tid >> 6);
                    convert_layer_weights(a, l + 1, ws, lds, wave, lane, (bx - 128) * NWAVES + wave, 128 * NWAVES, 7);
                }
            } else if (s == 4) {
                if (G == 256) {
                    const int seg = vcu & 3, a0 = (vcu >> 2) * 8 + (seg == 0 ? 0 : (seg == 1 ? 3 : (seg == 2 ? 5 : 7))), an = (seg == 0 ? 3 : (seg == 3 ? 1 : 2));
                    RET_UNIT(vcu >> 5, (vcu >> 2) & 7, seg);
                    for (int u = a0; u < a0 + an; ++u) { ATT_UNIT(u >> 6, (u >> 5) & 1, u & 31); }
                } else {
                    for (int u = vcu; u < 256; u += G) { RET_UNIT(u >> 5, (u >> 2) & 7, u & 3); }
                    for (int u = vcu; u < BATCH * 2 * 32; u += G) { ATT_UNIT(u >> 6, (u >> 5) & 1, u & 31); }
                }
            } else {
                const int tid = opaque_tid(), lane = tid & 63, wave = __builtin_amdgcn_readfirstlane(tid >> 6), gw = vcu * NWAVES + wave;
                const int k = (s == 2) ? 0 : (s == 6 ? 1 : 2);
                const float* gp = (k == 0 ? a.ln_g0 : (k == 1 ? a.ln_g1 : a.ln_g2)) + l * D; const float* bp = (k == 0 ? a.ln_b0 : (k == 1 ? a.ln_b1 : a.ln_b2)) + l * D;
                const bool fin = (s == 9 && l + 1 == DEPTH);
                if (M % (4 * NGW) == 0) { for (int m = gw; m < M; m += 4 * NGW) ln_rows<4>(YH, X, XB, (f32x2*)(ws + WS_STAT), gp, bp, lane, s != 2, fin, m, NGW); }
                else { for (int m = gw; m < M; m += NGW) ln_rows<1>(YH, X, XB, (f32x2*)(ws + WS_STAT), gp, bp, lane, s != 2, fin, m, NGW); }
                if (s == 9 && l + 1 < DEPTH) convert_layer_weights(a, l + 1, ws, lds, wave, lane, gw, NGW, G == 256 ? 56 : 63);
            }
        }
        if (ph + 1 < ph_hi) {
            unsigned* bw_ = (unsigned*)ws; volatile LAS unsigned* st_ = (volatile LAS unsigned*)(lds + 131072 + 320) + 8;
            if (!bar_ready) { __syncthreads(); cg::this_grid().sync(); (void)xcd_barrier_post(bw_, st_); bar_ready = true; }
            else { XcdBarrier bar; bar.bar = bw_; bar.x = xb_xcc_id(); bar.st = st_; xcd_barrier(bar); }
        }
    }
}

extern "C" void kernel_launch(void* const* d_in, const int* in_sizes, int n_in, void* d_out, int out_size, void* d_ws, size_t ws_size, hipStream_t stream) {
    static int grid = 0;
    if (grid == 0) {
        if (n_in != 14 || in_sizes[0] != M * D || out_size != M * D || ws_size < WS_END) { fprintf(stderr, "kernel_launch: unexpected shapes: n_in %d in0 %d out %d ws %zu\n", n_in, n_in > 0 ? in_sizes[0] : -1, out_size, ws_size); grid = -1; return; }
        int dev = 0, cus = 0, per_cu = 0;
        if (hipGetDevice(&dev) != hipSuccess || hipDeviceGetAttribute(&cus, hipDeviceAttributeMultiprocessorCount, dev) != hipSuccess) { grid = -1; return; }
        if (hipFuncSetAttribute((const void*)mk_fwd, hipFuncAttributeMaxDynamicSharedMemorySize, LDS_BYTES) != hipSuccess) { fprintf(stderr, "kernel_launch: hipFuncSetAttribute failed\n"); grid = -1; return; }
        if (hipOccupancyMaxActiveBlocksPerMultiprocessor(&per_cu, (const void*)mk_fwd, NTHREADS, LDS_BYTES) != hipSuccess || per_cu < 1) { fprintf(stderr, "kernel_launch: occupancy query gave %d\n", per_cu); per_cu = 1; }
        (void)hipGetLastError();
        grid = cus * per_cu;
        fprintf(stderr, "kernel_launch: grid %d (cus %d x %d)\n", grid, cus, per_cu);
    }
    if (grid < 0) return;
    Args a{};
    a.x = (const float*)d_in[0]; a.w_in = (const float*)d_in[1]; a.w_out = (const float*)d_in[2]; a.sinks = (const float*)d_in[3];
    a.w_gu1 = (const float*)d_in[4]; a.w_d1 = (const float*)d_in[5]; a.w_gu2 = (const float*)d_in[6]; a.w_d2 = (const float*)d_in[7];
    a.ln_g0 = (const float*)d_in[8]; a.ln_b0 = (const float*)d_in[9]; a.ln_g1 = (const float*)d_in[10]; a.ln_b1 = (const float*)d_in[11];
    a.ln_g2 = (const float*)d_in[12]; a.ln_b2 = (const float*)d_in[13];
    a.out = (float*)d_out; a.ws = (unsigned char*)d_ws;
#ifdef PROBE_DUP
    constexpr int NPH = 1 + 11 * DEPTH;
#else
    constexpr int NPH = 1 + 10 * DEPTH;
#endif
#if MK_ONE_LAUNCH
    a.ph_lo = 0; a.ph_hi = NPH;
    void* params[] = {&a};
    hipError_t e = hipLaunchCooperativeKernel((const void*)mk_fwd, dim3(grid), dim3(NTHREADS), params, LDS_BYTES, stream);
    if (e != hipSuccess) fprintf(stderr, "kernel_launch: cooperative launch failed: %s (grid %d)\n", hipGetErrorString(e), grid);
#else
    for (int p = 0; p < NPH; ++p) { a.ph_lo = p; a.ph_hi = p + 1; hipLaunchKernelGGL(mk_fwd, dim3(grid), dim3(NTHREADS), LDS_BYTES, stream, a); }
#endif
}
```
